# Optimizing an MI355X kernel written in HIP

```python
import jax, jax.numpy as jnp
from jax import lax
import numpy as np

D_MODEL = 1024
BATCH = 32
SEQ = 2048
DEPTH = 1

HEAD_DIM = 64
N_HEADS_A = 8
N_KV_HEADS_A = 2
GROUP_A = N_HEADS_A // N_KV_HEADS_A
N_HEADS_B = 8
WINDOW_A = 128
DILATED_PATTERNS = ((128, 1), (512, 4), (2048, 16))
ROPE_THETA = 500000.0
ROPE_DIM = HEAD_DIM // 4
D_FF = 4 * D_MODEL
BLOCK = 128
EPS = 1e-6

WIDTH_QA = N_HEADS_A * HEAD_DIM
WIDTH_KA = N_KV_HEADS_A * HEAD_DIM
WIDTH_B = N_HEADS_B * HEAD_DIM
MIX_WIDTH = WIDTH_QA + WIDTH_B
PROJ_WIDTH = WIDTH_QA + 2 * WIDTH_KA + 3 * WIDTH_B
SPLITS = (WIDTH_QA,
          WIDTH_QA + WIDTH_KA,
          WIDTH_QA + 2 * WIDTH_KA,
          WIDTH_QA + 2 * WIDTH_KA + WIDTH_B,
          WIDTH_QA + 2 * WIDTH_KA + 2 * WIDTH_B)

kernel_name = "hymba_swa_sink_dilated_hybrid"


def rms_norm(t, gain):
    t32 = t.astype(jnp.float32)
    y = t32 * lax.rsqrt(jnp.mean(t32 * t32, axis=-1, keepdims=True) + EPS)
    return (y * gain.astype(jnp.float32)).astype(t.dtype)


def rope_tables(positions):
    inv_freq = ROPE_THETA ** (-(jnp.arange(0, ROPE_DIM, 2, dtype=jnp.float32) / ROPE_DIM))
    ang = positions.astype(jnp.float32)[..., None] * inv_freq
    return jnp.cos(ang)[:, :, None, :], jnp.sin(ang)[:, :, None, :]


def apply_partial_rope(t, cos, sin):
    rot = t[..., :ROPE_DIM].astype(jnp.float32)
    x1, x2 = rot[..., :ROPE_DIM // 2], rot[..., ROPE_DIM // 2:]
    r = jnp.concatenate([x1 * cos - x2 * sin, x2 * cos + x1 * sin], axis=-1)
    return jnp.concatenate([r.astype(t.dtype), t[..., ROPE_DIM:]], axis=-1)


def banded_attention(q, k, v, max_dist, sinks=None):
    n, L, hkv, g, dh = q.shape
    nb = -(-L // BLOCK)
    pad = nb * BLOCK - L
    q = jnp.pad(q, ((0, 0), (0, pad), (0, 0), (0, 0), (0, 0)))
    kv_pad = ((0, 0), (BLOCK, pad), (0, 0), (0, 0))
    kb = jnp.pad(k, kv_pad).reshape(n, nb + 1, BLOCK, hkv, dh)
    vb = jnp.pad(v, kv_pad).reshape(n, nb + 1, BLOCK, hkv, dh)
    kw = jnp.concatenate([kb[:, :-1], kb[:, 1:]], axis=2)
    vw = jnp.concatenate([vb[:, :-1], vb[:, 1:]], axis=2)
    qb = q.reshape(n, nb, BLOCK, hkv, g, dh)
    s = jnp.einsum('nbqhgd,nbkhd->nbhgqk', qb, kw,
                   preferred_element_type=jnp.float32) * (dh ** -0.5)
    qi = jnp.arange(BLOCK)[:, None]
    kj = jnp.arange(2 * BLOCK)[None, :]
    dist = BLOCK + qi - kj
    band = (dist >= 0) & (dist <= max_dist)
    blk = jnp.arange(nb)[:, None, None]
    mask = band[None] & ((blk > 0) | (kj[None] >= BLOCK))
    s = jnp.where(mask[:, None, None], s, -jnp.inf)
    m = jnp.max(s, axis=-1)
    if sinks is not None:
        sink = sinks.astype(jnp.float32)[:, :, None]
        m = jnp.maximum(m, sink)
    p = jnp.exp(s - m[..., None])
    den = jnp.sum(p, axis=-1)
    lse = m + jnp.log(den)
    if sinks is not None:
        den = den + jnp.exp(sink - m)
    p = p / den[..., None]
    o = jnp.einsum('nbhgqk,nbkhd->nbqhgd', p.astype(v.dtype), vw)
    o = o.reshape(n, nb * BLOCK, hkv, g, dh)[:, :L]
    lse = jnp.transpose(lse, (0, 1, 4, 2, 3)).reshape(n, nb * BLOCK, hkv, g)[:, :L]
    return o, lse


def dilated_attention(q, k, v):
    b, s, h, dh = q.shape
    outs, lses = [], []
    for window, dil in DILATED_PATTERNS:
        sub = s // dil
        def to_sub(t):
            return t.reshape(b, sub, dil, h, dh).transpose(0, 2, 1, 3, 4).reshape(b * dil, sub, h, dh)
        o, lse = banded_attention(to_sub(q)[:, :, :, None], to_sub(k), to_sub(v), window // dil)
        outs.append(o[:, :, :, 0].reshape(b, dil, sub, h, dh).transpose(0, 2, 1, 3, 4).reshape(b, s, h, dh))
        lses.append(lse[..., 0].reshape(b, dil, sub, h).transpose(0, 2, 1, 3).reshape(b, s, h))
    wts = jax.nn.softmax(jnp.stack(lses, axis=0), axis=0)
    out = sum(wts[i][..., None] * outs[i].astype(jnp.float32) for i in range(len(outs)))
    return out.astype(q.dtype)


def setup_inputs(seed: int = 0) -> dict:
    key = jax.random.key(seed)
    ks = jax.random.split(key, 14)
    f32 = jnp.float32
    x = jax.random.normal(ks[0], (BATCH, SEQ, D_MODEL), f32)
    offsets = jax.random.randint(ks[1], (BATCH, 1), 0, 4096, dtype=jnp.int32)
    positions = offsets + jnp.arange(SEQ, dtype=jnp.int32)[None, :]
    gain = lambda k, n: 1.0 + 0.1 * jax.random.normal(k, (DEPTH, n), f32)
    return {
        "x": x,
        "positions": positions,
        "attn_norm_gain": gain(ks[2], D_MODEL),
        "w_in": jax.random.normal(ks[3], (DEPTH, D_MODEL, PROJ_WIDTH), f32) * D_MODEL ** -0.5,
        "q_norm_a": gain(ks[4], HEAD_DIM),
        "k_norm_a": gain(ks[5], HEAD_DIM),
        "sinks_a": 0.5 * jax.random.normal(ks[6], (DEPTH, N_HEADS_A), f32),
        "q_norm_b": gain(ks[7], HEAD_DIM),
        "k_norm_b": gain(ks[8], HEAD_DIM),
        "w_out": jax.random.normal(ks[9], (DEPTH, MIX_WIDTH, D_MODEL), f32) * MIX_WIDTH ** -0.5,
        "mlp_norm_gain": gain(ks[10], D_MODEL),
        "w_up": jax.random.normal(ks[11], (DEPTH, D_MODEL, D_FF), f32) * D_MODEL ** -0.5,
        "w_down": jax.random.normal(ks[12], (DEPTH, D_FF, D_MODEL), f32) * D_FF ** -0.5,
    }


def reference(x, positions, attn_norm_gain, w_in, q_norm_a, k_norm_a, sinks_a,
              q_norm_b, k_norm_b, w_out, mlp_norm_gain, w_up, w_down):
    b, s, _ = x.shape
    cos, sin = rope_tables(positions)
    h = x
    for layer in range(DEPTH):
        hn = rms_norm(h, attn_norm_gain[layer])
        proj = hn @ w_in[layer]
        qa, ka, va, qb, kb, vb = jnp.split(proj, SPLITS, axis=-1)
        qa = qa.reshape(b, s, N_HEADS_A, HEAD_DIM)
        ka = ka.reshape(b, s, N_KV_HEADS_A, HEAD_DIM)
        va = va.reshape(b, s, N_KV_HEADS_A, HEAD_DIM)
        qb = qb.reshape(b, s, N_HEADS_B, HEAD_DIM)
        kb = kb.reshape(b, s, N_HEADS_B, HEAD_DIM)
        vb = vb.reshape(b, s, N_HEADS_B, HEAD_DIM)
        qa = apply_partial_rope(rms_norm(qa, q_norm_a[layer]), cos, sin)
        ka = apply_partial_rope(rms_norm(ka, k_norm_a[layer]), cos, sin)
        qb = apply_partial_rope(rms_norm(qb, q_norm_b[layer]), cos, sin)
        kb = apply_partial_rope(rms_norm(kb, k_norm_b[layer]), cos, sin)
        oa, _ = banded_attention(qa.reshape(b, s, N_KV_HEADS_A, GROUP_A, HEAD_DIM), ka, va,
                                 WINDOW_A - 1, sinks_a[layer].reshape(N_KV_HEADS_A, GROUP_A))
        ob = dilated_attention(qb, kb, vb)
        mix = jnp.concatenate([oa.reshape(b, s, WIDTH_QA), ob.reshape(b, s, WIDTH_B)], axis=-1)
        h = h + mix @ w_out[layer]
        hn = rms_norm(h, mlp_norm_gain[layer])
        h = h + jnp.square(jax.nn.relu(hn @ w_up[layer])) @ w_down[layer]
    return h
```

```cpp
#include <hip/hip_runtime.h>
#include <cstdio>
#include <cstdint>

#ifndef MK_N_LAUNCHES
#define MK_N_LAUNCHES 1
#endif

namespace pg8 {
#define PG8_LAS __attribute__((address_space(3)))
typedef unsigned short bf16_t;
typedef short bf16x8 __attribute__((ext_vector_type(8)));
typedef float f32x4 __attribute__((ext_vector_type(4)));
typedef unsigned u32x4 __attribute__((ext_vector_type(4)));
constexpr int BM = 256, BK = 64, HALF = 128, HTB = HALF * BK * 2  , STAGE_BYTES = 8 * HTB, NXCD = 8, WGM = 8;

__host__ __device__ __forceinline__ int lds_byte(int r, int c) { const int st = (r >> 4) * 2 + (c >> 5), rr = r & 15, cc = c & 31, ob = rr * 64 + cc * 2; return st * 1024 + (ob ^ (((ob >> 9) & 1) << 5)); }
__host__ __device__ __forceinline__ void stage_rc(int b, int& R, int& C) { const int st = b / 1024, sb = b % 1024, swz = sb ^ (((sb >> 9) & 1) << 5); R = (st >> 1) * 16 + swz / 64; C = (st & 1) * 32 + (swz % 64) / 2; }
__host__ __device__ __forceinline__ int perm32(int rho) { const int n = rho >> 4, i = rho & 15; return 8 * (i >> 2) + 4 * n + (i & 3); }

struct Unit { int pm, pn; };
struct Gemm { const bf16_t* A; const bf16_t* Bt; int M, N, K; };

struct StaticOrder {
    int nM, nN, nwg, G, c;
    __host__ __device__ void init(int M, int N, int G_, int c_) { nM = M / BM; nN = N / BM; nwg = nM * nN; G = G_; c = c_; }
    __host__ __device__ bool next(int i, Unit& u) const {
        const long L = (long)i * G + c; if (L >= nwg) return false;
        int wgid = (int)L; { const int q = nwg / NXCD, r = nwg % NXCD, xcd = wgid % NXCD, off = wgid / NXCD; wgid = (xcd < r ? xcd * (q + 1) : r * (q + 1) + (xcd - r) * q) + off; }
        const int nig = WGM * nN, gid = wgid / nig, fm = gid * WGM, gsz = (nM - fm) < WGM ? (nM - fm) : WGM;
        u.pm = fm + ((wgid % nig) % gsz); u.pn = (wgid % nig) / gsz; return true;
    }
};

__device__ __forceinline__ unsigned cvt_pk_bf16(float lo, float hi) { unsigned r; asm volatile("v_cvt_pk_bf16_f32 %0, %1, %2" : "=v"(r) : "v"(lo), "v"(hi)); return r; }

constexpr float QK_EPS = 1e-6f;
constexpr float C2 = 0.125f * 1.4426950408889634f;

struct EpiQKV {
    bf16_t* O; int ldc; const float* gqa; const float* gka; const float* gqb; const float* gkb; const float* rope;
    __device__ __forceinline__ void operator()(const f32x4 (&acc)[2][2][4][2], const Unit& u, int wr, int wc, int fr, int fq) const {
        const int pn = u.pn; int mode = 0; const float* g = gqa;
        if (pn < 2) { mode = 1; g = gqa; } else if (pn == 2) { if (wc < 2) { mode = 2; g = gka; } } else if (pn < 5) { mode = 1; g = gqb; } else if (pn < 7) { mode = 2; g = gkb; }
        const int row0 = u.pm * BM + wr * 64 + fr, col0 = pn * BM + wc * 64 + 8 * fq;
        if (mode == 0) {
#pragma unroll
            for (int ai = 0; ai < 2; ++ai)
#pragma unroll
                for (int m = 0; m < 4; ++m) { bf16_t* rowp = O + (size_t)(row0 + ai * HALF + m * 16) * ldc + col0;
#pragma unroll
                    for (int bj = 0; bj < 2; ++bj) { const f32x4 v0 = acc[ai][bj][m][0], v1 = acc[ai][bj][m][1]; u32x4 w;
                        w.x = cvt_pk_bf16(v0[0], v0[1]); w.y = cvt_pk_bf16(v0[2], v0[3]); w.z = cvt_pk_bf16(v1[0], v1[1]); w.w = cvt_pk_bf16(v1[2], v1[3]);
                        *(u32x4*)(rowp + bj * 32) = w; } }
            return;
        }
        f32x4 gv[2][2];
#pragma unroll
        for (int bj = 0; bj < 2; ++bj)
#pragma unroll
            for (int n = 0; n < 2; ++n) gv[bj][n] = *(const f32x4*)(g + 32 * bj + 8 * fq + 4 * n);
        const float sc = (mode == 1) ? C2 : 1.0f;
        const float sgn = (fq == 0) ? -1.0f : 1.0f;
#pragma unroll
        for (int ai = 0; ai < 2; ++ai)
#pragma unroll
            for (int m = 0; m < 4; ++m) {
                const int row = row0 + ai * HALF + m * 16;
                float ss = 0.f;
#pragma unroll
                for (int bj = 0; bj < 2; ++bj)
#pragma unroll
                    for (int n = 0; n < 2; ++n) { const f32x4 x = acc[ai][bj][m][n]; ss += (x[0] * x[0] + x[1] * x[1]) + (x[2] * x[2] + x[3] * x[3]); }
                ss += __shfl_xor(ss, 16); ss += __shfl_xor(ss, 32);
                const float rs = __builtin_amdgcn_rsqf(ss * (1.0f / 64.0f) + QK_EPS);
                f32x4 y[2][2];
#pragma unroll
                for (int bj = 0; bj < 2; ++bj)
#pragma unroll
                    for (int n = 0; n < 2; ++n) y[bj][n] = acc[ai][bj][m][n] * rs * gv[bj][n];
                const f32x4 c0 = *(const f32x4*)(rope + (size_t)row * 16), c1 = *(const f32x4*)(rope + (size_t)row * 16 + 4);
                const f32x4 s0 = *(const f32x4*)(rope + (size_t)row * 16 + 8), s1 = *(const f32x4*)(rope + (size_t)row * 16 + 12);
                f32x4 p0, p1;
#pragma unroll
                for (int e = 0; e < 4; ++e) { p0[e] = __shfl_xor(y[0][0][e], 16); p1[e] = __shfl_xor(y[0][1][e], 16); }
                if (fq < 2) { y[0][0] = y[0][0] * c0 + p0 * s0 * sgn; y[0][1] = y[0][1] * c1 + p1 * s1 * sgn; }
                bf16_t* rowp = O + (size_t)row * ldc + col0;
#pragma unroll
                for (int bj = 0; bj < 2; ++bj) { const f32x4 v0 = y[bj][0] * sc, v1 = y[bj][1] * sc; u32x4 w;
                    w.x = cvt_pk_bf16(v0[0], v0[1]); w.y = cvt_pk_bf16(v0[2], v0[3]); w.z = cvt_pk_bf16(v1[0], v1[1]); w.w = cvt_pk_bf16(v1[2], v1[3]);
                    *(u32x4*)(rowp + bj * 32) = w; }
            }
    }
};

struct EpiOut {
    const float* x; float* h; bf16_t* hb; float* ssp; int ldc;
    __device__ __forceinline__ void operator()(const f32x4 (&acc)[2][2][4][2], const Unit& u, int wr, int wc, int fr, int fq) const {
        const int row0 = u.pm * BM + wr * 64 + fr, col0 = u.pn * BM + wc * 64 + 8 * fq;
#pragma unroll
        for (int ai = 0; ai < 2; ++ai)
#pragma unroll
            for (int m = 0; m < 4; ++m) {
                const int row = row0 + ai * HALF + m * 16; const size_t off = (size_t)row * ldc + col0; float ss = 0.f;
#pragma unroll
                for (int bj = 0; bj < 2; ++bj) {
                    const f32x4 x0 = *(const f32x4*)(x + off + bj * 32), x1 = *(const f32x4*)(x + off + bj * 32 + 4);
                    const f32x4 v0 = acc[ai][bj][m][0] + x0, v1 = acc[ai][bj][m][1] + x1;
                    *(f32x4*)(h + off + bj * 32) = v0; *(f32x4*)(h + off + bj * 32 + 4) = v1;
                    u32x4 w; w.x = cvt_pk_bf16(v0[0], v0[1]); w.y = cvt_pk_bf16(v0[2], v0[3]); w.z = cvt_pk_bf16(v1[0], v1[1]); w.w = cvt_pk_bf16(v1[2], v1[3]);
                    *(u32x4*)(hb + off + bj * 32) = w;
                    ss += (v0[0] * v0[0] + v0[1] * v0[1]) + (v0[2] * v0[2] + v0[3] * v0[3]) + (v1[0] * v1[0] + v1[1] * v1[1]) + (v1[2] * v1[2] + v1[3] * v1[3]);
                }
                ss += __shfl_xor(ss, 16); ss += __shfl_xor(ss, 32);
                if (fq == 0) ssp[(size_t)row * 16 + u.pn * 4 + wc] = ss;
            }
    }
};

struct EpiUp {
    const float* ssp; bf16_t* hid; int ldc; float inv_n, eps;
    __device__ __forceinline__ void operator()(const f32x4 (&acc)[2][2][4][2], const Unit& u, int wr, int wc, int fr, int fq) const {
        const int row0 = u.pm * BM + wr * 64 + fr, col0 = u.pn * BM + wc * 64 + 8 * fq;
#pragma unroll
        for (int ai = 0; ai < 2; ++ai)
#pragma unroll
            for (int m = 0; m < 4; ++m) {
                const int row = row0 + ai * HALF + m * 16;
                const f32x4 a = *(const f32x4*)(ssp + (size_t)row * 16), b = *(const f32x4*)(ssp + (size_t)row * 16 + 4), c = *(const f32x4*)(ssp + (size_t)row * 16 + 8), d = *(const f32x4*)(ssp + (size_t)row * 16 + 12);
                const f32x4 t = (a + b) + (c + d); const float ss = (t[0] + t[1]) + (t[2] + t[3]);
                const float rs = __builtin_amdgcn_rsqf(ss * inv_n + eps);
                bf16_t* rowp = hid + (size_t)row * ldc + col0;
#pragma unroll
                for (int bj = 0; bj < 2; ++bj) { f32x4 v0 = acc[ai][bj][m][0] * rs, v1 = acc[ai][bj][m][1] * rs;
#pragma unroll
                    for (int e = 0; e < 4; ++e) { const float r0 = __builtin_fmaxf(v0[e], 0.f), r1 = __builtin_fmaxf(v1[e], 0.f); v0[e] = r0 * r0; v1[e] = r1 * r1; }
                    u32x4 w; w.x = cvt_pk_bf16(v0[0], v0[1]); w.y = cvt_pk_bf16(v0[2], v0[3]); w.z = cvt_pk_bf16(v1[0], v1[1]); w.w = cvt_pk_bf16(v1[2], v1[3]);
                    *(u32x4*)(rowp + bj * 32) = w; }
            }
    }
};

struct EpiDown {
    float* out; int ldc;
    __device__ __forceinline__ void operator()(const f32x4 (&acc)[2][2][4][2], const Unit& u, int wr, int wc, int fr, int fq) const {
        const int row0 = u.pm * BM + wr * 64 + fr, col0 = u.pn * BM + wc * 64 + 8 * fq;
#pragma unroll
        for (int ai = 0; ai < 2; ++ai)
#pragma unroll
            for (int m = 0; m < 4; ++m) {
                const size_t off = (size_t)(row0 + ai * HALF + m * 16) * ldc + col0;
#pragma unroll
                for (int bj = 0; bj < 2; ++bj) {
                    const f32x4 h0 = *(const f32x4*)(out + off + bj * 32), h1 = *(const f32x4*)(out + off + bj * 32 + 4);
                    *(f32x4*)(out + off + bj * 32) = h0 + acc[ai][bj][m][0]; *(f32x4*)(out + off + bj * 32 + 4) = h1 + acc[ai][bj][m][1];
                }
            }
    }
};

template <class Epi, class Sched, bool ALIGN_EPI>
__device__ __forceinline__ void gemm_phase(PG8_LAS unsigned char* lds, const Gemm g, const Sched& S, const Epi& E) {
    const int tid = threadIdx.x, wid = __builtin_amdgcn_readfirstlane(tid >> 6), lane = tid & 63, wr = wid >> 2, wc = wid & 3, fr = lane & 15, fq = lane >> 4;
    const int K = g.K, nt = K / BK;
    unsigned voffA[2], voffB[2];
#pragma unroll
    for (int i = 0; i < 2; ++i) { int R, C; stage_rc(tid * 16 + i * 8192, R, C); const int Rb = (R >> 5) * 64 + perm32(R & 31);
        voffA[i] = (unsigned)(R * K + C) * 2u; voffB[i] = (unsigned)(Rb * K + C) * 2u; }
    const size_t kstep = (size_t)(BK * 2);
    const size_t hstepA = (size_t)HALF * K * 2;
    const size_t hstepB = (size_t)32 * K * 2;
    const size_t tstep = (size_t)BM * K * 2;
    const unsigned ldsw = (unsigned)wid * 1024u;
    const int aoff = lds_byte(wr * 64 + fr, fq * 8), boff = lds_byte(wc * 32 + fr, fq * 8);
#define PG8_SA(b, h) (((b) * 2 + (h)) * HTB)
#define PG8_SB(b, h) ((4 + (b) * 2 + (h)) * HTB)
#define PG8_STAGE(bufoff, gbase, voff) do { _Pragma("unroll") for (int _i = 0; _i < 2; ++_i) \
        __builtin_amdgcn_global_load_lds((const unsigned*)((const char*)(gbase) + (voff)[_i]), (PG8_LAS unsigned*)(lds + (bufoff) + ldsw + _i * 8192), 16, 0, 0); } while (0)
#define PG8_LDA(dst, b, h) do { _Pragma("unroll") for (int m = 0; m < 4; ++m) _Pragma("unroll") for (int k = 0; k < 2; ++k) dst[m][k] = *(const PG8_LAS bf16x8*)(lds + PG8_SA(b, h) + aoff + m * 2048 + k * 1024); } while (0)
#define PG8_LDB(dst, b, h) do { _Pragma("unroll") for (int n = 0; n < 2; ++n) _Pragma("unroll") for (int k = 0; k < 2; ++k) dst[n][k] = *(const PG8_LAS bf16x8*)(lds + PG8_SB(b, h) + boff + n * 2048 + k * 1024); } while (0)
#define PG8_MMA(ai, bj, At, Bt) do { __builtin_amdgcn_s_setprio(1); _Pragma("unroll") for (int m = 0; m < 4; ++m) _Pragma("unroll") for (int n = 0; n < 2; ++n) _Pragma("unroll") for (int k = 0; k < 2; ++k) \
        acc[ai][bj][m][n] = __builtin_amdgcn_mfma_f32_16x16x32_bf16(Bt[n][k], At[m][k], acc[ai][bj][m][n], 0, 0, 0); __builtin_amdgcn_s_setprio(0); } while (0)
#define PG8_WAIT_V(n) asm volatile("s_waitcnt vmcnt(" #n ")" ::: "memory")
#define PG8_WAIT_L(n) asm volatile("s_waitcnt lgkmcnt(" #n ")" ::: "memory")
#define PG8_BAR __builtin_amdgcn_s_barrier()
#define PG8_SCHED __builtin_amdgcn_sched_barrier(0)
    Unit cur, nxt; int ui = 0;
    if (!S.next(0, cur)) return;
    f32x4 acc[2][2][4][2];
#pragma unroll
    for (int a = 0; a < 2; ++a)
#pragma unroll
        for (int b = 0; b < 2; ++b)
#pragma unroll
            for (int m = 0; m < 4; ++m)
#pragma unroll
                for (int n = 0; n < 2; ++n) acc[a][b][m][n] = (f32x4){0.f, 0.f, 0.f, 0.f};
    bf16x8 At[4][2], B0[2][2], B1[2][2];
    const char* cA = (const char*)g.A + (size_t)cur.pm * tstep; const char* cB = (const char*)g.Bt + (size_t)cur.pn * tstep;
    PG8_STAGE(PG8_SB(0, 0), cB, voffB); PG8_STAGE(PG8_SB(0, 1), cB + hstepB, voffB); PG8_STAGE(PG8_SA(0, 0), cA, voffA); PG8_STAGE(PG8_SA(0, 1), cA + hstepA, voffA);
    if (wr == 1) PG8_BAR;
    PG8_WAIT_V(2); PG8_BAR;
    PG8_STAGE(PG8_SB(1, 0), cB + kstep, voffB); PG8_STAGE(PG8_SA(1, 0), cA + kstep, voffA); PG8_STAGE(PG8_SB(1, 1), cB + hstepB + kstep, voffB);
    PG8_WAIT_V(6); PG8_BAR;
    for (;;) {
        const bool has_next = S.next(ui + 1, nxt);
        const char* nA = has_next ? (const char*)g.A + (size_t)nxt.pm * tstep : cA; const char* nB = has_next ? (const char*)g.Bt + (size_t)nxt.pn * tstep : cB;
        for (int t = 0; t < nt; t += 2) {
            const bool last = (t == nt - 2);
            const char* a1 = cA + (size_t)(t + 1) * kstep;
            const char* a2 = last ? nA : cA + (size_t)(t + 2) * kstep; const char* b2 = last ? nB : cB + (size_t)(t + 2) * kstep;
            const char* a3 = a2 + kstep; const char* b3 = b2 + kstep;
            PG8_LDB(B0, 0, 0); PG8_LDB(B1, 0, 1); PG8_SCHED; PG8_LDA(At, 0, 0); PG8_STAGE(PG8_SA(1, 1), a1 + hstepA, voffA);
            PG8_WAIT_V(8); PG8_WAIT_L(0); PG8_BAR; PG8_MMA(0, 0, At, B0); PG8_MMA(0, 1, At, B1); PG8_BAR; PG8_SCHED;
            PG8_LDA(At, 0, 1); PG8_STAGE(PG8_SB(0, 0), b2, voffB); PG8_STAGE(PG8_SB(0, 1), b2 + hstepB, voffB); PG8_STAGE(PG8_SA(0, 0), a2, voffA);
            PG8_WAIT_V(8); PG8_WAIT_L(0); PG8_BAR; PG8_MMA(1, 0, At, B0); PG8_MMA(1, 1, At, B1); PG8_BAR; PG8_SCHED;
            PG8_LDB(B0, 1, 0); PG8_LDB(B1, 1, 1); PG8_SCHED; PG8_LDA(At, 1, 0); PG8_STAGE(PG8_SA(0, 1), a2 + hstepA, voffA);
            PG8_WAIT_V(8); PG8_WAIT_L(0); PG8_BAR; PG8_MMA(0, 0, At, B0); PG8_MMA(0, 1, At, B1); PG8_BAR; PG8_SCHED;
            PG8_LDA(At, 1, 1); PG8_STAGE(PG8_SB(1, 0), b3, voffB); PG8_STAGE(PG8_SB(1, 1), b3 + hstepB, voffB); PG8_STAGE(PG8_SA(1, 0), a3, voffA);
            PG8_WAIT_V(8); PG8_WAIT_L(0); PG8_BAR; PG8_MMA(1, 0, At, B0); PG8_MMA(1, 1, At, B1); PG8_BAR; PG8_SCHED;
        }
        if constexpr (ALIGN_EPI) { if (wr == 0) PG8_BAR; }
        E(acc, cur, wr, wc, fr, fq);
        if (!has_next) break;
#pragma unroll
        for (int a = 0; a < 2; ++a)
#pragma unroll
            for (int b = 0; b < 2; ++b)
#pragma unroll
                for (int m = 0; m < 4; ++m)
#pragma unroll
                    for (int n = 0; n < 2; ++n) acc[a][b][m][n] = (f32x4){0.f, 0.f, 0.f, 0.f};
        cur = nxt; cA = nA; cB = nB; ++ui;
        if constexpr (ALIGN_EPI) { if (wr == 1) PG8_BAR; }
    }
    PG8_WAIT_V(0);
    if constexpr (!ALIGN_EPI) { if (wr == 0) PG8_BAR; }
    PG8_BAR;
#undef PG8_SA
#undef PG8_SB
#undef PG8_STAGE
#undef PG8_LDA
#undef PG8_LDB
#undef PG8_MMA
#undef PG8_WAIT_V
#undef PG8_WAIT_L
#undef PG8_BAR
#undef PG8_SCHED
}
}

constexpr int NWAVES = 8;
constexpr int BATCH = 32, SEQ = 2048, D = 1024, FF = 4096, HD = 64;
constexpr int M = BATCH * SEQ;
constexpr int NPROJ = 2304;
constexpr int COL_QA = 0, COL_KA = 512, COL_VA = 640, COL_QB = 768, COL_KB = 1280, COL_VB = 1792;
constexpr float RMS_EPS = 1e-6f;
constexpr int N_LAUNCHES = MK_N_LAUNCHES, PER_PHASE = 6;
constexpr int N_BAR_REGIONS = (MK_N_LAUNCHES == PER_PHASE) ? 1 : MK_N_LAUNCHES;

constexpr size_t MiB = 1u << 20;
constexpr size_t WS_CTL = 0, CTL_ZERO_BYTES = 1 * MiB;
constexpr size_t WS_WIN = 2 * MiB, WS_WOUT = 8 * MiB, WS_WUP = 10 * MiB, WS_WDN = 18 * MiB;
constexpr size_t WS_ROPE = 26 * MiB;
constexpr size_t WS_SS = 30 * MiB;
constexpr size_t WS_XN = 64 * MiB;
constexpr size_t WS_PROJ = 192 * MiB;
constexpr size_t WS_MIX = 480 * MiB;
constexpr size_t WS_HID = 192 * MiB;
constexpr size_t WS_END = 704 * MiB;
static_assert(WS_WIN + (size_t)NPROJ * D * 2 <= WS_WOUT && WS_WDN + (size_t)D * FF * 2 <= WS_ROPE && WS_SS + (size_t)M * 64 <= WS_XN, "d_ws map");
static_assert(WS_XN + (size_t)M * D * 2 <= WS_PROJ && WS_PROJ + (size_t)M * NPROJ * 2 <= WS_MIX && WS_MIX + (size_t)M * D * 2 <= WS_END && WS_HID + (size_t)M * FF * 2 <= WS_END, "d_ws map");
constexpr int CW_TMO = 0, CW_CODE = 1;
constexpr int CW_BAR = 4096;

constexpr int RING_OFF = 0, RING_BYTES = 131072;
constexpr int LDSCTL_OFF = RING_BYTES, MISC_OFF = LDSCTL_OFF + 320;
constexpr int LDS_BYTES = 147456;

#define GAS __attribute__((address_space(1)))
#define LAS __attribute__((address_space(3)))
typedef unsigned short bf16;
typedef unsigned v4u __attribute__((ext_vector_type(4)));
typedef float f32x4 __attribute__((ext_vector_type(4)));
typedef GAS unsigned gu32;
#define RLX_AGENT __ATOMIC_RELAXED, __HIP_MEMORY_SCOPE_AGENT
#define LDS_WAIT() asm volatile("s_waitcnt lgkmcnt(0)" ::: "memory")
#define VM_WAIT() asm volatile("s_waitcnt vmcnt(0)" ::: "memory")
__device__ __forceinline__ unsigned f2bf(float f) { unsigned u = __builtin_bit_cast(unsigned, f); return (u + 0x7fffu + ((u >> 16) & 1u)) >> 16; }
__device__ __forceinline__ unsigned pk2(float lo, float hi) { return f2bf(lo) | (f2bf(hi) << 16); }
__device__ __forceinline__ float bf_lo(unsigned u) { return __uint_as_float(u << 16); }
__device__ __forceinline__ float bf_hi(unsigned u) { return __uint_as_float(u & 0xffff0000u); }

#define XB_TMO      128
#define XB_XCNT(j)  (256  + 64 * (j))
#define XB_XSUB(j)  (1280 + 64 * (j))
#define XB_XGEN(j)  (2304 + 64 * (j))
#define XB_TOP      3328
#define XB_TOPGEN   3392
#define XCD_BAR_WORDS 3456
#define XB_SPIN_CAP (1u << 18)

__device__ __forceinline__ unsigned xb_ld(unsigned* p)              { return __hip_atomic_load(p, __ATOMIC_RELAXED, __HIP_MEMORY_SCOPE_AGENT); }
__device__ __forceinline__ unsigned xb_add(unsigned* p, unsigned v) { return __hip_atomic_fetch_add(p, v, __ATOMIC_RELAXED, __HIP_MEMORY_SCOPE_AGENT); }
__device__ __forceinline__ unsigned xb_xcc_id() { return (unsigned)__builtin_amdgcn_s_getreg((3 << 11) | 20) & 0xFu; }
#define XB_SPIN(cond, bar) do { unsigned _sp = 0; while (cond) { __builtin_amdgcn_s_sleep(1); \
    if ((++_sp & 255u) == 0u) { if (xb_ld(&(bar)[XB_TMO])) break; if (_sp > XB_SPIN_CAP) { atomicAdd(&(bar)[XB_TMO], 1u); break; } } } } while (0)

struct XcdBarrier { unsigned* bar; unsigned x; volatile LAS unsigned* st; };

__device__ __forceinline__ XcdBarrier xcd_barrier_post(unsigned* bar, volatile LAS unsigned* st) {
    XcdBarrier b; b.bar = bar; b.x = xb_xcc_id(); b.st = st;
    if (threadIdx.x == 0) (void)xb_add(&bar[XB_XCNT(b.x)], 1u);
    return b;
}
__device__ __forceinline__ void xcd_barrier_complete(unsigned* bar, unsigned x, unsigned& nloc, unsigned& nx) {
    const unsigned G = gridDim.x * gridDim.y * gridDim.z;
    unsigned sum, cnt, mine, sp = 0u;
    for (;;) {
        sum = 0u; cnt = 0u; mine = 0u;
#pragma unroll
        for (unsigned j = 0; j < 16; ++j) { const unsigned c = xb_ld(&bar[XB_XCNT(j)]); sum += c; cnt += (c > 0u) ? 1u : 0u; mine = (j == x) ? c : mine; }
        if (sum == G) break;
        __builtin_amdgcn_s_sleep(1);
        if ((++sp & 255u) == 0u) { if (xb_ld(&bar[XB_TMO])) break; if (sp > XB_SPIN_CAP) { atomicAdd(&bar[XB_TMO], 1u); break; } }
    }
    nloc = mine > 0u ? mine : 1u; nx = cnt > 0u ? cnt : 1u;
}
__device__ __forceinline__ void xcd_barrier(const XcdBarrier& b) {
    asm volatile("s_waitcnt vmcnt(0)" ::: "memory");
    __syncthreads();
    if (threadIdx.x == 0) {
        unsigned* bar = b.bar;
        __builtin_amdgcn_s_waitcnt(0);
        unsigned nloc = b.st[0], nx = b.st[1];
        if (nloc == 0u) { xcd_barrier_complete(bar, b.x, nloc, nx); b.st[0] = nloc; b.st[1] = nx; }
        const unsigned old = xb_add(&bar[XB_XSUB(b.x)], 1u);
        const unsigned gen = old / nloc;
        if (old + 1u == (gen + 1u) * nloc) {
            __builtin_amdgcn_fence(__ATOMIC_RELEASE, "agent");
            asm volatile("s_waitcnt vmcnt(0)" ::: "memory");
            const unsigned og = xb_add(&bar[XB_TOP], 1u);
            const unsigned tg = og / nx;
            if (og + 1u == (tg + 1u) * nx) xb_add(&bar[XB_TOPGEN], 1u);
            else XB_SPIN(xb_ld(&bar[XB_TOPGEN]) == tg, bar);
            __builtin_amdgcn_fence(__ATOMIC_ACQUIRE, "agent");
            xb_add(&bar[XB_XGEN(b.x)], 1u);
            asm volatile("s_waitcnt vmcnt(0)" ::: "memory");
        } else {
            XB_SPIN(xb_ld(&bar[XB_XGEN(b.x)]) == gen, bar);
            __builtin_amdgcn_fence(__ATOMIC_ACQUIRE, "agent");
            asm volatile("s_waitcnt vmcnt(0)" ::: "memory");
        }
    }
    __syncthreads();
}

__device__ __forceinline__ float wave_sum(float v) {
#pragma unroll
    for (int o = 1; o < 64; o <<= 1) v += __shfl_xor(v, o);
    return v;
}
__device__ __forceinline__ float wave_max(float v) {
#pragma unroll
    for (int o = 1; o < 64; o <<= 1) v = __builtin_fmaxf(v, __shfl_xor(v, o));
    return v;
}
__device__ __forceinline__ void p0_transpose_item(const float* W, int K, int N, bf16* WT, const float* gk, LAS float* scr, int item, int lane) {
    const int nblk = N / 32, kb = item / nblk, nb = item % nblk, k0 = 64 * kb, n0 = 32 * nb;
#pragma unroll 8
    for (int i = 0; i < 32; ++i) { const int kk = 2 * i + (lane >> 5); float v = W[(size_t)(k0 + kk) * N + n0 + (lane & 31)]; if (gk) v *= gk[k0 + kk]; scr[kk * 33 + (lane & 31)] = v; }
    LDS_WAIT(); asm volatile("" ::: "memory");
    const int c = lane & 7;
#pragma unroll
    for (int j = 0; j < 4; ++j) { const int n = (lane >> 3) + 8 * j; const LAS float* s = scr + (8 * c) * 33 + n;
        v4u o; o.x = pk2(s[0 * 33], s[1 * 33]); o.y = pk2(s[2 * 33], s[3 * 33]); o.z = pk2(s[4 * 33], s[5 * 33]); o.w = pk2(s[6 * 33], s[7 * 33]);
        *(GAS v4u*)(WT + (size_t)(n0 + n) * K + k0 + 8 * c) = o; }
    LDS_WAIT(); asm volatile("" ::: "memory");
}
__device__ __forceinline__ void rms_row_to_bf16(const float* xrow, const float* gain, bf16* orow, int lane) {
    const GAS f32x4* xr = (const GAS f32x4*)xrow + lane; const GAS f32x4* gr = (const GAS f32x4*)gain + lane;
    f32x4 v[4]; float s = 0.f;
#pragma unroll
    for (int j = 0; j < 4; ++j) { v[j] = xr[64 * j]; s += (v[j].x * v[j].x + v[j].y * v[j].y) + (v[j].z * v[j].z + v[j].w * v[j].w); }
    const float rstd = __builtin_amdgcn_rsqf(wave_sum(s) * (1.f / D) + RMS_EPS);
    GAS unsigned long long* o8 = (GAS unsigned long long*)orow + lane;
#pragma unroll
    for (int j = 0; j < 4; ++j) { const f32x4 gg = gr[64 * j]; const f32x4 y = v[j] * rstd * gg;
        o8[64 * j] = (unsigned long long)pk2(y.x, y.y) | ((unsigned long long)pk2(y.z, y.w) << 32); }
}

__device__ __forceinline__ void attn_naive(const bf16* PROJ, bf16* MIX, const float* gqa, const float* gka, const float* gqb, const float* gkb, const float* sinks, int gtid, int nthr) {
    float mqa = 0.f, mka = 0.f, mqb = 0.f, mkb = 0.f;
    for (int d = 0; d < HD; ++d) { mqa = __builtin_fmaxf(mqa, __builtin_fabsf(gqa[d])); mka = __builtin_fmaxf(mka, __builtin_fabsf(gka[d])); mqb = __builtin_fmaxf(mqb, __builtin_fabsf(gqb[d])); mkb = __builtin_fmaxf(mkb, __builtin_fabsf(gkb[d])); }
    const float shiftA = pg8::C2 * 64.f * mqa * mka, shiftB = pg8::C2 * 64.f * mqb * mkb;
    for (long item = gtid; item < (long)M * 16; item += nthr) {
        const int hh = (int)(item / M), m = (int)(item % M), t = m & (SEQ - 1), rowbase = m - t;
        const bool isA = hh < 8; const int h = hh & 7;
        const int qcol = isA ? COL_QA + h * 64 : COL_QB + h * 64, kcol = isA ? COL_KA + (h >> 2) * 64 : COL_KB + h * 64, vcol = isA ? COL_VA + (h >> 2) * 64 : COL_VB + h * 64;
        const float shift = isA ? shiftA : shiftB;
        float q[64], o[64]; float l = 0.f;
        { const v4u* qp = (const v4u*)(PROJ + (size_t)m * NPROJ + qcol);
#pragma unroll
          for (int c = 0; c < 8; ++c) { const v4u u = qp[c]; q[8 * c + 0] = bf_lo(u.x); q[8 * c + 1] = bf_hi(u.x); q[8 * c + 2] = bf_lo(u.y); q[8 * c + 3] = bf_hi(u.y); q[8 * c + 4] = bf_lo(u.z); q[8 * c + 5] = bf_hi(u.z); q[8 * c + 6] = bf_lo(u.w); q[8 * c + 7] = bf_hi(u.w); } }
#pragma unroll
        for (int d = 0; d < 64; ++d) o[d] = 0.f;
#define KEY(srow, wgt) do { const v4u* kp = (const v4u*)(PROJ + (size_t)(rowbase + (srow)) * NPROJ + kcol); float sc = 0.f; \
        _Pragma("unroll") for (int c = 0; c < 8; ++c) { const v4u u = kp[c]; sc += q[8 * c + 0] * bf_lo(u.x) + q[8 * c + 1] * bf_hi(u.x) + q[8 * c + 2] * bf_lo(u.y) + q[8 * c + 3] * bf_hi(u.y) + q[8 * c + 4] * bf_lo(u.z) + q[8 * c + 5] * bf_hi(u.z) + q[8 * c + 6] * bf_lo(u.w) + q[8 * c + 7] * bf_hi(u.w); } \
        const float p = (wgt) * __builtin_amdgcn_exp2f(sc - shift); l += p; const v4u* vp = (const v4u*)(PROJ + (size_t)(rowbase + (srow)) * NPROJ + vcol); \
        _Pragma("unroll") for (int c = 0; c < 8; ++c) { const v4u u = vp[c]; o[8 * c + 0] += p * bf_lo(u.x); o[8 * c + 1] += p * bf_hi(u.x); o[8 * c + 2] += p * bf_lo(u.y); o[8 * c + 3] += p * bf_hi(u.y); o[8 * c + 4] += p * bf_lo(u.z); o[8 * c + 5] += p * bf_hi(u.z); o[8 * c + 6] += p * bf_lo(u.w); o[8 * c + 7] += p * bf_hi(u.w); } } while (0)
        if (isA) {
            for (int dist = 0; dist <= 127 && dist <= t; ++dist) KEY(t - dist, 1.0f);
            l += __builtin_amdgcn_exp2f(sinks[h] * 1.4426950408889634f - shift);
        } else {
            for (int dist = 0; dist <= 128 && dist <= t; ++dist) { const float w = 1.0f + (((dist & 3) == 0) ? 1.0f : 0.0f) + (((dist & 15) == 0) ? 1.0f : 0.0f); KEY(t - dist, w); }
            for (int dist = 132; dist <= 512 && dist <= t; dist += 4) { const float w = 1.0f + (((dist & 15) == 0) ? 1.0f : 0.0f); KEY(t - dist, w); }
            for (int dist = 528; dist <= t; dist += 16) KEY(t - dist, 1.0f);
        }
#undef KEY
        const float rl = 1.0f / l;
        v4u* op = (v4u*)(MIX + (size_t)m * D + hh * 64);
#pragma unroll
        for (int c = 0; c < 8; ++c) { v4u u; u.x = pk2(o[8 * c + 0] * rl, o[8 * c + 1] * rl); u.y = pk2(o[8 * c + 2] * rl, o[8 * c + 3] * rl); u.z = pk2(o[8 * c + 4] * rl, o[8 * c + 5] * rl); u.w = pk2(o[8 * c + 6] * rl, o[8 * c + 7] * rl); op[c] = u; }
    }
}

struct Args { const float* in[13]; float* out; unsigned char* ws; int ph_lo, ph_hi, li, pad; };
__global__ void __launch_bounds__(NWAVES * 64, 2) hymba_fwd(Args args) {
    extern __shared__ __attribute__((aligned(16))) unsigned char lds[];
    LAS unsigned char* L = (LAS unsigned char*)lds;
    volatile LAS unsigned* MISC = (volatile LAS unsigned*)(L + MISC_OFF);
    const int tid = threadIdx.x, lane = tid & 63, wave = __builtin_amdgcn_readfirstlane(tid >> 6);
    const int G = gridDim.x; const int bx = blockIdx.x; const int vcu = (G % 8 == 0) ? (bx % 8) * (G / 8) + bx / 8 : bx;
    unsigned char* ws = args.ws;
    gu32* ctl = (gu32*)(ws + WS_CTL);
    const float* x = args.in[0]; const int* positions = (const int*)args.in[1]; const float* g_attn = args.in[2]; const float* w_in = args.in[3];
    const float* gqa = args.in[4]; const float* gka = args.in[5]; const float* sinks = args.in[6]; const float* gqb = args.in[7]; const float* gkb = args.in[8];
    const float* w_out = args.in[9]; const float* g_mlp = args.in[10]; const float* w_up = args.in[11]; const float* w_dn = args.in[12];
    float* out = args.out;
    bf16* Win_t = (bf16*)(ws + WS_WIN); bf16* Wout_t = (bf16*)(ws + WS_WOUT); bf16* Wup_t = (bf16*)(ws + WS_WUP); bf16* Wdn_t = (bf16*)(ws + WS_WDN);
    float* rope = (float*)(ws + WS_ROPE); float* ssp = (float*)(ws + WS_SS);
    bf16* XN = (bf16*)(ws + WS_XN); bf16* PROJ = (bf16*)(ws + WS_PROJ); bf16* MIXB = (bf16*)(ws + WS_MIX); bf16* HID = (bf16*)(ws + WS_HID);
    for (int u = tid; u < (LDS_BYTES - LDSCTL_OFF) / 4; u += NWAVES * 64) ((LAS unsigned*)(L + LDSCTL_OFF))[u] = 0u;
    __syncthreads();
    const int bli = (N_LAUNCHES == PER_PHASE) ? 0 : args.li;
    XcdBarrier bar; bar.bar = (unsigned*)(ctl + CW_BAR) + bli * XCD_BAR_WORDS; bar.x = 0; bar.st = nullptr;
    if (N_LAUNCHES != PER_PHASE) bar = xcd_barrier_post((unsigned*)(ctl + CW_BAR) + bli * XCD_BAR_WORDS, MISC + 8);
#define GRID_BAR(seam) do { if (N_LAUNCHES == PER_PHASE) { if (tid == 0) __hip_atomic_store(ctl + CW_TMO, 0xBADBA0u | (unsigned)(seam), RLX_AGENT); } else { xcd_barrier(bar); } } while (0)
    const int lo = args.ph_lo, hi = args.ph_hi;
#define IN(k) (lo <= (k) && (k) < hi)
#define BOTH(k) (IN(k) && IN((k) + 1))

    if (IN(0)) {
        LAS float* scr = (LAS float*)(L + RING_OFF + wave * 16384);
        const int gw = vcu * NWAVES + wave, NGW = G * NWAVES;
        constexpr int I_IN = (D / 64) * (NPROJ / 32), I_OUT = (D / 64) * (D / 32), I_UP = (D / 64) * (FF / 32), I_DN = (FF / 64) * (D / 32);
        constexpr int NITEMS = I_IN + I_OUT + I_UP + I_DN;
        for (int it = gw; it < NITEMS; it += NGW) {
            int r = it;
            if (r < I_IN) { p0_transpose_item(w_in, D, NPROJ, Win_t, nullptr, scr, r, lane); continue; } r -= I_IN;
            if (r < I_OUT) { p0_transpose_item(w_out, D, D, Wout_t, nullptr, scr, r, lane); continue; } r -= I_OUT;
            if (r < I_UP) { p0_transpose_item(w_up, D, FF, Wup_t, g_mlp, scr, r, lane); continue; } r -= I_UP;
            p0_transpose_item(w_dn, FF, D, Wdn_t, nullptr, scr, r, lane);
        }
        for (int m = gw; m < M; m += NGW) rms_row_to_bf16(x + (size_t)m * D, g_attn, XN + (size_t)m * D, lane);
        for (int it = gw * 64 + lane; it < M * 8; it += NGW * 64) {
            const int m = it >> 3, i = it & 7;
            const float inv_freq = (i == 0) ? 1.0f : (i == 1) ? 0.193922743f : (i == 2) ? 0.0376060307f : (i == 3) ? 0.00729266461f : (i == 4) ? 0.00141421356f : (i == 5) ? 0.000274248188f : (i == 6) ? 5.3182961e-05f : 1.03133862e-05f;
            const float ang = (float)positions[m] * inv_freq;
            double rev = (double)ang * 0.15915494309189535; rev -= __builtin_floor(rev);
            const float rf = (float)rev;
            rope[(size_t)m * 16 + i] = __builtin_amdgcn_cosf(rf); rope[(size_t)m * 16 + 8 + i] = __builtin_amdgcn_sinf(rf);
        }
        if (BOTH(0)) GRID_BAR(0);
    }
    if (IN(1)) {
        pg8::Gemm g{XN, Win_t, M, NPROJ, D}; pg8::StaticOrder S; S.init(M, NPROJ, G, (int)blockIdx.x);
        pg8::EpiQKV E{PROJ, NPROJ, gqa, gka, gqb, gkb, rope};
        pg8::gemm_phase<pg8::EpiQKV, pg8::StaticOrder, true>(L + RING_OFF, g, S, E);
        if (BOTH(1)) GRID_BAR(1);
    }
    if (IN(2)) {
        attn_naive(PROJ, MIXB, gqa, gka, gqb, gkb, sinks, vcu * (NWAVES * 64) + tid, G * NWAVES * 64);
        if (BOTH(2)) GRID_BAR(2);
    }
    if (IN(3)) {
        pg8::Gemm g{MIXB, Wout_t, M, D, D}; pg8::StaticOrder S; S.init(M, D, G, (int)blockIdx.x);
        pg8::EpiOut E{x, out, XN, ssp, D};
        pg8::gemm_phase<pg8::EpiOut, pg8::StaticOrder, true>(L + RING_OFF, g, S, E);
        if (BOTH(3)) GRID_BAR(3);
    }
    if (IN(4)) {
        pg8::Gemm g{XN, Wup_t, M, FF, D}; pg8::StaticOrder S; S.init(M, FF, G, (int)blockIdx.x);
        pg8::EpiUp E{ssp, HID, FF, 1.0f / D, RMS_EPS};
        pg8::gemm_phase<pg8::EpiUp, pg8::StaticOrder, true>(L + RING_OFF, g, S, E);
        if (BOTH(4)) GRID_BAR(4);
    }
    if (IN(5)) {
        pg8::Gemm g{HID, Wdn_t, M, D, FF}; pg8::StaticOrder S; S.init(M, D, G, (int)blockIdx.x);
        pg8::EpiDown E{out, D};
        pg8::gemm_phase<pg8::EpiDown, pg8::StaticOrder, true>(L + RING_OFF, g, S, E);
    }
#undef IN
#undef BOTH
}

extern "C" void kernel_launch(void* const* d_in, const int* in_sizes, int n_in, void* d_out, int out_size, void* d_ws, size_t ws_size, hipStream_t stream) {
    static int grid = 0;
    if (grid == 0) {
        if (n_in != 13 || in_sizes[0] != M * D || out_size != M * D || ws_size < WS_END) { fprintf(stderr, "kernel_launch: shape/workspace mismatch (n_in %d in0 %d out %d ws %zu); nothing launched\n", n_in, n_in > 0 ? in_sizes[0] : -1, out_size, ws_size); grid = -1; return; }
        int dev = 0, cus = 0, per_cu = 0;
        if (hipGetDevice(&dev) != hipSuccess || hipDeviceGetAttribute(&cus, hipDeviceAttributeMultiprocessorCount, dev) != hipSuccess) { fprintf(stderr, "kernel_launch: device query failed\n"); grid = -1; return; }
        if (hipFuncSetAttribute((const void*)hymba_fwd, hipFuncAttributeMaxDynamicSharedMemorySize, LDS_BYTES) != hipSuccess) { fprintf(stderr, "kernel_launch: hipFuncSetAttribute failed\n"); grid = -1; return; }
        if (hipOccupancyMaxActiveBlocksPerMultiprocessor(&per_cu, (const void*)hymba_fwd, NWAVES * 64, LDS_BYTES) != hipSuccess || per_cu < 1)
            fprintf(stderr, "kernel_launch: note: occupancy query reports %d workgroups per CU\n", per_cu);
        (void)hipGetLastError();
        grid = cus;
    }
    if (grid < 0) return;
    if (hipMemsetAsync((char*)d_ws + WS_CTL, 0, CTL_ZERO_BYTES, stream) != hipSuccess) { fprintf(stderr, "kernel_launch: hipMemsetAsync failed\n"); return; }
    Args a{};
    for (int i = 0; i < 13; ++i) a.in[i] = (const float*)d_in[i];
    a.out = (float*)d_out; a.ws = (unsigned char*)d_ws;
    static_assert(N_LAUNCHES == 1 || N_LAUNCHES == PER_PHASE, "MK_N_LAUNCHES must be 1 or 6");
    for (int li = 0; li < N_LAUNCHES; ++li) {
        a.ph_lo = (N_LAUNCHES == PER_PHASE) ? li : 0; a.ph_hi = (N_LAUNCHES == PER_PHASE) ? li + 1 : PER_PHASE; a.li = li;
        hipLaunchKernelGGL(hymba_fwd, dim3(grid), dim3(NWAVES * 64), LDS_BYTES, stream, a);
        const hipError_t le = hipPeekAtLastError();
        if (le != hipSuccess) { fprintf(stderr, "kernel_launch: launch %d failed: %s\n", li, hipGetErrorName(le)); break; }
    }
}
```

```cpp
#include <hip/hip_runtime.h>
#include <cstdio>
#include <cstdint>

#ifndef MK_N_LAUNCHES
#define MK_N_LAUNCHES 1
#endif

namespace pg8 {
#define PG8_LAS __attribute__((address_space(3)))
typedef unsigned short bf16_t;
typedef short bf16x8 __attribute__((ext_vector_type(8)));
typedef float f32x4 __attribute__((ext_vector_type(4)));
typedef unsigned u32x4 __attribute__((ext_vector_type(4)));
constexpr int BM = 256, BK = 64, HALF = 128, HTB = HALF * BK * 2  , STAGE_BYTES = 8 * HTB, NXCD = 8, WGM = 8;

__host__ __device__ __forceinline__ int lds_byte(int r, int c) { const int st = (r >> 4) * 2 + (c >> 5), rr = r & 15, cc = c & 31, ob = rr * 64 + cc * 2; return st * 1024 + (ob ^ (((ob >> 9) & 1) << 5)); }
__host__ __device__ __forceinline__ void stage_rc(int b, int& R, int& C) { const int st = b / 1024, sb = b % 1024, swz = sb ^ (((sb >> 9) & 1) << 5); R = (st >> 1) * 16 + swz / 64; C = (st & 1) * 32 + (swz % 64) / 2; }
__host__ __device__ __forceinline__ int perm32(int rho) { const int n = rho >> 4, i = rho & 15; return 8 * (i >> 2) + 4 * n + (i & 3); }

struct Unit { int pm, pn; };
struct Gemm { const bf16_t* A; const bf16_t* Bt; int M, N, K; };

struct StaticOrder {
    int nM, nN, nwg, G, c;
    __host__ __device__ void init(int M, int N, int G_, int c_) { nM = M / BM; nN = N / BM; nwg = nM * nN; G = G_; c = c_; }
    __host__ __device__ bool next(int i, Unit& u) const {
        const long L = (long)i * G + c; if (L >= nwg) return false;
        int wgid = (int)L; { const int q = nwg / NXCD, r = nwg % NXCD, xcd = wgid % NXCD, off = wgid / NXCD; wgid = (xcd < r ? xcd * (q + 1) : r * (q + 1) + (xcd - r) * q) + off; }
        const int nig = WGM * nN, gid = wgid / nig, fm = gid * WGM, gsz = (nM - fm) < WGM ? (nM - fm) : WGM;
        u.pm = fm + ((wgid % nig) % gsz); u.pn = (wgid % nig) / gsz; return true;
    }
};

__device__ __forceinline__ unsigned cvt_pk_bf16(float lo, float hi) { unsigned r; asm volatile("v_cvt_pk_bf16_f32 %0, %1, %2" : "=v"(r) : "v"(lo), "v"(hi)); return r; }

constexpr float QK_EPS = 1e-6f;
constexpr float C2 = 0.125f * 1.4426950408889634f;

struct EpiQKV {
    bf16_t* O; int ldc; const float* gqa; const float* gka; const float* gqb; const float* gkb; const float* rope;
    __device__ __forceinline__ void operator()(const f32x4 (&acc)[2][2][4][2], const Unit& u, int wr, int wc, int fr, int fq) const {
        const int pn = u.pn; int mode = 0; const float* g = gqa;
        if (pn < 2) { mode = 1; g = gqa; } else if (pn == 2) { if (wc < 2) { mode = 2; g = gka; } } else if (pn < 5) { mode = 1; g = gqb; } else if (pn < 7) { mode = 2; g = gkb; }
        const int row0 = u.pm * BM + wr * 64 + fr, col0 = pn * BM + wc * 64 + 8 * fq;
        if (mode == 0) {
#pragma unroll
            for (int ai = 0; ai < 2; ++ai)
#pragma unroll
                for (int m = 0; m < 4; ++m) { bf16_t* rowp = O + (size_t)(row0 + ai * HALF + m * 16) * ldc + col0;
#pragma unroll
                    for (int bj = 0; bj < 2; ++bj) { const f32x4 v0 = acc[ai][bj][m][0], v1 = acc[ai][bj][m][1]; u32x4 w;
                        w.x = cvt_pk_bf16(v0[0], v0[1]); w.y = cvt_pk_bf16(v0[2], v0[3]); w.z = cvt_pk_bf16(v1[0], v1[1]); w.w = cvt_pk_bf16(v1[2], v1[3]);
                        *(u32x4*)(rowp + bj * 32) = w; } }
            return;
        }
        f32x4 gv[2][2];
#pragma unroll
        for (int bj = 0; bj < 2; ++bj)
#pragma unroll
            for (int n = 0; n < 2; ++n) gv[bj][n] = *(const f32x4*)(g + 32 * bj + 8 * fq + 4 * n);
        const float sc = (mode == 1) ? C2 : 1.0f;
        const float sgn = (fq == 0) ? -1.0f : 1.0f;
#pragma unroll
        for (int ai = 0; ai < 2; ++ai)
#pragma unroll
            for (int m = 0; m < 4; ++m) {
                const int row = row0 + ai * HALF + m * 16;
                float ss = 0.f;
#pragma unroll
                for (int bj = 0; bj < 2; ++bj)
#pragma unroll
                    for (int n = 0; n < 2; ++n) { const f32x4 x = acc[ai][bj][m][n]; ss += (x[0] * x[0] + x[1] * x[1]) + (x[2] * x[2] + x[3] * x[3]); }
                ss += __shfl_xor(ss, 16); ss += __shfl_xor(ss, 32);
                const float rs = __builtin_amdgcn_rsqf(ss * (1.0f / 64.0f) + QK_EPS);
                f32x4 y[2][2];
#pragma unroll
                for (int bj = 0; bj < 2; ++bj)
#pragma unroll
                    for (int n = 0; n < 2; ++n) y[bj][n] = acc[ai][bj][m][n] * rs * gv[bj][n];
                const f32x4 c0 = *(const f32x4*)(rope + (size_t)row * 16), c1 = *(const f32x4*)(rope + (size_t)row * 16 + 4);
                const f32x4 s0 = *(const f32x4*)(rope + (size_t)row * 16 + 8), s1 = *(const f32x4*)(rope + (size_t)row * 16 + 12);
                f32x4 p0, p1;
#pragma unroll
                for (int e = 0; e < 4; ++e) { p0[e] = __shfl_xor(y[0][0][e], 16); p1[e] = __shfl_xor(y[0][1][e], 16); }
                if (fq < 2) { y[0][0] = y[0][0] * c0 + p0 * s0 * sgn; y[0][1] = y[0][1] * c1 + p1 * s1 * sgn; }
                bf16_t* rowp = O + (size_t)row * ldc + col0;
#pragma unroll
                for (int bj = 0; bj < 2; ++bj) { const f32x4 v0 = y[bj][0] * sc, v1 = y[bj][1] * sc; u32x4 w;
                    w.x = cvt_pk_bf16(v0[0], v0[1]); w.y = cvt_pk_bf16(v0[2], v0[3]); w.z = cvt_pk_bf16(v1[0], v1[1]); w.w = cvt_pk_bf16(v1[2], v1[3]);
                    *(u32x4*)(rowp + bj * 32) = w; }
            }
    }
};

struct EpiOut {
    const float* x; float* h; bf16_t* hb; float* ssp; int ldc;
    __device__ __forceinline__ void operator()(const f32x4 (&acc)[2][2][4][2], const Unit& u, int wr, int wc, int fr, int fq) const {
        const int row0 = u.pm * BM + wr * 64 + fr, col0 = u.pn * BM + wc * 64 + 8 * fq;
#pragma unroll
        for (int ai = 0; ai < 2; ++ai)
#pragma unroll
            for (int m = 0; m < 4; ++m) {
                const int row = row0 + ai * HALF + m * 16; const size_t off = (size_t)row * ldc + col0; float ss = 0.f;
#pragma unroll
                for (int bj = 0; bj < 2; ++bj) {
                    const f32x4 x0 = *(const f32x4*)(x + off + bj * 32), x1 = *(const f32x4*)(x + off + bj * 32 + 4);
                    const f32x4 v0 = acc[ai][bj][m][0] + x0, v1 = acc[ai][bj][m][1] + x1;
                    *(f32x4*)(h + off + bj * 32) = v0; *(f32x4*)(h + off + bj * 32 + 4) = v1;
                    u32x4 w; w.x = cvt_pk_bf16(v0[0], v0[1]); w.y = cvt_pk_bf16(v0[2], v0[3]); w.z = cvt_pk_bf16(v1[0], v1[1]); w.w = cvt_pk_bf16(v1[2], v1[3]);
                    *(u32x4*)(hb + off + bj * 32) = w;
                    ss += (v0[0] * v0[0] + v0[1] * v0[1]) + (v0[2] * v0[2] + v0[3] * v0[3]) + (v1[0] * v1[0] + v1[1] * v1[1]) + (v1[2] * v1[2] + v1[3] * v1[3]);
                }
                ss += __shfl_xor(ss, 16); ss += __shfl_xor(ss, 32);
                if (fq == 0) ssp[(size_t)row * 16 + u.pn * 4 + wc] = ss;
            }
    }
};

struct EpiUp {
    const float* ssp; bf16_t* hid; int ldc; float inv_n, eps;
    __device__ __forceinline__ void operator()(const f32x4 (&acc)[2][2][4][2], const Unit& u, int wr, int wc, int fr, int fq) const {
        const int row0 = u.pm * BM + wr * 64 + fr, col0 = u.pn * BM + wc * 64 + 8 * fq;
#pragma unroll
        for (int ai = 0; ai < 2; ++ai)
#pragma unroll
            for (int m = 0; m < 4; ++m) {
                const int row = row0 + ai * HALF + m * 16;
                const f32x4 a = *(const f32x4*)(ssp + (size_t)row * 16), b = *(const f32x4*)(ssp + (size_t)row * 16 + 4), c = *(const f32x4*)(ssp + (size_t)row * 16 + 8), d = *(const f32x4*)(ssp + (size_t)row * 16 + 12);
                const f32x4 t = (a + b) + (c + d); const float ss = (t[0] + t[1]) + (t[2] + t[3]);
                const float rs = __builtin_amdgcn_rsqf(ss * inv_n + eps);
                bf16_t* rowp = hid + (size_t)row * ldc + col0;
#pragma unroll
                for (int bj = 0; bj < 2; ++bj) { f32x4 v0 = acc[ai][bj][m][0] * rs, v1 = acc[ai][bj][m][1] * rs;
#pragma unroll
                    for (int e = 0; e < 4; ++e) { const float r0 = __builtin_fmaxf(v0[e], 0.f), r1 = __builtin_fmaxf(v1[e], 0.f); v0[e] = r0 * r0; v1[e] = r1 * r1; }
                    u32x4 w; w.x = cvt_pk_bf16(v0[0], v0[1]); w.y = cvt_pk_bf16(v0[2], v0[3]); w.z = cvt_pk_bf16(v1[0], v1[1]); w.w = cvt_pk_bf16(v1[2], v1[3]);
                    *(u32x4*)(rowp + bj * 32) = w; }
            }
    }
};

struct EpiDown {
    float* out; int ldc;
    __device__ __forceinline__ void operator()(const f32x4 (&acc)[2][2][4][2], const Unit& u, int wr, int wc, int fr, int fq) const {
        const int row0 = u.pm * BM + wr * 64 + fr, col0 = u.pn * BM + wc * 64 + 8 * fq;
#pragma unroll
        for (int ai = 0; ai < 2; ++ai)
#pragma unroll
            for (int m = 0; m < 4; ++m) {
                const size_t off = (size_t)(row0 + ai * HALF + m * 16) * ldc + col0;
#pragma unroll
                for (int bj = 0; bj < 2; ++bj) {
                    const f32x4 h0 = *(const f32x4*)(out + off + bj * 32), h1 = *(const f32x4*)(out + off + bj * 32 + 4);
                    *(f32x4*)(out + off + bj * 32) = h0 + acc[ai][bj][m][0]; *(f32x4*)(out + off + bj * 32 + 4) = h1 + acc[ai][bj][m][1];
                }
            }
    }
};

template <class Epi, class Sched, bool ALIGN_EPI>
__device__ __forceinline__ void gemm_phase(PG8_LAS unsigned char* lds, const Gemm g, const Sched& S, const Epi& E) {
    const int tid = threadIdx.x, wid = __builtin_amdgcn_readfirstlane(tid >> 6), lane = tid & 63, wr = wid >> 2, wc = wid & 3, fr = lane & 15, fq = lane >> 4;
    const int K = g.K, nt = K / BK;
    unsigned voffA[2], voffB[2];
#pragma unroll
    for (int i = 0; i < 2; ++i) { int R, C; stage_rc(tid * 16 + i * 8192, R, C); const int Rb = (R >> 5) * 64 + perm32(R & 31);
        voffA[i] = (unsigned)(R * K + C) * 2u; voffB[i] = (unsigned)(Rb * K + C) * 2u; }
    const size_t kstep = (size_t)(BK * 2);
    const size_t hstepA = (size_t)HALF * K * 2;
    const size_t hstepB = (size_t)32 * K * 2;
    const size_t tstep = (size_t)BM * K * 2;
    const unsigned ldsw = (unsigned)wid * 1024u;
    const int aoff = lds_byte(wr * 64 + fr, fq * 8), boff = lds_byte(wc * 32 + fr, fq * 8);
#define PG8_SA(b, h) (((b) * 2 + (h)) * HTB)
#define PG8_SB(b, h) ((4 + (b) * 2 + (h)) * HTB)
#define PG8_STAGE(bufoff, gbase, voff) do { _Pragma("unroll") for (int _i = 0; _i < 2; ++_i) \
        __builtin_amdgcn_global_load_lds((const unsigned*)((const char*)(gbase) + (voff)[_i]), (PG8_LAS unsigned*)(lds + (bufoff) + ldsw + _i * 8192), 16, 0, 0); } while (0)
#define PG8_LDA(dst, b, h) do { _Pragma("unroll") for (int m = 0; m < 4; ++m) _Pragma("unroll") for (int k = 0; k < 2; ++k) dst[m][k] = *(const PG8_LAS bf16x8*)(lds + PG8_SA(b, h) + aoff + m * 2048 + k * 1024); } while (0)
#define PG8_LDB(dst, b, h) do { _Pragma("unroll") for (int n = 0; n < 2; ++n) _Pragma("unroll") for (int k = 0; k < 2; ++k) dst[n][k] = *(const PG8_LAS bf16x8*)(lds + PG8_SB(b, h) + boff + n * 2048 + k * 1024); } while (0)
#define PG8_MMA(ai, bj, At, Bt) do { __builtin_amdgcn_s_setprio(1); _Pragma("unroll") for (int m = 0; m < 4; ++m) _Pragma("unroll") for (int n = 0; n < 2; ++n) _Pragma("unroll") for (int k = 0; k < 2; ++k) \
        acc[ai][bj][m][n] = __builtin_amdgcn_mfma_f32_16x16x32_bf16(Bt[n][k], At[m][k], acc[ai][bj][m][n], 0, 0, 0); __builtin_amdgcn_s_setprio(0); } while (0)
#define PG8_WAIT_V(n) asm volatile("s_waitcnt vmcnt(" #n ")" ::: "memory")
#define PG8_WAIT_L(n) asm volatile("s_waitcnt lgkmcnt(" #n ")" ::: "memory")
#define PG8_BAR __builtin_amdgcn_s_barrier()
#define PG8_SCHED __builtin_amdgcn_sched_barrier(0)
    Unit cur, nxt; int ui = 0;
    if (!S.next(0, cur)) return;
    f32x4 acc[2][2][4][2];
#pragma unroll
    for (int a = 0; a < 2; ++a)
#pragma unroll
        for (int b = 0; b < 2; ++b)
#pragma unroll
            for (int m = 0; m < 4; ++m)
#pragma unroll
                for (int n = 0; n < 2; ++n) acc[a][b][m][n] = (f32x4){0.f, 0.f, 0.f, 0.f};
    bf16x8 At[4][2], B0[2][2], B1[2][2];
    const char* cA = (const char*)g.A + (size_t)cur.pm * tstep; const char* cB = (const char*)g.Bt + (size_t)cur.pn * tstep;
    PG8_STAGE(PG8_SB(0, 0), cB, voffB); PG8_STAGE(PG8_SB(0, 1), cB + hstepB, voffB); PG8_STAGE(PG8_SA(0, 0), cA, voffA); PG8_STAGE(PG8_SA(0, 1), cA + hstepA, voffA);
    if (wr == 1) PG8_BAR;
    PG8_WAIT_V(2); PG8_BAR;
    PG8_STAGE(PG8_SB(1, 0), cB + kstep, voffB); PG8_STAGE(PG8_SA(1, 0), cA + kstep, voffA); PG8_STAGE(PG8_SB(1, 1), cB + hstepB + kstep, voffB);
    PG8_WAIT_V(6); PG8_BAR;
    for (;;) {
        const bool has_next = S.next(ui + 1, nxt);
        const char* nA = has_next ? (const char*)g.A + (size_t)nxt.pm * tstep : cA; const char* nB = has_next ? (const char*)g.Bt + (size_t)nxt.pn * tstep : cB;
        for (int t = 0; t < nt; t += 2) {
            const bool last = (t == nt - 2);
            const char* a1 = cA + (size_t)(t + 1) * kstep;
            const char* a2 = last ? nA : cA + (size_t)(t + 2) * kstep; const char* b2 = last ? nB : cB + (size_t)(t + 2) * kstep;
            const char* a3 = a2 + kstep; const char* b3 = b2 + kstep;
            PG8_LDB(B0, 0, 0); PG8_LDB(B1, 0, 1); PG8_SCHED; PG8_LDA(At, 0, 0); PG8_STAGE(PG8_SA(1, 1), a1 + hstepA, voffA);
            PG8_WAIT_V(8); PG8_WAIT_L(0); PG8_BAR; PG8_MMA(0, 0, At, B0); PG8_MMA(0, 1, At, B1); PG8_BAR; PG8_SCHED;
            PG8_LDA(At, 0, 1); PG8_STAGE(PG8_SB(0, 0), b2, voffB); PG8_STAGE(PG8_SB(0, 1), b2 + hstepB, voffB); PG8_STAGE(PG8_SA(0, 0), a2, voffA);
            PG8_WAIT_V(8); PG8_WAIT_L(0); PG8_BAR; PG8_MMA(1, 0, At, B0); PG8_MMA(1, 1, At, B1); PG8_BAR; PG8_SCHED;
            PG8_LDB(B0, 1, 0); PG8_LDB(B1, 1, 1); PG8_SCHED; PG8_LDA(At, 1, 0); PG8_STAGE(PG8_SA(0, 1), a2 + hstepA, voffA);
            PG8_WAIT_V(8); PG8_WAIT_L(0); PG8_BAR; PG8_MMA(0, 0, At, B0); PG8_MMA(0, 1, At, B1); PG8_BAR; PG8_SCHED;
            PG8_LDA(At, 1, 1); PG8_STAGE(PG8_SB(1, 0), b3, voffB); PG8_STAGE(PG8_SB(1, 1), b3 + hstepB, voffB); PG8_STAGE(PG8_SA(1, 0), a3, voffA);
            PG8_WAIT_V(8); PG8_WAIT_L(0); PG8_BAR; PG8_MMA(1, 0, At, B0); PG8_MMA(1, 1, At, B1); PG8_BAR; PG8_SCHED;
        }
        if constexpr (ALIGN_EPI) { if (wr == 0) PG8_BAR; }
        E(acc, cur, wr, wc, fr, fq);
        if (!has_next) break;
#pragma unroll
        for (int a = 0; a < 2; ++a)
#pragma unroll
            for (int b = 0; b < 2; ++b)
#pragma unroll
                for (int m = 0; m < 4; ++m)
#pragma unroll
                    for (int n = 0; n < 2; ++n) acc[a][b][m][n] = (f32x4){0.f, 0.f, 0.f, 0.f};
        cur = nxt; cA = nA; cB = nB; ++ui;
        if constexpr (ALIGN_EPI) { if (wr == 1) PG8_BAR; }
    }
    PG8_WAIT_V(0);
    if constexpr (!ALIGN_EPI) { if (wr == 0) PG8_BAR; }
    PG8_BAR;
#undef PG8_SA
#undef PG8_SB
#undef PG8_STAGE
#undef PG8_LDA
#undef PG8_LDB
#undef PG8_MMA
#undef PG8_WAIT_V
#undef PG8_WAIT_L
#undef PG8_BAR
#undef PG8_SCHED
}
}

constexpr int NWAVES = 8;
constexpr int BATCH = 32, SEQ = 2048, D = 1024, FF = 4096, HD = 64;
constexpr int M = BATCH * SEQ;
constexpr int NPROJ = 2304;
constexpr int COL_QA = 0, COL_KA = 512, COL_VA = 640, COL_QB = 768, COL_KB = 1280, COL_VB = 1792;
constexpr float RMS_EPS = 1e-6f;
constexpr int N_LAUNCHES = MK_N_LAUNCHES, PER_PHASE = 6;
constexpr int N_BAR_REGIONS = (MK_N_LAUNCHES == PER_PHASE) ? 1 : MK_N_LAUNCHES;

constexpr size_t MiB = 1u << 20;
constexpr size_t WS_CTL = 0, CTL_ZERO_BYTES = 1 * MiB;
constexpr size_t WS_WIN = 2 * MiB, WS_WOUT = 8 * MiB, WS_WUP = 10 * MiB, WS_WDN = 18 * MiB;
constexpr size_t WS_ROPE = 26 * MiB;
constexpr size_t WS_SS = 30 * MiB;
constexpr size_t WS_XN = 64 * MiB;
constexpr size_t WS_PROJ = 192 * MiB;
constexpr size_t WS_MIX = 480 * MiB;
constexpr size_t WS_HID = 192 * MiB;
constexpr size_t WS_END = 704 * MiB;
static_assert(WS_WIN + (size_t)NPROJ * D * 2 <= WS_WOUT && WS_WDN + (size_t)D * FF * 2 <= WS_ROPE && WS_SS + (size_t)M * 64 <= WS_XN, "d_ws map");
static_assert(WS_XN + (size_t)M * D * 2 <= WS_PROJ && WS_PROJ + (size_t)M * NPROJ * 2 <= WS_MIX && WS_MIX + (size_t)M * D * 2 <= WS_END && WS_HID + (size_t)M * FF * 2 <= WS_END, "d_ws map");
constexpr int CW_TMO = 0, CW_CODE = 1;
constexpr int CW_BAR = 4096;

constexpr int RING_OFF = 0, RING_BYTES = 131072;
constexpr int LDSCTL_OFF = RING_BYTES, MISC_OFF = LDSCTL_OFF + 320;
constexpr int LDS_BYTES = 147456;

#define GAS __attribute__((address_space(1)))
#define LAS __attribute__((address_space(3)))
typedef unsigned short bf16;
typedef unsigned v4u __attribute__((ext_vector_type(4)));
typedef float f32x4 __attribute__((ext_vector_type(4)));
typedef GAS unsigned gu32;
#define RLX_AGENT __ATOMIC_RELAXED, __HIP_MEMORY_SCOPE_AGENT
#define LDS_WAIT() asm volatile("s_waitcnt lgkmcnt(0)" ::: "memory")
#define VM_WAIT() asm volatile("s_waitcnt vmcnt(0)" ::: "memory")
__device__ __forceinline__ unsigned f2bf(float f) { unsigned u = __builtin_bit_cast(unsigned, f); return (u + 0x7fffu + ((u >> 16) & 1u)) >> 16; }
__device__ __forceinline__ unsigned pk2(float lo, float hi) { return f2bf(lo) | (f2bf(hi) << 16); }
__device__ __forceinline__ float bf_lo(unsigned u) { return __uint_as_float(u << 16); }
__device__ __forceinline__ float bf_hi(unsigned u) { return __uint_as_float(u & 0xffff0000u); }

#define XB_TMO      128
#define XB_XCNT(j)  (256  + 64 * (j))
#define XB_XSUB(j)  (1280 + 64 * (j))
#define XB_XGEN(j)  (2304 + 64 * (j))
#define XB_TOP      3328
#define XB_TOPGEN   3392
#define XCD_BAR_WORDS 3456
#define XB_SPIN_CAP (1u << 18)

__device__ __forceinline__ unsigned xb_ld(unsigned* p)              { return __hip_atomic_load(p, __ATOMIC_RELAXED, __HIP_MEMORY_SCOPE_AGENT); }
__device__ __forceinline__ unsigned xb_add(unsigned* p, unsigned v) { return __hip_atomic_fetch_add(p, v, __ATOMIC_RELAXED, __HIP_MEMORY_SCOPE_AGENT); }
__device__ __forceinline__ unsigned xb_xcc_id() { return (unsigned)__builtin_amdgcn_s_getreg((3 << 11) | 20) & 0xFu; }
#define XB_SPIN(cond, bar) do { unsigned _sp = 0; while (cond) { __builtin_amdgcn_s_sleep(1); \
    if ((++_sp & 255u) == 0u) { if (xb_ld(&(bar)[XB_TMO])) break; if (_sp > XB_SPIN_CAP) { atomicAdd(&(bar)[XB_TMO], 1u); break; } } } } while (0)

struct XcdBarrier { unsigned* bar; unsigned x; volatile LAS unsigned* st; };

__device__ __forceinline__ XcdBarrier xcd_barrier_post(unsigned* bar, volatile LAS unsigned* st) {
    XcdBarrier b; b.bar = bar; b.x = xb_xcc_id(); b.st = st;
    if (threadIdx.x == 0) (void)xb_add(&bar[XB_XCNT(b.x)], 1u);
    return b;
}
__device__ __forceinline__ void xcd_barrier_complete(unsigned* bar, unsigned x, unsigned& nloc, unsigned& nx) {
    const unsigned G = gridDim.x * gridDim.y * gridDim.z;
    unsigned sum, cnt, mine, sp = 0u;
    for (;;) {
        sum = 0u; cnt = 0u; mine = 0u;
#pragma unroll
        for (unsigned j = 0; j < 16; ++j) { const unsigned c = xb_ld(&bar[XB_XCNT(j)]); sum += c; cnt += (c > 0u) ? 1u : 0u; mine = (j == x) ? c : mine; }
        if (sum == G) break;
        __builtin_amdgcn_s_sleep(1);
        if ((++sp & 255u) == 0u) { if (xb_ld(&bar[XB_TMO])) break; if (sp > XB_SPIN_CAP) { atomicAdd(&bar[XB_TMO], 1u); break; } }
    }
    nloc = mine > 0u ? mine : 1u; nx = cnt > 0u ? cnt : 1u;
}
__device__ __forceinline__ void xcd_barrier(const XcdBarrier& b) {
    asm volatile("s_waitcnt vmcnt(0)" ::: "memory");
    __syncthreads();
    if (threadIdx.x == 0) {
        unsigned* bar = b.bar;
        __builtin_amdgcn_s_waitcnt(0);
        unsigned nloc = b.st[0], nx = b.st[1];
        if (nloc == 0u) { xcd_barrier_complete(bar, b.x, nloc, nx); b.st[0] = nloc; b.st[1] = nx; }
        const unsigned old = xb_add(&bar[XB_XSUB(b.x)], 1u);
        const unsigned gen = old / nloc;
        if (old + 1u == (gen + 1u) * nloc) {
            __builtin_amdgcn_fence(__ATOMIC_RELEASE, "agent");
            asm volatile("s_waitcnt vmcnt(0)" ::: "memory");
            const unsigned og = xb_add(&bar[XB_TOP], 1u);
            const unsigned tg = og / nx;
            if (og + 1u == (tg + 1u) * nx) xb_add(&bar[XB_TOPGEN], 1u);
            else XB_SPIN(xb_ld(&bar[XB_TOPGEN]) == tg, bar);
            __builtin_amdgcn_fence(__ATOMIC_ACQUIRE, "agent");
            xb_add(&bar[XB_XGEN(b.x)], 1u);
            asm volatile("s_waitcnt vmcnt(0)" ::: "memory");
        } else {
            XB_SPIN(xb_ld(&bar[XB_XGEN(b.x)]) == gen, bar);
            __builtin_amdgcn_fence(__ATOMIC_ACQUIRE, "agent");
            asm volatile("s_waitcnt vmcnt(0)" ::: "memory");
        }
    }
    __syncthreads();
}

__device__ __forceinline__ float wave_sum(float v) {
#pragma unroll
    for (int o = 1; o < 64; o <<= 1) v += __shfl_xor(v, o);
    return v;
}
__device__ __forceinline__ float wave_max(float v) {
#pragma unroll
    for (int o = 1; o < 64; o <<= 1) v = __builtin_fmaxf(v, __shfl_xor(v, o));
    return v;
}
__device__ __forceinline__ void p0_transpose_item(const float* W, int K, int N, bf16* WT, const float* gk, LAS float* scr, int item, int lane) {
    const int nblk = N / 32, kb = item / nblk, nb = item % nblk, k0 = 64 * kb, n0 = 32 * nb;
#pragma unroll 8
    for (int i = 0; i < 32; ++i) { const int kk = 2 * i + (lane >> 5); float v = W[(size_t)(k0 + kk) * N + n0 + (lane & 31)]; if (gk) v *= gk[k0 + kk]; scr[kk * 33 + (lane & 31)] = v; }
    LDS_WAIT(); asm volatile("" ::: "memory");
    const int c = lane & 7;
#pragma unroll
    for (int j = 0; j < 4; ++j) { const int n = (lane >> 3) + 8 * j; const LAS float* s = scr + (8 * c) * 33 + n;
        v4u o; o.x = pk2(s[0 * 33], s[1 * 33]); o.y = pk2(s[2 * 33], s[3 * 33]); o.z = pk2(s[4 * 33], s[5 * 33]); o.w = pk2(s[6 * 33], s[7 * 33]);
        *(GAS v4u*)(WT + (size_t)(n0 + n) * K + k0 + 8 * c) = o; }
    LDS_WAIT(); asm volatile("" ::: "memory");
}
__device__ __forceinline__ void rms_row_to_bf16(const float* xrow, const float* gain, bf16* orow, int lane) {
    const GAS f32x4* xr = (const GAS f32x4*)xrow + lane; const GAS f32x4* gr = (const GAS f32x4*)gain + lane;
    f32x4 v[4]; float s = 0.f;
#pragma unroll
    for (int j = 0; j < 4; ++j) { v[j] = xr[64 * j]; s += (v[j].x * v[j].x + v[j].y * v[j].y) + (v[j].z * v[j].z + v[j].w * v[j].w); }
    const float rstd = __builtin_amdgcn_rsqf(wave_sum(s) * (1.f / D) + RMS_EPS);
    GAS unsigned long long* o8 = (GAS unsigned long long*)orow + lane;
#pragma unroll
    for (int j = 0; j < 4; ++j) { const f32x4 gg = gr[64 * j]; const f32x4 y = v[j] * rstd * gg;
        o8[64 * j] = (unsigned long long)pk2(y.x, y.y) | ((unsigned long long)pk2(y.z, y.w) << 32); }
}

__device__ __forceinline__ void attn_naive(const bf16* PROJ, bf16* MIX, const float* gqa, const float* gka, const float* gqb, const float* gkb, const float* sinks, int gtid, int nthr) {
    float mqa = 0.f, mka = 0.f, mqb = 0.f, mkb = 0.f;
    for (int d = 0; d < HD; ++d) { mqa = __builtin_fmaxf(mqa, __builtin_fabsf(gqa[d])); mka = __builtin_fmaxf(mka, __builtin_fabsf(gka[d])); mqb = __builtin_fmaxf(mqb, __builtin_fabsf(gqb[d])); mkb = __builtin_fmaxf(mkb, __builtin_fabsf(gkb[d])); }
    const float shiftA = pg8::C2 * 64.f * mqa * mka, shiftB = pg8::C2 * 64.f * mqb * mkb;
    for (long item = gtid; item < (long)M * 16; item += nthr) {
        const int hh = (int)(item / M), m = (int)(item % M), t = m & (SEQ - 1), rowbase = m - t;
        const bool isA = hh < 8; const int h = hh & 7;
        const int qcol = isA ? COL_QA + h * 64 : COL_QB + h * 64, kcol = isA ? COL_KA + (h >> 2) * 64 : COL_KB + h * 64, vcol = isA ? COL_VA + (h >> 2) * 64 : COL_VB + h * 64;
        const float shift = isA ? shiftA : shiftB;
        float q[64], o[64]; float l = 0.f;
        { const v4u* qp = (const v4u*)(PROJ + (size_t)m * NPROJ + qcol);
#pragma unroll
          for (int c = 0; c < 8; ++c) { const v4u u = qp[c]; q[8 * c + 0] = bf_lo(u.x); q[8 * c + 1] = bf_hi(u.x); q[8 * c + 2] = bf_lo(u.y); q[8 * c + 3] = bf_hi(u.y); q[8 * c + 4] = bf_lo(u.z); q[8 * c + 5] = bf_hi(u.z); q[8 * c + 6] = bf_lo(u.w); q[8 * c + 7] = bf_hi(u.w); } }
#pragma unroll
        for (int d = 0; d < 64; ++d) o[d] = 0.f;
#define KEY(srow, wgt) do { const v4u* kp = (const v4u*)(PROJ + (size_t)(rowbase + (srow)) * NPROJ + kcol); float sc = 0.f; \
        _Pragma("unroll") for (int c = 0; c < 8; ++c) { const v4u u = kp[c]; sc += q[8 * c + 0] * bf_lo(u.x) + q[8 * c + 1] * bf_hi(u.x) + q[8 * c + 2] * bf_lo(u.y) + q[8 * c + 3] * bf_hi(u.y) + q[8 * c + 4] * bf_lo(u.z) + q[8 * c + 5] * bf_hi(u.z) + q[8 * c + 6] * bf_lo(u.w) + q[8 * c + 7] * bf_hi(u.w); } \
        const float p = (wgt) * __builtin_amdgcn_exp2f(sc - shift); l += p; const v4u* vp = (const v4u*)(PROJ + (size_t)(rowbase + (srow)) * NPROJ + vcol); \
        _Pragma("unroll") for (int c = 0; c < 8; ++c) { const v4u u = vp[c]; o[8 * c + 0] += p * bf_lo(u.x); o[8 * c + 1] += p * bf_hi(u.x); o[8 * c + 2] += p * bf_lo(u.y); o[8 * c + 3] += p * bf_hi(u.y); o[8 * c + 4] += p * bf_lo(u.z); o[8 * c + 5] += p * bf_hi(u.z); o[8 * c + 6] += p * bf_lo(u.w); o[8 * c + 7] += p * bf_hi(u.w); } } while (0)
        if (isA) {
            for (int dist = 0; dist <= 127 && dist <= t; ++dist) KEY(t - dist, 1.0f);
            l += __builtin_amdgcn_exp2f(sinks[h] * 1.4426950408889634f - shift);
        } else {
            for (int dist = 0; dist <= 128 && dist <= t; ++dist) { const float w = 1.0f + (((dist & 3) == 0) ? 1.0f : 0.0f) + (((dist & 15) == 0) ? 1.0f : 0.0f); KEY(t - dist, w); }
            for (int dist = 132; dist <= 512 && dist <= t; dist += 4) { const float w = 1.0f + (((dist & 15) == 0) ? 1.0f : 0.0f); KEY(t - dist, w); }
            for (int dist = 528; dist <= t; dist += 16) KEY(t - dist, 1.0f);
        }
#undef KEY
        const float rl = 1.0f / l;
        v4u* op = (v4u*)(MIX + (size_t)m * D + hh * 64);
#pragma unroll
        for (int c = 0; c < 8; ++c) { v4u u; u.x = pk2(o[8 * c + 0] * rl, o[8 * c + 1] * rl); u.y = pk2(o[8 * c + 2] * rl, o[8 * c + 3] * rl); u.z = pk2(o[8 * c + 4] * rl, o[8 * c + 5] * rl); u.w = pk2(o[8 * c + 6] * rl, o[8 * c + 7] * rl); op[c] = u; }
    }
}


typedef short a_bf16x8 __attribute__((ext_vector_type(8)));
typedef short a_s16x4 __attribute__((ext_vector_type(4)));
typedef float a_f32x16 __attribute__((ext_vector_type(16)));
typedef float a_f32x2 __attribute__((ext_vector_type(2)));
typedef __bf16 a_bf16x2 __attribute__((ext_vector_type(2)));
__device__ __forceinline__ unsigned a_cvtpk(float lo, float hi) { a_f32x2 v = {lo, hi}; a_bf16x2 b = __builtin_convertvector(v, a_bf16x2); return __builtin_bit_cast(unsigned, b); }
__device__ __forceinline__ a_s16x4 a_vtr(LAS const unsigned char* p) { return __builtin_bit_cast(a_s16x4, __builtin_amdgcn_ds_read_tr16_b64_v4i16((LAS a_s16x4*)p)); }
constexpr int ATT_WLDS = 16384;
constexpr int ATT_STG = 8192, ATT_STG_PITCH = 144;

struct AttnTask { int qrow0, qrs, qcol, kcol, vcol, n1, row1, D01, kt2lo, kt2hi, row2, D02, qstep2, maxd2, orow0, ors, ocol; float shift, sinkterm; };

__device__ __forceinline__ void attn_task(const bf16* __restrict__ PROJ, bf16* __restrict__ MIX, LAS unsigned char* wl, const int lane, const AttnTask& T) {
    const int i = lane & 31, hh = lane >> 5;
    a_bf16x8 qf[4];
    { const bf16* qp = PROJ + (size_t)(T.qrow0 + i * T.qrs) * NPROJ + T.qcol + 8 * hh;
#pragma unroll
      for (int s = 0; s < 4; ++s) qf[s] = *(const a_bf16x8*)(qp + 16 * s); }
    a_f32x16 o0 = {}, o1 = {}; float lsum = 0.f;
    const int Dl1 = T.D01 + i - 4 * hh, Dl2 = T.D02 + T.qstep2 * i - 4 * hh;
    float wg[4];
#pragma unroll
    for (int c = 0; c < 4; ++c) wg[c] = ((Dl1 & 3) == c) ? 1.0f : 0.0f;
    const int nt = T.n1 + (T.kt2hi - T.kt2lo);
    const int klane = i * NPROJ + 8 * hh, vlane = (lane >> 3) * NPROJ + (lane & 7) * 8;
    LAS unsigned char* vw = wl + ((lane & 7) >> 2) * 2048 + (lane >> 3) * 64 + (lane & 3) * 16;
    LAS const unsigned char* tra = wl + (4 * hh + ((lane & 15) >> 2)) * 64 + ((lane >> 4) & 1) * 32 + (lane & 3) * 8;
    a_f32x16 negs;
#pragma unroll
    for (int r = 0; r < 16; ++r) negs[r] = -T.shift;
    a_bf16x8 kn[4]; v4u vn[4];
#define ATT_LOAD(j) do { const int seg1_ = (j) < T.n1; const int kt_ = seg1_ ? (j) : T.kt2lo + ((j) - T.n1); const int row_ = seg1_ ? T.row1 + 128 * kt_ : T.row2 + 32 * kt_; const int rs_ = seg1_ ? 4 : 1; \
        const bf16* kb_ = PROJ + (size_t)row_ * NPROJ + T.kcol + (size_t)(klane - 8 * hh) * rs_ + 8 * hh; const bf16* vb_ = PROJ + (size_t)row_ * NPROJ + T.vcol + (size_t)(vlane - (lane & 7) * 8) * rs_ + (lane & 7) * 8; \
        _Pragma("unroll") for (int s = 0; s < 4; ++s) kn[s] = *(const a_bf16x8*)(kb_ + 16 * s); \
        _Pragma("unroll") for (int jj = 0; jj < 4; ++jj) vn[jj] = *(const v4u*)(vb_ + (size_t)(8 * jj * rs_) * NPROJ); } while (0)
    ATT_LOAD(0);
    for (int j = 0; j < nt; ++j) {
        a_bf16x8 kf[4]; v4u vr[4];
#pragma unroll
        for (int s = 0; s < 4; ++s) { kf[s] = kn[s]; vr[s] = vn[s]; }
        if (j + 1 < nt) ATT_LOAD(j + 1);
        const bool seg1 = j < T.n1; const int kt = seg1 ? j : T.kt2lo + (j - T.n1);
        const int Dt = (seg1 ? Dl1 : Dl2) - 32 * kt;
        const int D0 = (seg1 ? T.D01 : T.D02) - 32 * kt, qst = seg1 ? 1 : T.qstep2, maxd = seg1 ? 128 : T.maxd2;
        const int dpmin = D0 - 31, dpmax = D0 + 31 * qst;
        const int cls = (dpmin >= 0 && dpmax <= maxd) ? 1 : (dpmin > maxd ? 2 : 0);
#pragma unroll
        for (int jj = 0; jj < 4; ++jj) *(LAS v4u*)(vw + 512 * jj) = vr[jj];
        a_f32x16 S = negs;
#pragma unroll
        for (int s = 0; s < 4; ++s) S = __builtin_amdgcn_mfma_f32_32x32x16_bf16(kf[s], qf[s], S, 0, 0, 0);
        float p[16];
        float wm[4];
#pragma unroll
        for (int c = 0; c < 4; ++c) wm[c] = seg1 ? wg[c] : 0.0f;
        if (cls == 1) {
#pragma unroll
            for (int r = 0; r < 16; ++r) p[r] = (1.0f + wm[r & 3]) * __builtin_amdgcn_exp2f(S[r]);
        } else if (cls == 2) {
#pragma unroll
            for (int r = 0; r < 16; ++r) p[r] = wm[r & 3] * __builtin_amdgcn_exp2f(S[r]);
        } else {
#pragma unroll
            for (int r = 0; r < 16; ++r) { const int dp = Dt - ((r & 3) + 8 * (r >> 2));
                const float w = (((unsigned)dp <= (unsigned)maxd) ? 1.0f : 0.0f) + ((dp >= 0) ? wm[r & 3] : 0.0f);
                p[r] = w * __builtin_amdgcn_exp2f(S[r]); }
        }
        float ls = 0.f;
#pragma unroll
        for (int r = 0; r < 16; ++r) ls += p[r];
        lsum += ls;
        a_bf16x8 pb0, pb1;
        { v4u w0, w1; w0.x = a_cvtpk(p[0], p[1]); w0.y = a_cvtpk(p[2], p[3]); w0.z = a_cvtpk(p[4], p[5]); w0.w = a_cvtpk(p[6], p[7]);
          w1.x = a_cvtpk(p[8], p[9]); w1.y = a_cvtpk(p[10], p[11]); w1.z = a_cvtpk(p[12], p[13]); w1.w = a_cvtpk(p[14], p[15]);
          pb0 = __builtin_bit_cast(a_bf16x8, w0); pb1 = __builtin_bit_cast(a_bf16x8, w1); }
        {
            a_s16x4 lo, hi;
#define ATT_VF (a_bf16x8){lo[0], lo[1], lo[2], lo[3], hi[0], hi[1], hi[2], hi[3]}
            lo = a_vtr(tra);               hi = a_vtr(tra + 512);               o0 = __builtin_amdgcn_mfma_f32_32x32x16_bf16(ATT_VF, pb0, o0, 0, 0, 0);
            lo = a_vtr(tra + 1024);        hi = a_vtr(tra + 1024 + 512);        o0 = __builtin_amdgcn_mfma_f32_32x32x16_bf16(ATT_VF, pb1, o0, 0, 0, 0);
            lo = a_vtr(tra + 2048);        hi = a_vtr(tra + 2048 + 512);        o1 = __builtin_amdgcn_mfma_f32_32x32x16_bf16(ATT_VF, pb0, o1, 0, 0, 0);
            lo = a_vtr(tra + 2048 + 1024); hi = a_vtr(tra + 2048 + 1024 + 512); o1 = __builtin_amdgcn_mfma_f32_32x32x16_bf16(ATT_VF, pb1, o1, 0, 0, 0);
#undef ATT_VF
        }
    }
#undef ATT_LOAD
    const float ltot = lsum + __shfl_xor(lsum, 32) + T.sinkterm;
    const float rl = 1.0f / ltot;
    LAS unsigned char* stg = wl + ATT_STG;
#pragma unroll
    for (int g = 0; g < 4; ++g) {
        typedef unsigned u32x2_t __attribute__((ext_vector_type(2)));
        u32x2_t a, b2;
        a.x = a_cvtpk(o0[4 * g] * rl, o0[4 * g + 1] * rl); a.y = a_cvtpk(o0[4 * g + 2] * rl, o0[4 * g + 3] * rl);
        b2.x = a_cvtpk(o1[4 * g] * rl, o1[4 * g + 1] * rl); b2.y = a_cvtpk(o1[4 * g + 2] * rl, o1[4 * g + 3] * rl);
        *(LAS u32x2_t*)(stg + i * ATT_STG_PITCH + (8 * g + 4 * hh) * 2) = a;
        *(LAS u32x2_t*)(stg + i * ATT_STG_PITCH + (32 + 8 * g + 4 * hh) * 2) = b2;
    }
#pragma unroll
    for (int jj = 0; jj < 4; ++jj) { const int row = jj * 8 + (lane >> 3), ch = lane & 7;
        const v4u v = *(LAS const v4u*)(stg + row * ATT_STG_PITCH + ch * 16);
        *(v4u*)(MIX + (size_t)(T.orow0 + row * T.ors) * D + T.ocol + ch * 8) = v; }
}

__device__ __forceinline__ void attn_phase(const bf16* PROJ, bf16* MIX, const float* gqa, const float* gka, const float* gqb, const float* gkb, const float* sinks, LAS unsigned char* lds, int vcu, int G, int wave, int lane) {
    const float mqa = wave_max(__builtin_fabsf(gqa[lane])), mka = wave_max(__builtin_fabsf(gka[lane])), mqb = wave_max(__builtin_fabsf(gqb[lane])), mkb = wave_max(__builtin_fabsf(gkb[lane]));
    const float shiftA = pg8::C2 * 64.f * mqa * mka, shiftB = pg8::C2 * 64.f * mqb * mkb;
    LAS unsigned char* wl = lds + wave * ATT_WLDS;
    for (int v = vcu; v < BATCH * 8; v += G) {
        const int b = v >> 3, h = v & 7, rowb = b * SEQ;
        for (int k = 0; k < 16; ++k) {
            AttnTask T;
            if (k < 8) {
                const int r = wave & 3, half = wave >> 2, pr = 2 * (k >> 1) + half, c = (k & 1) ? 15 - pr : pr;
                T.qrow0 = rowb + 128 * c + r; T.qrs = 4; T.qcol = COL_QB + h * 64; T.kcol = COL_KB + h * 64; T.vcol = COL_VB + h * 64;
                T.n1 = c + 1; T.row1 = rowb + r; T.D01 = 32 * c;
                T.kt2lo = (c == 0) ? 4 : 0; T.kt2hi = 8; T.row2 = rowb + 128 * c - 128; T.D02 = 128 + r; T.qstep2 = 4; T.maxd2 = 128;
                T.orow0 = T.qrow0; T.ors = 4; T.ocol = 512 + h * 64; T.shift = shiftB; T.sinkterm = 0.f;
            } else {
                const int c = wave + 8 * (k - 8);
                T.qrow0 = rowb + 32 * c; T.qrs = 1; T.qcol = COL_QA + h * 64; T.kcol = COL_KA + (h >> 2) * 64; T.vcol = COL_VA + (h >> 2) * 64;
                T.n1 = 0; T.row1 = rowb; T.D01 = 0;
                T.kt2lo = (c < 4) ? 4 - c : 0; T.kt2hi = 5; T.row2 = rowb + 32 * c - 128; T.D02 = 128; T.qstep2 = 1; T.maxd2 = 127;
                T.orow0 = T.qrow0; T.ors = 1; T.ocol = h * 64; T.shift = shiftA; T.sinkterm = __builtin_amdgcn_exp2f(sinks[h] * 1.4426950408889634f - shiftA);
            }
            attn_task(PROJ, MIX, wl, lane, T);
        }
    }
}

struct Args { const float* in[13]; float* out; unsigned char* ws; int ph_lo, ph_hi, li, pad; };
__global__ void __launch_bounds__(NWAVES * 64, 2) hymba_fwd(Args args) {
    extern __shared__ __attribute__((aligned(16))) unsigned char lds[];
    LAS unsigned char* L = (LAS unsigned char*)lds;
    volatile LAS unsigned* MISC = (volatile LAS unsigned*)(L + MISC_OFF);
    const int tid = threadIdx.x, lane = tid & 63, wave = __builtin_amdgcn_readfirstlane(tid >> 6);
    const int G = gridDim.x; const int bx = blockIdx.x; const int vcu = (G % 8 == 0) ? (bx % 8) * (G / 8) + bx / 8 : bx;
    unsigned char* ws = args.ws;
    gu32* ctl = (gu32*)(ws + WS_CTL);
    const float* x = args.in[0]; const int* positions = (const int*)args.in[1]; const float* g_attn = args.in[2]; const float* w_in = args.in[3];
    const float* gqa = args.in[4]; const float* gka = args.in[5]; const float* sinks = args.in[6]; const float* gqb = args.in[7]; const float* gkb = args.in[8];
    const float* w_out = args.in[9]; const float* g_mlp = args.in[10]; const float* w_up = args.in[11]; const float* w_dn = args.in[12];
    float* out = args.out;
    bf16* Win_t = (bf16*)(ws + WS_WIN); bf16* Wout_t = (bf16*)(ws + WS_WOUT); bf16* Wup_t = (bf16*)(ws + WS_WUP); bf16* Wdn_t = (bf16*)(ws + WS_WDN);
    float* rope = (float*)(ws + WS_ROPE); float* ssp = (float*)(ws + WS_SS);
    bf16* XN = (bf16*)(ws + WS_XN); bf16* PROJ = (bf16*)(ws + WS_PROJ); bf16* MIXB = (bf16*)(ws + WS_MIX); bf16* HID = (bf16*)(ws + WS_HID);
    for (int u = tid; u < (LDS_BYTES - LDSCTL_OFF) / 4; u += NWAVES * 64) ((LAS unsigned*)(L + LDSCTL_OFF))[u] = 0u;
    __syncthreads();
    const int bli = (N_LAUNCHES == PER_PHASE) ? 0 : args.li;
    XcdBarrier bar; bar.bar = (unsigned*)(ctl + CW_BAR) + bli * XCD_BAR_WORDS; bar.x = 0; bar.st = nullptr;
    if (N_LAUNCHES != PER_PHASE) bar = xcd_barrier_post((unsigned*)(ctl + CW_BAR) + bli * XCD_BAR_WORDS, MISC + 8);
#define GRID_BAR(seam) do { if (N_LAUNCHES == PER_PHASE) { if (tid == 0) __hip_atomic_store(ctl + CW_TMO, 0xBADBA0u | (unsigned)(seam), RLX_AGENT); } else { xcd_barrier(bar); } } while (0)
    const int lo = args.ph_lo, hi = args.ph_hi;
#define IN(k) (lo <= (k) && (k) < hi)
#define BOTH(k) (IN(k) && IN((k) + 1))

    if (IN(0)) {
        LAS float* scr = (LAS float*)(L + RING_OFF + wave * 16384);
        const int gw = vcu * NWAVES + wave, NGW = G * NWAVES;
        constexpr int I_IN = (D / 64) * (NPROJ / 32), I_OUT = (D / 64) * (D / 32), I_UP = (D / 64) * (FF / 32), I_DN = (FF / 64) * (D / 32);
        constexpr int NITEMS = I_IN + I_OUT + I_UP + I_DN;
        for (int it = gw; it < NITEMS; it += NGW) {
            int r = it;
            if (r < I_IN) { p0_transpose_item(w_in, D, NPROJ, Win_t, nullptr, scr, r, lane); continue; } r -= I_IN;
            if (r < I_OUT) { p0_transpose_item(w_out, D, D, Wout_t, nullptr, scr, r, lane); continue; } r -= I_OUT;
            if (r < I_UP) { p0_transpose_item(w_up, D, FF, Wup_t, g_mlp, scr, r, lane); continue; } r -= I_UP;
            p0_transpose_item(w_dn, FF, D, Wdn_t, nullptr, scr, r, lane);
        }
        for (int m = gw; m < M; m += NGW) rms_row_to_bf16(x + (size_t)m * D, g_attn, XN + (size_t)m * D, lane);
        for (int it = gw * 64 + lane; it < M * 8; it += NGW * 64) {
            const int m = it >> 3, i = it & 7;
            const float inv_freq = (i == 0) ? 1.0f : (i == 1) ? 0.193922743f : (i == 2) ? 0.0376060307f : (i == 3) ? 0.00729266461f : (i == 4) ? 0.00141421356f : (i == 5) ? 0.000274248188f : (i == 6) ? 5.3182961e-05f : 1.03133862e-05f;
            const float ang = (float)positions[m] * inv_freq;
            double rev = (double)ang * 0.15915494309189535; rev -= __builtin_floor(rev);
            const float rf = (float)rev;
            rope[(size_t)m * 16 + i] = __builtin_amdgcn_cosf(rf); rope[(size_t)m * 16 + 8 + i] = __builtin_amdgcn_sinf(rf);
        }
        if (BOTH(0)) GRID_BAR(0);
    }
    if (IN(1)) {
        pg8::Gemm g{XN, Win_t, M, NPROJ, D}; pg8::StaticOrder S; S.init(M, NPROJ, G, (int)blockIdx.x);
        pg8::EpiQKV E{PROJ, NPROJ, gqa, gka, gqb, gkb, rope};
        pg8::gemm_phase<pg8::EpiQKV, pg8::StaticOrder, true>(L + RING_OFF, g, S, E);
        if (BOTH(1)) GRID_BAR(1);
    }
    if (IN(2)) {
#if defined(NAIVE_ATTN)
        attn_naive(PROJ, MIXB, gqa, gka, gqb, gkb, sinks, vcu * (NWAVES * 64) + tid, G * NWAVES * 64);
#else
        attn_phase(PROJ, MIXB, gqa, gka, gqb, gkb, sinks, L + RING_OFF, vcu, G, wave, lane);
#endif
        if (BOTH(2)) GRID_BAR(2);
    }
    if (IN(3)) {
        pg8::Gemm g{MIXB, Wout_t, M, D, D}; pg8::StaticOrder S; S.init(M, D, G, (int)blockIdx.x);
        pg8::EpiOut E{x, out, XN, ssp, D};
        pg8::gemm_phase<pg8::EpiOut, pg8::StaticOrder, true>(L + RING_OFF, g, S, E);
        if (BOTH(3)) GRID_BAR(3);
    }
    if (IN(4)) {
        pg8::Gemm g{XN, Wup_t, M, FF, D}; pg8::StaticOrder S; S.init(M, FF, G, (int)blockIdx.x);
        pg8::EpiUp E{ssp, HID, FF, 1.0f / D, RMS_EPS};
        pg8::gemm_phase<pg8::EpiUp, pg8::StaticOrder, true>(L + RING_OFF, g, S, E);
        if (BOTH(4)) GRID_BAR(4);
    }
    if (IN(5)) {
        pg8::Gemm g{HID, Wdn_t, M, D, FF}; pg8::StaticOrder S; S.init(M, D, G, (int)blockIdx.x);
        pg8::EpiDown E{out, D};
        pg8::gemm_phase<pg8::EpiDown, pg8::StaticOrder, true>(L + RING_OFF, g, S, E);
    }
#undef IN
#undef BOTH
}

extern "C" void kernel_launch(void* const* d_in, const int* in_sizes, int n_in, void* d_out, int out_size, void* d_ws, size_t ws_size, hipStream_t stream) {
    static int grid = 0;
    if (grid == 0) {
        if (n_in != 13 || in_sizes[0] != M * D || out_size != M * D || ws_size < WS_END) { fprintf(stderr, "kernel_launch: shape/workspace mismatch (n_in %d in0 %d out %d ws %zu); nothing launched\n", n_in, n_in > 0 ? in_sizes[0] : -1, out_size, ws_size); grid = -1; return; }
        int dev = 0, cus = 0, per_cu = 0;
        if (hipGetDevice(&dev) != hipSuccess || hipDeviceGetAttribute(&cus, hipDeviceAttributeMultiprocessorCount, dev) != hipSuccess) { fprintf(stderr, "kernel_launch: device query failed\n"); grid = -1; return; }
        if (hipFuncSetAttribute((const void*)hymba_fwd, hipFuncAttributeMaxDynamicSharedMemorySize, LDS_BYTES) != hipSuccess) { fprintf(stderr, "kernel_launch: hipFuncSetAttribute failed\n"); grid = -1; return; }
        if (hipOccupancyMaxActiveBlocksPerMultiprocessor(&per_cu, (const void*)hymba_fwd, NWAVES * 64, LDS_BYTES) != hipSuccess || per_cu < 1)
            fprintf(stderr, "kernel_launch: note: occupancy query reports %d workgroups per CU\n", per_cu);
        (void)hipGetLastError();
        grid = cus;
    }
    if (grid < 0) return;
    if (hipMemsetAsync((char*)d_ws + WS_CTL, 0, CTL_ZERO_BYTES, stream) != hipSuccess) { fprintf(stderr, "kernel_launch: hipMemsetAsync failed\n"); return; }
    Args a{};
    for (int i = 0; i < 13; ++i) a.in[i] = (const float*)d_in[i];
    a.out = (float*)d_out; a.ws = (unsigned char*)d_ws;
    static_assert(N_LAUNCHES == 1 || N_LAUNCHES == PER_PHASE, "MK_N_LAUNCHES must be 1 or 6");
    for (int li = 0; li < N_LAUNCHES; ++li) {
        a.ph_lo = (N_LAUNCHES == PER_PHASE) ? li : 0; a.ph_hi = (N_LAUNCHES == PER_PHASE) ? li + 1 : PER_PHASE; a.li = li;
        hipLaunchKernelGGL(hymba_fwd, dim3(grid), dim3(NWAVES * 64), LDS_BYTES, stream, a);
        const hipError_t le = hipPeekAtLastError();
        if (le != hipSuccess) { fprintf(stderr, "kernel_launch: launch %d failed: %s\n", li, hipGetErrorName(le)); break; }
    }
}
```

```cpp
#include <hip/hip_runtime.h>
#include <cstdio>
#include <cstdint>

#ifndef MK_N_LAUNCHES
#define MK_N_LAUNCHES 1
#endif
#ifndef REPEAT_MASK
#define REPEAT_MASK 0
#endif
#define REP(k) for (int rep_ = 0; rep_ < 1 + ((REPEAT_MASK >> (k)) & 1); ++rep_)

namespace pg8 {
#define PG8_LAS __attribute__((address_space(3)))
typedef unsigned short bf16_t;
typedef short bf16x8 __attribute__((ext_vector_type(8)));
typedef float f32x4 __attribute__((ext_vector_type(4)));
typedef unsigned u32x4 __attribute__((ext_vector_type(4)));
constexpr int BM = 256, BK = 64, HALF = 128, HTB = HALF * BK * 2  , STAGE_BYTES = 8 * HTB, NXCD = 8, WGM = 8;

__host__ __device__ __forceinline__ int lds_byte(int r, int c) { const int st = (r >> 4) * 2 + (c >> 5), rr = r & 15, cc = c & 31, ob = rr * 64 + cc * 2; return st * 1024 + (ob ^ (((ob >> 9) & 1) << 5)); }
__host__ __device__ __forceinline__ void stage_rc(int b, int& R, int& C) { const int st = b / 1024, sb = b % 1024, swz = sb ^ (((sb >> 9) & 1) << 5); R = (st >> 1) * 16 + swz / 64; C = (st & 1) * 32 + (swz % 64) / 2; }
__host__ __device__ __forceinline__ int perm32(int rho) { const int n = rho >> 4, i = rho & 15; return 8 * (i >> 2) + 4 * n + (i & 3); }

struct Unit { int pm, pn; };
struct Gemm { const bf16_t* A; const bf16_t* Bt; int M, N, K; };

struct StaticOrder {
    int nM, nN, nwg, G, c;
    __host__ __device__ void init(int M, int N, int G_, int c_) { nM = M / BM; nN = N / BM; nwg = nM * nN; G = G_; c = c_; }
    __host__ __device__ bool next(int i, Unit& u) const {
        const long L = (long)i * G + c; if (L >= nwg) return false;
        int wgid = (int)L; { const int q = nwg / NXCD, r = nwg % NXCD, xcd = wgid % NXCD, off = wgid / NXCD; wgid = (xcd < r ? xcd * (q + 1) : r * (q + 1) + (xcd - r) * q) + off; }
        const int nig = WGM * nN, gid = wgid / nig, fm = gid * WGM, gsz = (nM - fm) < WGM ? (nM - fm) : WGM;
        u.pm = fm + ((wgid % nig) % gsz); u.pn = (wgid % nig) / gsz; return true;
    }
};

__device__ __forceinline__ unsigned cvt_pk_bf16(float lo, float hi) { unsigned r; asm volatile("v_cvt_pk_bf16_f32 %0, %1, %2" : "=v"(r) : "v"(lo), "v"(hi)); return r; }

constexpr float QK_EPS = 1e-6f;
constexpr float C2 = 0.125f * 1.4426950408889634f;

struct EpiQKV {
    bf16_t* O; int ldc; const float* gqa; const float* gka; const float* gqb; const float* gkb; const float* rope;
    __device__ __forceinline__ void operator()(const f32x4 (&acc)[2][2][4][2], const Unit& u, int wr, int wc, int fr, int fq) const {
        const int pn = u.pn; int mode = 0; const float* g = gqa;
        if (pn < 2) { mode = 1; g = gqa; } else if (pn == 2) { if (wc < 2) { mode = 2; g = gka; } } else if (pn < 5) { mode = 1; g = gqb; } else if (pn < 7) { mode = 2; g = gkb; }
        const int row0 = u.pm * BM + wr * 64 + fr, col0 = pn * BM + wc * 64 + 8 * fq;
        if (mode == 0) {
#pragma unroll
            for (int ai = 0; ai < 2; ++ai)
#pragma unroll
                for (int m = 0; m < 4; ++m) { bf16_t* rowp = O + (size_t)(row0 + ai * HALF + m * 16) * ldc + col0;
#pragma unroll
                    for (int bj = 0; bj < 2; ++bj) { const f32x4 v0 = acc[ai][bj][m][0], v1 = acc[ai][bj][m][1]; u32x4 w;
                        w.x = cvt_pk_bf16(v0[0], v0[1]); w.y = cvt_pk_bf16(v0[2], v0[3]); w.z = cvt_pk_bf16(v1[0], v1[1]); w.w = cvt_pk_bf16(v1[2], v1[3]);
                        *(u32x4*)(rowp + bj * 32) = w; } }
            return;
        }
        f32x4 gv[2][2];
#pragma unroll
        for (int bj = 0; bj < 2; ++bj)
#pragma unroll
            for (int n = 0; n < 2; ++n) gv[bj][n] = *(const f32x4*)(g + 32 * bj + 8 * fq + 4 * n);
        const float sc = (mode == 1) ? C2 : 1.0f;
        const float sgn = (fq == 0) ? -1.0f : 1.0f;
#pragma unroll
        for (int ai = 0; ai < 2; ++ai)
#pragma unroll
            for (int m = 0; m < 4; ++m) {
                const int row = row0 + ai * HALF + m * 16;
                float ss = 0.f;
#pragma unroll
                for (int bj = 0; bj < 2; ++bj)
#pragma unroll
                    for (int n = 0; n < 2; ++n) { const f32x4 x = acc[ai][bj][m][n]; ss += (x[0] * x[0] + x[1] * x[1]) + (x[2] * x[2] + x[3] * x[3]); }
                ss += __shfl_xor(ss, 16); ss += __shfl_xor(ss, 32);
                const float rs = __builtin_amdgcn_rsqf(ss * (1.0f / 64.0f) + QK_EPS);
                f32x4 y[2][2];
#pragma unroll
                for (int bj = 0; bj < 2; ++bj)
#pragma unroll
                    for (int n = 0; n < 2; ++n) y[bj][n] = acc[ai][bj][m][n] * rs * gv[bj][n];
                const f32x4 c0 = *(const f32x4*)(rope + (size_t)row * 16), c1 = *(const f32x4*)(rope + (size_t)row * 16 + 4);
                const f32x4 s0 = *(const f32x4*)(rope + (size_t)row * 16 + 8), s1 = *(const f32x4*)(rope + (size_t)row * 16 + 12);
                f32x4 p0, p1;
#pragma unroll
                for (int e = 0; e < 4; ++e) { p0[e] = __shfl_xor(y[0][0][e], 16); p1[e] = __shfl_xor(y[0][1][e], 16); }
                if (fq < 2) { y[0][0] = y[0][0] * c0 + p0 * s0 * sgn; y[0][1] = y[0][1] * c1 + p1 * s1 * sgn; }
                bf16_t* rowp = O + (size_t)row * ldc + col0;
#pragma unroll
                for (int bj = 0; bj < 2; ++bj) { const f32x4 v0 = y[bj][0] * sc, v1 = y[bj][1] * sc; u32x4 w;
                    w.x = cvt_pk_bf16(v0[0], v0[1]); w.y = cvt_pk_bf16(v0[2], v0[3]); w.z = cvt_pk_bf16(v1[0], v1[1]); w.w = cvt_pk_bf16(v1[2], v1[3]);
                    *(u32x4*)(rowp + bj * 32) = w; }
            }
    }
};

struct EpiOut {
    const float* x; float* h; bf16_t* hb; float* ssp; int ldc;
    __device__ __forceinline__ void operator()(const f32x4 (&acc)[2][2][4][2], const Unit& u, int wr, int wc, int fr, int fq) const {
        const int row0 = u.pm * BM + wr * 64 + fr, col0 = u.pn * BM + wc * 64 + 8 * fq;
#pragma unroll
        for (int ai = 0; ai < 2; ++ai)
#pragma unroll
            for (int m = 0; m < 4; ++m) {
                const int row = row0 + ai * HALF + m * 16; const size_t off = (size_t)row * ldc + col0; float ss = 0.f;
#pragma unroll
                for (int bj = 0; bj < 2; ++bj) {
                    const f32x4 x0 = *(const f32x4*)(x + off + bj * 32), x1 = *(const f32x4*)(x + off + bj * 32 + 4);
                    const f32x4 v0 = acc[ai][bj][m][0] + x0, v1 = acc[ai][bj][m][1] + x1;
                    *(f32x4*)(h + off + bj * 32) = v0; *(f32x4*)(h + off + bj * 32 + 4) = v1;
                    u32x4 w; w.x = cvt_pk_bf16(v0[0], v0[1]); w.y = cvt_pk_bf16(v0[2], v0[3]); w.z = cvt_pk_bf16(v1[0], v1[1]); w.w = cvt_pk_bf16(v1[2], v1[3]);
                    *(u32x4*)(hb + off + bj * 32) = w;
                    ss += (v0[0] * v0[0] + v0[1] * v0[1]) + (v0[2] * v0[2] + v0[3] * v0[3]) + (v1[0] * v1[0] + v1[1] * v1[1]) + (v1[2] * v1[2] + v1[3] * v1[3]);
                }
                ss += __shfl_xor(ss, 16); ss += __shfl_xor(ss, 32);
                if (fq == 0) ssp[(size_t)row * 16 + u.pn * 4 + wc] = ss;
            }
    }
};

struct EpiUp {
    const float* ssp; bf16_t* hid; int ldc; float inv_n, eps;
    __device__ __forceinline__ void operator()(const f32x4 (&acc)[2][2][4][2], const Unit& u, int wr, int wc, int fr, int fq) const {
        const int row0 = u.pm * BM + wr * 64 + fr, col0 = u.pn * BM + wc * 64 + 8 * fq;
#pragma unroll
        for (int ai = 0; ai < 2; ++ai)
#pragma unroll
            for (int m = 0; m < 4; ++m) {
                const int row = row0 + ai * HALF + m * 16;
                const f32x4 a = *(const f32x4*)(ssp + (size_t)row * 16), b = *(const f32x4*)(ssp + (size_t)row * 16 + 4), c = *(const f32x4*)(ssp + (size_t)row * 16 + 8), d = *(const f32x4*)(ssp + (size_t)row * 16 + 12);
                const f32x4 t = (a + b) + (c + d); const float ss = (t[0] + t[1]) + (t[2] + t[3]);
                const float rs = __builtin_amdgcn_rsqf(ss * inv_n + eps);
                bf16_t* rowp = hid + (size_t)row * ldc + col0;
#pragma unroll
                for (int bj = 0; bj < 2; ++bj) { f32x4 v0 = acc[ai][bj][m][0] * rs, v1 = acc[ai][bj][m][1] * rs;
#pragma unroll
                    for (int e = 0; e < 4; ++e) { const float r0 = __builtin_fmaxf(v0[e], 0.f), r1 = __builtin_fmaxf(v1[e], 0.f); v0[e] = r0 * r0; v1[e] = r1 * r1; }
                    u32x4 w; w.x = cvt_pk_bf16(v0[0], v0[1]); w.y = cvt_pk_bf16(v0[2], v0[3]); w.z = cvt_pk_bf16(v1[0], v1[1]); w.w = cvt_pk_bf16(v1[2], v1[3]);
                    *(u32x4*)(rowp + bj * 32) = w; }
            }
    }
};

struct EpiDown {
    float* out; int ldc;
    __device__ __forceinline__ void operator()(const f32x4 (&acc)[2][2][4][2], const Unit& u, int wr, int wc, int fr, int fq) const {
        const int row0 = u.pm * BM + wr * 64 + fr, col0 = u.pn * BM + wc * 64 + 8 * fq;
#pragma unroll
        for (int ai = 0; ai < 2; ++ai)
#pragma unroll
            for (int m = 0; m < 4; ++m) {
                const size_t off = (size_t)(row0 + ai * HALF + m * 16) * ldc + col0;
#pragma unroll
                for (int bj = 0; bj < 2; ++bj) {
                    const f32x4 h0 = *(const f32x4*)(out + off + bj * 32), h1 = *(const f32x4*)(out + off + bj * 32 + 4);
                    *(f32x4*)(out + off + bj * 32) = h0 + acc[ai][bj][m][0]; *(f32x4*)(out + off + bj * 32 + 4) = h1 + acc[ai][bj][m][1];
                }
            }
    }
};

template <class Epi, class Sched, bool ALIGN_EPI>
__device__ __forceinline__ void gemm_phase(PG8_LAS unsigned char* lds, const Gemm g, const Sched& S, const Epi& E) {
    const int tid = threadIdx.x, wid = __builtin_amdgcn_readfirstlane(tid >> 6), lane = tid & 63, wr = wid >> 2, wc = wid & 3, fr = lane & 15, fq = lane >> 4;
    const int K = g.K, nt = K / BK;
    unsigned voffA[2], voffB[2];
#pragma unroll
    for (int i = 0; i < 2; ++i) { int R, C; stage_rc(tid * 16 + i * 8192, R, C); const int Rb = (R >> 5) * 64 + perm32(R & 31);
        voffA[i] = (unsigned)(R * K + C) * 2u; voffB[i] = (unsigned)(Rb * K + C) * 2u; }
    const size_t kstep = (size_t)(BK * 2);
    const size_t hstepA = (size_t)HALF * K * 2;
    const size_t hstepB = (size_t)32 * K * 2;
    const size_t tstep = (size_t)BM * K * 2;
    const unsigned ldsw = (unsigned)wid * 1024u;
    const int aoff = lds_byte(wr * 64 + fr, fq * 8), boff = lds_byte(wc * 32 + fr, fq * 8);
#define PG8_SA(b, h) (((b) * 2 + (h)) * HTB)
#define PG8_SB(b, h) ((4 + (b) * 2 + (h)) * HTB)
#define PG8_STAGE(bufoff, gbase, voff) do { _Pragma("unroll") for (int _i = 0; _i < 2; ++_i) \
        __builtin_amdgcn_global_load_lds((const unsigned*)((const char*)(gbase) + (voff)[_i]), (PG8_LAS unsigned*)(lds + (bufoff) + ldsw + _i * 8192), 16, 0, 0); } while (0)
#define PG8_LDA(dst, b, h) do { _Pragma("unroll") for (int m = 0; m < 4; ++m) _Pragma("unroll") for (int k = 0; k < 2; ++k) dst[m][k] = *(const PG8_LAS bf16x8*)(lds + PG8_SA(b, h) + aoff + m * 2048 + k * 1024); } while (0)
#define PG8_LDB(dst, b, h) do { _Pragma("unroll") for (int n = 0; n < 2; ++n) _Pragma("unroll") for (int k = 0; k < 2; ++k) dst[n][k] = *(const PG8_LAS bf16x8*)(lds + PG8_SB(b, h) + boff + n * 2048 + k * 1024); } while (0)
#define PG8_MMA(ai, bj, At, Bt) do { __builtin_amdgcn_s_setprio(1); _Pragma("unroll") for (int m = 0; m < 4; ++m) _Pragma("unroll") for (int n = 0; n < 2; ++n) _Pragma("unroll") for (int k = 0; k < 2; ++k) \
        acc[ai][bj][m][n] = __builtin_amdgcn_mfma_f32_16x16x32_bf16(Bt[n][k], At[m][k], acc[ai][bj][m][n], 0, 0, 0); __builtin_amdgcn_s_setprio(0); } while (0)
#define PG8_WAIT_V(n) asm volatile("s_waitcnt vmcnt(" #n ")" ::: "memory")
#define PG8_WAIT_L(n) asm volatile("s_waitcnt lgkmcnt(" #n ")" ::: "memory")
#define PG8_BAR __builtin_amdgcn_s_barrier()
#define PG8_SCHED __builtin_amdgcn_sched_barrier(0)
    Unit cur, nxt; int ui = 0;
    if (!S.next(0, cur)) return;
    f32x4 acc[2][2][4][2];
#pragma unroll
    for (int a = 0; a < 2; ++a)
#pragma unroll
        for (int b = 0; b < 2; ++b)
#pragma unroll
            for (int m = 0; m < 4; ++m)
#pragma unroll
                for (int n = 0; n < 2; ++n) acc[a][b][m][n] = (f32x4){0.f, 0.f, 0.f, 0.f};
    bf16x8 At[4][2], B0[2][2], B1[2][2];
    const char* cA = (const char*)g.A + (size_t)cur.pm * tstep; const char* cB = (const char*)g.Bt + (size_t)cur.pn * tstep;
    PG8_STAGE(PG8_SB(0, 0), cB, voffB); PG8_STAGE(PG8_SB(0, 1), cB + hstepB, voffB); PG8_STAGE(PG8_SA(0, 0), cA, voffA); PG8_STAGE(PG8_SA(0, 1), cA + hstepA, voffA);
    if (wr == 1) PG8_BAR;
    PG8_WAIT_V(2); PG8_BAR;
    PG8_STAGE(PG8_SB(1, 0), cB + kstep, voffB); PG8_STAGE(PG8_SA(1, 0), cA + kstep, voffA); PG8_STAGE(PG8_SB(1, 1), cB + hstepB + kstep, voffB);
    PG8_WAIT_V(6); PG8_BAR;
    for (;;) {
        const bool has_next = S.next(ui + 1, nxt);
        const char* nA = has_next ? (const char*)g.A + (size_t)nxt.pm * tstep : cA; const char* nB = has_next ? (const char*)g.Bt + (size_t)nxt.pn * tstep : cB;
        for (int t = 0; t < nt; t += 2) {
            const bool last = (t == nt - 2);
            const char* a1 = cA + (size_t)(t + 1) * kstep;
            const char* a2 = last ? nA : cA + (size_t)(t + 2) * kstep; const char* b2 = last ? nB : cB + (size_t)(t + 2) * kstep;
            const char* a3 = a2 + kstep; const char* b3 = b2 + kstep;
            PG8_LDB(B0, 0, 0); PG8_LDB(B1, 0, 1); PG8_SCHED; PG8_LDA(At, 0, 0); PG8_STAGE(PG8_SA(1, 1), a1 + hstepA, voffA);
            PG8_WAIT_V(8); PG8_WAIT_L(0); PG8_BAR; PG8_MMA(0, 0, At, B0); PG8_MMA(0, 1, At, B1); PG8_BAR; PG8_SCHED;
            PG8_LDA(At, 0, 1); PG8_STAGE(PG8_SB(0, 0), b2, voffB); PG8_STAGE(PG8_SB(0, 1), b2 + hstepB, voffB); PG8_STAGE(PG8_SA(0, 0), a2, voffA);
            PG8_WAIT_V(8); PG8_WAIT_L(0); PG8_BAR; PG8_MMA(1, 0, At, B0); PG8_MMA(1, 1, At, B1); PG8_BAR; PG8_SCHED;
            PG8_LDB(B0, 1, 0); PG8_LDB(B1, 1, 1); PG8_SCHED; PG8_LDA(At, 1, 0); PG8_STAGE(PG8_SA(0, 1), a2 + hstepA, voffA);
            PG8_WAIT_V(8); PG8_WAIT_L(0); PG8_BAR; PG8_MMA(0, 0, At, B0); PG8_MMA(0, 1, At, B1); PG8_BAR; PG8_SCHED;
            PG8_LDA(At, 1, 1); PG8_STAGE(PG8_SB(1, 0), b3, voffB); PG8_STAGE(PG8_SB(1, 1), b3 + hstepB, voffB); PG8_STAGE(PG8_SA(1, 0), a3, voffA);
            PG8_WAIT_V(8); PG8_WAIT_L(0); PG8_BAR; PG8_MMA(1, 0, At, B0); PG8_MMA(1, 1, At, B1); PG8_BAR; PG8_SCHED;
        }
        if constexpr (ALIGN_EPI) { if (wr == 0) PG8_BAR; }
        E(acc, cur, wr, wc, fr, fq);
        if (!has_next) break;
#pragma unroll
        for (int a = 0; a < 2; ++a)
#pragma unroll
            for (int b = 0; b < 2; ++b)
#pragma unroll
                for (int m = 0; m < 4; ++m)
#pragma unroll
                    for (int n = 0; n < 2; ++n) acc[a][b][m][n] = (f32x4){0.f, 0.f, 0.f, 0.f};
        cur = nxt; cA = nA; cB = nB; ++ui;
        if constexpr (ALIGN_EPI) { if (wr == 1) PG8_BAR; }
    }
    PG8_WAIT_V(0);
    if constexpr (!ALIGN_EPI) { if (wr == 0) PG8_BAR; }
    PG8_BAR;
#undef PG8_SA
#undef PG8_SB
#undef PG8_STAGE
#undef PG8_LDA
#undef PG8_LDB
#undef PG8_MMA
#undef PG8_WAIT_V
#undef PG8_WAIT_L
#undef PG8_BAR
#undef PG8_SCHED
}
}

constexpr int NWAVES = 8;
constexpr int BATCH = 32, SEQ = 2048, D = 1024, FF = 4096, HD = 64;
constexpr int M = BATCH * SEQ;
constexpr int NPROJ = 2304;
constexpr int COL_QA = 0, COL_KA = 512, COL_VA = 640, COL_QB = 768, COL_KB = 1280, COL_VB = 1792;
constexpr float RMS_EPS = 1e-6f;
constexpr int N_LAUNCHES = MK_N_LAUNCHES, PER_PHASE = 6;
constexpr int N_BAR_REGIONS = (MK_N_LAUNCHES == PER_PHASE) ? 1 : MK_N_LAUNCHES;

constexpr size_t MiB = 1u << 20;
constexpr size_t WS_CTL = 0, CTL_ZERO_BYTES = 1 * MiB;
constexpr size_t WS_WIN = 2 * MiB, WS_WOUT = 8 * MiB, WS_WUP = 10 * MiB, WS_WDN = 18 * MiB;
constexpr size_t WS_ROPE = 26 * MiB;
constexpr size_t WS_SS = 30 * MiB;
constexpr size_t WS_XN = 64 * MiB;
constexpr size_t WS_PROJ = 192 * MiB;
constexpr size_t WS_MIX = 480 * MiB;
constexpr size_t WS_HID = 192 * MiB;
constexpr size_t WS_END = 704 * MiB;
static_assert(WS_WIN + (size_t)NPROJ * D * 2 <= WS_WOUT && WS_WDN + (size_t)D * FF * 2 <= WS_ROPE && WS_SS + (size_t)M * 64 <= WS_XN, "d_ws map");
static_assert(WS_XN + (size_t)M * D * 2 <= WS_PROJ && WS_PROJ + (size_t)M * NPROJ * 2 <= WS_MIX && WS_MIX + (size_t)M * D * 2 <= WS_END && WS_HID + (size_t)M * FF * 2 <= WS_END, "d_ws map");
constexpr int CW_TMO = 0, CW_CODE = 1;
constexpr int CW_BAR = 4096;

constexpr int RING_OFF = 0, RING_BYTES = 131072;
constexpr int LDSCTL_OFF = RING_BYTES, MISC_OFF = LDSCTL_OFF + 320;
constexpr int LDS_BYTES = 147456;

#define GAS __attribute__((address_space(1)))
#define LAS __attribute__((address_space(3)))
typedef unsigned short bf16;
typedef unsigned v4u __attribute__((ext_vector_type(4)));
typedef float f32x4 __attribute__((ext_vector_type(4)));
typedef GAS unsigned gu32;
#define RLX_AGENT __ATOMIC_RELAXED, __HIP_MEMORY_SCOPE_AGENT
#define LDS_WAIT() asm volatile("s_waitcnt lgkmcnt(0)" ::: "memory")
#define VM_WAIT() asm volatile("s_waitcnt vmcnt(0)" ::: "memory")
__device__ __forceinline__ unsigned f2bf(float f) { unsigned u = __builtin_bit_cast(unsigned, f); return (u + 0x7fffu + ((u >> 16) & 1u)) >> 16; }
__device__ __forceinline__ unsigned pk2(float lo, float hi) { return f2bf(lo) | (f2bf(hi) << 16); }
__device__ __forceinline__ float bf_lo(unsigned u) { return __uint_as_float(u << 16); }
__device__ __forceinline__ float bf_hi(unsigned u) { return __uint_as_float(u & 0xffff0000u); }

#define XB_TMO      128
#define XB_XCNT(j)  (256  + 64 * (j))
#define XB_XSUB(j)  (1280 + 64 * (j))
#define XB_XGEN(j)  (2304 + 64 * (j))
#define XB_TOP      3328
#define XB_TOPGEN   3392
#define XCD_BAR_WORDS 3456
#define XB_SPIN_CAP (1u << 18)

__device__ __forceinline__ unsigned xb_ld(unsigned* p)              { return __hip_atomic_load(p, __ATOMIC_RELAXED, __HIP_MEMORY_SCOPE_AGENT); }
__device__ __forceinline__ unsigned xb_add(unsigned* p, unsigned v) { return __hip_atomic_fetch_add(p, v, __ATOMIC_RELAXED, __HIP_MEMORY_SCOPE_AGENT); }
__device__ __forceinline__ unsigned xb_xcc_id() { return (unsigned)__builtin_amdgcn_s_getreg((3 << 11) | 20) & 0xFu; }
#define XB_SPIN(cond, bar) do { unsigned _sp = 0; while (cond) { __builtin_amdgcn_s_sleep(1); \
    if ((++_sp & 255u) == 0u) { if (xb_ld(&(bar)[XB_TMO])) break; if (_sp > XB_SPIN_CAP) { atomicAdd(&(bar)[XB_TMO], 1u); break; } } } } while (0)

struct XcdBarrier { unsigned* bar; unsigned x; volatile LAS unsigned* st; };

__device__ __forceinline__ XcdBarrier xcd_barrier_post(unsigned* bar, volatile LAS unsigned* st) {
    XcdBarrier b; b.bar = bar; b.x = xb_xcc_id(); b.st = st;
    if (threadIdx.x == 0) (void)xb_add(&bar[XB_XCNT(b.x)], 1u);
    return b;
}
__device__ __forceinline__ void xcd_barrier_complete(unsigned* bar, unsigned x, unsigned& nloc, unsigned& nx) {
    const unsigned G = gridDim.x * gridDim.y * gridDim.z;
    unsigned sum, cnt, mine, sp = 0u;
    for (;;) {
        sum = 0u; cnt = 0u; mine = 0u;
#pragma unroll
        for (unsigned j = 0; j < 16; ++j) { const unsigned c = xb_ld(&bar[XB_XCNT(j)]); sum += c; cnt += (c > 0u) ? 1u : 0u; mine = (j == x) ? c : mine; }
        if (sum == G) break;
        __builtin_amdgcn_s_sleep(1);
        if ((++sp & 255u) == 0u) { if (xb_ld(&bar[XB_TMO])) break; if (sp > XB_SPIN_CAP) { atomicAdd(&bar[XB_TMO], 1u); break; } }
    }
    nloc = mine > 0u ? mine : 1u; nx = cnt > 0u ? cnt : 1u;
}
__device__ __forceinline__ void xcd_barrier(const XcdBarrier& b) {
    asm volatile("s_waitcnt vmcnt(0)" ::: "memory");
    __syncthreads();
    if (threadIdx.x == 0) {
        unsigned* bar = b.bar;
        __builtin_amdgcn_s_waitcnt(0);
        unsigned nloc = b.st[0], nx = b.st[1];
        if (nloc == 0u) { xcd_barrier_complete(bar, b.x, nloc, nx); b.st[0] = nloc; b.st[1] = nx; }
        const unsigned old = xb_add(&bar[XB_XSUB(b.x)], 1u);
        const unsigned gen = old / nloc;
        if (old + 1u == (gen + 1u) * nloc) {
            __builtin_amdgcn_fence(__ATOMIC_RELEASE, "agent");
            asm volatile("s_waitcnt vmcnt(0)" ::: "memory");
            const unsigned og = xb_add(&bar[XB_TOP], 1u);
            const unsigned tg = og / nx;
            if (og + 1u == (tg + 1u) * nx) xb_add(&bar[XB_TOPGEN], 1u);
            else XB_SPIN(xb_ld(&bar[XB_TOPGEN]) == tg, bar);
            __builtin_amdgcn_fence(__ATOMIC_ACQUIRE, "agent");
            xb_add(&bar[XB_XGEN(b.x)], 1u);
            asm volatile("s_waitcnt vmcnt(0)" ::: "memory");
        } else {
            XB_SPIN(xb_ld(&bar[XB_XGEN(b.x)]) == gen, bar);
            __builtin_amdgcn_fence(__ATOMIC_ACQUIRE, "agent");
            asm volatile("s_waitcnt vmcnt(0)" ::: "memory");
        }
    }
    __syncthreads();
}

__device__ __forceinline__ float wave_sum(float v) {
#pragma unroll
    for (int o = 1; o < 64; o <<= 1) v += __shfl_xor(v, o);
    return v;
}
__device__ __forceinline__ float wave_max(float v) {
#pragma unroll
    for (int o = 1; o < 64; o <<= 1) v = __builtin_fmaxf(v, __shfl_xor(v, o));
    return v;
}
__device__ __forceinline__ void p0_transpose_item(const float* W, int K, int N, bf16* WT, const float* gk, LAS float* scr, int item, int lane) {
    const int nblk = N / 32, kb = item / nblk, nb = item % nblk, k0 = 64 * kb, n0 = 32 * nb;
#pragma unroll 8
    for (int i = 0; i < 32; ++i) { const int kk = 2 * i + (lane >> 5); float v = W[(size_t)(k0 + kk) * N + n0 + (lane & 31)]; if (gk) v *= gk[k0 + kk]; scr[kk * 33 + (lane & 31)] = v; }
    LDS_WAIT(); asm volatile("" ::: "memory");
    const int c = lane & 7;
#pragma unroll
    for (int j = 0; j < 4; ++j) { const int n = (lane >> 3) + 8 * j; const LAS float* s = scr + (8 * c) * 33 + n;
        v4u o; o.x = pk2(s[0 * 33], s[1 * 33]); o.y = pk2(s[2 * 33], s[3 * 33]); o.z = pk2(s[4 * 33], s[5 * 33]); o.w = pk2(s[6 * 33], s[7 * 33]);
        *(GAS v4u*)(WT + (size_t)(n0 + n) * K + k0 + 8 * c) = o; }
    LDS_WAIT(); asm volatile("" ::: "memory");
}
__device__ __forceinline__ void rms_row_to_bf16(const float* xrow, const float* gain, bf16* orow, int lane) {
    const GAS f32x4* xr = (const GAS f32x4*)xrow + lane; const GAS f32x4* gr = (const GAS f32x4*)gain + lane;
    f32x4 v[4]; float s = 0.f;
#pragma unroll
    for (int j = 0; j < 4; ++j) { v[j] = xr[64 * j]; s += (v[j].x * v[j].x + v[j].y * v[j].y) + (v[j].z * v[j].z + v[j].w * v[j].w); }
    const float rstd = __builtin_amdgcn_rsqf(wave_sum(s) * (1.f / D) + RMS_EPS);
    GAS unsigned long long* o8 = (GAS unsigned long long*)orow + lane;
#pragma unroll
    for (int j = 0; j < 4; ++j) { const f32x4 gg = gr[64 * j]; const f32x4 y = v[j] * rstd * gg;
        o8[64 * j] = (unsigned long long)pk2(y.x, y.y) | ((unsigned long long)pk2(y.z, y.w) << 32); }
}

__device__ __forceinline__ void attn_naive(const bf16* PROJ, bf16* MIX, const float* gqa, const float* gka, const float* gqb, const float* gkb, const float* sinks, int gtid, int nthr) {
    float mqa = 0.f, mka = 0.f, mqb = 0.f, mkb = 0.f;
    for (int d = 0; d < HD; ++d) { mqa = __builtin_fmaxf(mqa, __builtin_fabsf(gqa[d])); mka = __builtin_fmaxf(mka, __builtin_fabsf(gka[d])); mqb = __builtin_fmaxf(mqb, __builtin_fabsf(gqb[d])); mkb = __builtin_fmaxf(mkb, __builtin_fabsf(gkb[d])); }
    const float shiftA = pg8::C2 * 64.f * mqa * mka, shiftB = pg8::C2 * 64.f * mqb * mkb;
    for (long item = gtid; item < (long)M * 16; item += nthr) {
        const int hh = (int)(item / M), m = (int)(item % M), t = m & (SEQ - 1), rowbase = m - t;
        const bool isA = hh < 8; const int h = hh & 7;
        const int qcol = isA ? COL_QA + h * 64 : COL_QB + h * 64, kcol = isA ? COL_KA + (h >> 2) * 64 : COL_KB + h * 64, vcol = isA ? COL_VA + (h >> 2) * 64 : COL_VB + h * 64;
        const float shift = isA ? shiftA : shiftB;
        float q[64], o[64]; float l = 0.f;
        { const v4u* qp = (const v4u*)(PROJ + (size_t)m * NPROJ + qcol);
#pragma unroll
          for (int c = 0; c < 8; ++c) { const v4u u = qp[c]; q[8 * c + 0] = bf_lo(u.x); q[8 * c + 1] = bf_hi(u.x); q[8 * c + 2] = bf_lo(u.y); q[8 * c + 3] = bf_hi(u.y); q[8 * c + 4] = bf_lo(u.z); q[8 * c + 5] = bf_hi(u.z); q[8 * c + 6] = bf_lo(u.w); q[8 * c + 7] = bf_hi(u.w); } }
#pragma unroll
        for (int d = 0; d < 64; ++d) o[d] = 0.f;
#define KEY(srow, wgt) do { const v4u* kp = (const v4u*)(PROJ + (size_t)(rowbase + (srow)) * NPROJ + kcol); float sc = 0.f; \
        _Pragma("unroll") for (int c = 0; c < 8; ++c) { const v4u u = kp[c]; sc += q[8 * c + 0] * bf_lo(u.x) + q[8 * c + 1] * bf_hi(u.x) + q[8 * c + 2] * bf_lo(u.y) + q[8 * c + 3] * bf_hi(u.y) + q[8 * c + 4] * bf_lo(u.z) + q[8 * c + 5] * bf_hi(u.z) + q[8 * c + 6] * bf_lo(u.w) + q[8 * c + 7] * bf_hi(u.w); } \
        const float p = (wgt) * __builtin_amdgcn_exp2f(sc - shift); l += p; const v4u* vp = (const v4u*)(PROJ + (size_t)(rowbase + (srow)) * NPROJ + vcol); \
        _Pragma("unroll") for (int c = 0; c < 8; ++c) { const v4u u = vp[c]; o[8 * c + 0] += p * bf_lo(u.x); o[8 * c + 1] += p * bf_hi(u.x); o[8 * c + 2] += p * bf_lo(u.y); o[8 * c + 3] += p * bf_hi(u.y); o[8 * c + 4] += p * bf_lo(u.z); o[8 * c + 5] += p * bf_hi(u.z); o[8 * c + 6] += p * bf_lo(u.w); o[8 * c + 7] += p * bf_hi(u.w); } } while (0)
        if (isA) {
            for (int dist = 0; dist <= 127 && dist <= t; ++dist) KEY(t - dist, 1.0f);
            l += __builtin_amdgcn_exp2f(sinks[h] * 1.4426950408889634f - shift);
        } else {
            for (int dist = 0; dist <= 128 && dist <= t; ++dist) { const float w = 1.0f + (((dist & 3) == 0) ? 1.0f : 0.0f) + (((dist & 15) == 0) ? 1.0f : 0.0f); KEY(t - dist, w); }
            for (int dist = 132; dist <= 512 && dist <= t; dist += 4) { const float w = 1.0f + (((dist & 15) == 0) ? 1.0f : 0.0f); KEY(t - dist, w); }
            for (int dist = 528; dist <= t; dist += 16) KEY(t - dist, 1.0f);
        }
#undef KEY
        const float rl = 1.0f / l;
        v4u* op = (v4u*)(MIX + (size_t)m * D + hh * 64);
#pragma unroll
        for (int c = 0; c < 8; ++c) { v4u u; u.x = pk2(o[8 * c + 0] * rl, o[8 * c + 1] * rl); u.y = pk2(o[8 * c + 2] * rl, o[8 * c + 3] * rl); u.z = pk2(o[8 * c + 4] * rl, o[8 * c + 5] * rl); u.w = pk2(o[8 * c + 6] * rl, o[8 * c + 7] * rl); op[c] = u; }
    }
}


typedef short a_bf16x8 __attribute__((ext_vector_type(8)));
typedef short a_s16x4 __attribute__((ext_vector_type(4)));
typedef float a_f32x16 __attribute__((ext_vector_type(16)));
typedef float a_f32x2 __attribute__((ext_vector_type(2)));
typedef __bf16 a_bf16x2 __attribute__((ext_vector_type(2)));
__device__ __forceinline__ unsigned a_cvtpk(float lo, float hi) { a_f32x2 v = {lo, hi}; a_bf16x2 b = __builtin_convertvector(v, a_bf16x2); return __builtin_bit_cast(unsigned, b); }
__device__ __forceinline__ a_s16x4 a_vtr(LAS const unsigned char* p) { return __builtin_bit_cast(a_s16x4, __builtin_amdgcn_ds_read_tr16_b64_v4i16((LAS a_s16x4*)p)); }
constexpr int ATT_WLDS = 16384;
constexpr int ATT_STG = 8192, ATT_STG_PITCH = 144;

struct AttnTask { int qrow0, qrs, qcol, kcol, vcol, n1, row1, D01, kt2lo, kt2hi, row2, D02, qstep2, maxd2, orow0, ors, ocol; float shift, sinkterm; };

__device__ __forceinline__ void attn_task(const bf16* __restrict__ PROJ, bf16* __restrict__ MIX, LAS unsigned char* wl, const int lane, const AttnTask& T) {
    const int i = lane & 31, hh = lane >> 5;
    a_bf16x8 qf[4];
    { const bf16* qp = PROJ + (size_t)(T.qrow0 + i * T.qrs) * NPROJ + T.qcol + 8 * hh;
#pragma unroll
      for (int s = 0; s < 4; ++s) qf[s] = *(const a_bf16x8*)(qp + 16 * s); }
    a_f32x16 o0 = {}, o1 = {}; float lsum = 0.f;
    const int Dl1 = T.D01 + i - 4 * hh, Dl2 = T.D02 + T.qstep2 * i - 4 * hh;
    float wg[4];
#pragma unroll
    for (int c = 0; c < 4; ++c) wg[c] = ((Dl1 & 3) == c) ? 1.0f : 0.0f;
    const int nt = T.n1 + (T.kt2hi - T.kt2lo);
    const int klane = i * NPROJ + 8 * hh, vlane = (lane >> 3) * NPROJ + (lane & 7) * 8;
    LAS unsigned char* vw = wl + ((lane & 7) >> 2) * 2048 + (lane >> 3) * 64 + (lane & 3) * 16;
    LAS const unsigned char* tra = wl + (4 * hh + ((lane & 15) >> 2)) * 64 + ((lane >> 4) & 1) * 32 + (lane & 3) * 8;
    a_f32x16 negs;
#pragma unroll
    for (int r = 0; r < 16; ++r) negs[r] = -T.shift;
    v4u kn[4]; v4u vn[4];
#define ATT_LOAD(j) do { const int seg1_ = (j) < T.n1; const int kt_ = seg1_ ? (j) : T.kt2lo + ((j) - T.n1); const int row_ = seg1_ ? T.row1 + 128 * kt_ : T.row2 + 32 * kt_; const int rs_ = seg1_ ? 4 : 1; \
        const bf16* kb_ = PROJ + (size_t)row_ * NPROJ + T.kcol + (size_t)(vlane - (lane & 7) * 8) * rs_ + (lane & 7) * 8; const bf16* vb_ = PROJ + (size_t)row_ * NPROJ + T.vcol + (size_t)(vlane - (lane & 7) * 8) * rs_ + (lane & 7) * 8; \
        _Pragma("unroll") for (int jj = 0; jj < 4; ++jj) kn[jj] = *(const v4u*)(kb_ + (size_t)(8 * jj * rs_) * NPROJ); \
        _Pragma("unroll") for (int jj = 0; jj < 4; ++jj) vn[jj] = *(const v4u*)(vb_ + (size_t)(8 * jj * rs_) * NPROJ); } while (0)
    ATT_LOAD(0);
    for (int j = 0; j < nt; ++j) {
        v4u kr[4]; v4u vr[4];
#pragma unroll
        for (int s = 0; s < 4; ++s) { kr[s] = kn[s]; vr[s] = vn[s]; }
        if (j + 1 < nt) ATT_LOAD(j + 1);
        const bool seg1 = j < T.n1; const int kt = seg1 ? j : T.kt2lo + (j - T.n1);
        const int Dt = (seg1 ? Dl1 : Dl2) - 32 * kt;
        const int D0 = (seg1 ? T.D01 : T.D02) - 32 * kt, qst = seg1 ? 1 : T.qstep2, maxd = seg1 ? 128 : T.maxd2;
        const int dpmin = D0 - 31, dpmax = D0 + 31 * qst;
        const int cls = (dpmin >= 0 && dpmax <= maxd) ? 1 : (dpmin > maxd ? 2 : 0);
#pragma unroll
        for (int jj = 0; jj < 4; ++jj) *(LAS v4u*)(vw + 512 * jj) = vr[jj];
#pragma unroll
        for (int jj = 0; jj < 4; ++jj) *(LAS v4u*)(wl + 4096 + (lane & 7) * 512 + (((8 * jj + (lane >> 3)) ^ (lane & 7)) * 16)) = kr[jj];
        a_bf16x8 kf[4];
#pragma unroll
        for (int s = 0; s < 4; ++s) kf[s] = *(LAS const a_bf16x8*)(wl + 4096 + (2 * s + hh) * 512 + ((i ^ (2 * s + hh)) * 16));
        a_f32x16 S = negs;
#pragma unroll
        for (int s = 0; s < 4; ++s) S = __builtin_amdgcn_mfma_f32_32x32x16_bf16(kf[s], qf[s], S, 0, 0, 0);
        float p[16];
        float wm[4];
#pragma unroll
        for (int c = 0; c < 4; ++c) wm[c] = seg1 ? wg[c] : 0.0f;
        if (cls == 1) {
#pragma unroll
            for (int r = 0; r < 16; ++r) p[r] = (1.0f + wm[r & 3]) * __builtin_amdgcn_exp2f(S[r]);
        } else if (cls == 2) {
#pragma unroll
            for (int r = 0; r < 16; ++r) p[r] = wm[r & 3] * __builtin_amdgcn_exp2f(S[r]);
        } else {
#pragma unroll
            for (int r = 0; r < 16; ++r) { const int dp = Dt - ((r & 3) + 8 * (r >> 2));
                const float w = (((unsigned)dp <= (unsigned)maxd) ? 1.0f : 0.0f) + ((dp >= 0) ? wm[r & 3] : 0.0f);
                p[r] = w * __builtin_amdgcn_exp2f(S[r]); }
        }
        float ls = 0.f;
#pragma unroll
        for (int r = 0; r < 16; ++r) ls += p[r];
        lsum += ls;
        a_bf16x8 pb0, pb1;
        { v4u w0, w1; w0.x = a_cvtpk(p[0], p[1]); w0.y = a_cvtpk(p[2], p[3]); w0.z = a_cvtpk(p[4], p[5]); w0.w = a_cvtpk(p[6], p[7]);
          w1.x = a_cvtpk(p[8], p[9]); w1.y = a_cvtpk(p[10], p[11]); w1.z = a_cvtpk(p[12], p[13]); w1.w = a_cvtpk(p[14], p[15]);
          pb0 = __builtin_bit_cast(a_bf16x8, w0); pb1 = __builtin_bit_cast(a_bf16x8, w1); }
        {
            a_s16x4 lo, hi;
#define ATT_VF (a_bf16x8){lo[0], lo[1], lo[2], lo[3], hi[0], hi[1], hi[2], hi[3]}
            lo = a_vtr(tra);               hi = a_vtr(tra + 512);               o0 = __builtin_amdgcn_mfma_f32_32x32x16_bf16(ATT_VF, pb0, o0, 0, 0, 0);
            lo = a_vtr(tra + 1024);        hi = a_vtr(tra + 1024 + 512);        o0 = __builtin_amdgcn_mfma_f32_32x32x16_bf16(ATT_VF, pb1, o0, 0, 0, 0);
            lo = a_vtr(tra + 2048);        hi = a_vtr(tra + 2048 + 512);        o1 = __builtin_amdgcn_mfma_f32_32x32x16_bf16(ATT_VF, pb0, o1, 0, 0, 0);
            lo = a_vtr(tra + 2048 + 1024); hi = a_vtr(tra + 2048 + 1024 + 512); o1 = __builtin_amdgcn_mfma_f32_32x32x16_bf16(ATT_VF, pb1, o1, 0, 0, 0);
#undef ATT_VF
        }
    }
#undef ATT_LOAD
    const float ltot = lsum + __shfl_xor(lsum, 32) + T.sinkterm;
    const float rl = 1.0f / ltot;
    LAS unsigned char* stg = wl + ATT_STG;
#pragma unroll
    for (int g = 0; g < 4; ++g) {
        typedef unsigned u32x2_t __attribute__((ext_vector_type(2)));
        u32x2_t a, b2;
        a.x = a_cvtpk(o0[4 * g] * rl, o0[4 * g + 1] * rl); a.y = a_cvtpk(o0[4 * g + 2] * rl, o0[4 * g + 3] * rl);
        b2.x = a_cvtpk(o1[4 * g] * rl, o1[4 * g + 1] * rl); b2.y = a_cvtpk(o1[4 * g + 2] * rl, o1[4 * g + 3] * rl);
        *(LAS u32x2_t*)(stg + i * ATT_STG_PITCH + (8 * g + 4 * hh) * 2) = a;
        *(LAS u32x2_t*)(stg + i * ATT_STG_PITCH + (32 + 8 * g + 4 * hh) * 2) = b2;
    }
#pragma unroll
    for (int jj = 0; jj < 4; ++jj) { const int row = jj * 8 + (lane >> 3), ch = lane & 7;
        const v4u v = *(LAS const v4u*)(stg + row * ATT_STG_PITCH + ch * 16);
        *(v4u*)(MIX + (size_t)(T.orow0 + row * T.ors) * D + T.ocol + ch * 8) = v; }
}

__device__ __forceinline__ void attn_phase(const bf16* PROJ, bf16* MIX, const float* gqa, const float* gka, const float* gqb, const float* gkb, const float* sinks, LAS unsigned char* lds, int vcu, int G, int wave, int lane) {
    const float mqa = wave_max(__builtin_fabsf(gqa[lane])), mka = wave_max(__builtin_fabsf(gka[lane])), mqb = wave_max(__builtin_fabsf(gqb[lane])), mkb = wave_max(__builtin_fabsf(gkb[lane]));
    const float shiftA = pg8::C2 * 64.f * mqa * mka, shiftB = pg8::C2 * 64.f * mqb * mkb;
    LAS unsigned char* wl = lds + wave * ATT_WLDS;
    for (int v = vcu; v < BATCH * 8; v += G) {
        const int b = v >> 3, h = v & 7, rowb = b * SEQ;
        for (int k = 0; k < 16; ++k) {
            AttnTask T;
            if (k < 8) {
                const int r = wave & 3, half = wave >> 2, pr = 2 * (k >> 1) + half, c = (k & 1) ? 15 - pr : pr;
                T.qrow0 = rowb + 128 * c + r; T.qrs = 4; T.qcol = COL_QB + h * 64; T.kcol = COL_KB + h * 64; T.vcol = COL_VB + h * 64;
                T.n1 = c + 1; T.row1 = rowb + r; T.D01 = 32 * c;
                T.kt2lo = (c == 0) ? 4 : 0; T.kt2hi = 8; T.row2 = rowb + 128 * c - 128; T.D02 = 128 + r; T.qstep2 = 4; T.maxd2 = 128;
                T.orow0 = T.qrow0; T.ors = 4; T.ocol = 512 + h * 64; T.shift = shiftB; T.sinkterm = 0.f;
            } else {
                const int c = wave + 8 * (k - 8);
                T.qrow0 = rowb + 32 * c; T.qrs = 1; T.qcol = COL_QA + h * 64; T.kcol = COL_KA + (h >> 2) * 64; T.vcol = COL_VA + (h >> 2) * 64;
                T.n1 = 0; T.row1 = rowb; T.D01 = 0;
                T.kt2lo = (c < 4) ? 4 - c : 0; T.kt2hi = 5; T.row2 = rowb + 32 * c - 128; T.D02 = 128; T.qstep2 = 1; T.maxd2 = 127;
                T.orow0 = T.qrow0; T.ors = 1; T.ocol = h * 64; T.shift = shiftA; T.sinkterm = __builtin_amdgcn_exp2f(sinks[h] * 1.4426950408889634f - shiftA);
            }
            attn_task(PROJ, MIX, wl, lane, T);
        }
    }
}

struct Args { const float* in[13]; float* out; unsigned char* ws; int ph_lo, ph_hi, li, pad; };
__global__ void __launch_bounds__(NWAVES * 64, 2) hymba_fwd(Args args) {
    extern __shared__ __attribute__((aligned(16))) unsigned char lds[];
    LAS unsigned char* L = (LAS unsigned char*)lds;
    volatile LAS unsigned* MISC = (volatile LAS unsigned*)(L + MISC_OFF);
    const int tid = threadIdx.x, lane = tid & 63, wave = __builtin_amdgcn_readfirstlane(tid >> 6);
    const int G = gridDim.x; const int bx = blockIdx.x; const int vcu = (G % 8 == 0) ? (bx % 8) * (G / 8) + bx / 8 : bx;
    unsigned char* ws = args.ws;
    gu32* ctl = (gu32*)(ws + WS_CTL);
    const float* x = args.in[0]; const int* positions = (const int*)args.in[1]; const float* g_attn = args.in[2]; const float* w_in = args.in[3];
    const float* gqa = args.in[4]; const float* gka = args.in[5]; const float* sinks = args.in[6]; const float* gqb = args.in[7]; const float* gkb = args.in[8];
    const float* w_out = args.in[9]; const float* g_mlp = args.in[10]; const float* w_up = args.in[11]; const float* w_dn = args.in[12];
    float* out = args.out;
    bf16* Win_t = (bf16*)(ws + WS_WIN); bf16* Wout_t = (bf16*)(ws + WS_WOUT); bf16* Wup_t = (bf16*)(ws + WS_WUP); bf16* Wdn_t = (bf16*)(ws + WS_WDN);
    float* rope = (float*)(ws + WS_ROPE); float* ssp = (float*)(ws + WS_SS);
    bf16* XN = (bf16*)(ws + WS_XN); bf16* PROJ = (bf16*)(ws + WS_PROJ); bf16* MIXB = (bf16*)(ws + WS_MIX); bf16* HID = (bf16*)(ws + WS_HID);
    for (int u = tid; u < (LDS_BYTES - LDSCTL_OFF) / 4; u += NWAVES * 64) ((LAS unsigned*)(L + LDSCTL_OFF))[u] = 0u;
    __syncthreads();
    const int bli = (N_LAUNCHES == PER_PHASE) ? 0 : args.li;
    XcdBarrier bar; bar.bar = (unsigned*)(ctl + CW_BAR) + bli * XCD_BAR_WORDS; bar.x = 0; bar.st = nullptr;
    if (N_LAUNCHES != PER_PHASE) bar = xcd_barrier_post((unsigned*)(ctl + CW_BAR) + bli * XCD_BAR_WORDS, MISC + 8);
#define GRID_BAR(seam) do { if (N_LAUNCHES == PER_PHASE) { if (tid == 0) __hip_atomic_store(ctl + CW_TMO, 0xBADBA0u | (unsigned)(seam), RLX_AGENT); } else { xcd_barrier(bar); } } while (0)
    const int lo = args.ph_lo, hi = args.ph_hi;
#define IN(k) (lo <= (k) && (k) < hi)
#define BOTH(k) (IN(k) && IN((k) + 1))

    if (IN(0)) { REP(0) {
        LAS float* scr = (LAS float*)(L + RING_OFF + wave * 16384);
        const int gw = vcu * NWAVES + wave, NGW = G * NWAVES;
        constexpr int I_IN = (D / 64) * (NPROJ / 32), I_OUT = (D / 64) * (D / 32), I_UP = (D / 64) * (FF / 32), I_DN = (FF / 64) * (D / 32);
        constexpr int NITEMS = I_IN + I_OUT + I_UP + I_DN;
        for (int it = gw; it < NITEMS; it += NGW) {
            int r = it;
            if (r < I_IN) { p0_transpose_item(w_in, D, NPROJ, Win_t, nullptr, scr, r, lane); continue; } r -= I_IN;
            if (r < I_OUT) { p0_transpose_item(w_out, D, D, Wout_t, nullptr, scr, r, lane); continue; } r -= I_OUT;
            if (r < I_UP) { p0_transpose_item(w_up, D, FF, Wup_t, g_mlp, scr, r, lane); continue; } r -= I_UP;
            p0_transpose_item(w_dn, FF, D, Wdn_t, nullptr, scr, r, lane);
        }
        for (int m = gw; m < M; m += NGW) rms_row_to_bf16(x + (size_t)m * D, g_attn, XN + (size_t)m * D, lane);
        for (int it = gw * 64 + lane; it < M * 8; it += NGW * 64) {
            const int m = it >> 3, i = it & 7;
            const float inv_freq = (i == 0) ? 1.0f : (i == 1) ? 0.193922743f : (i == 2) ? 0.0376060307f : (i == 3) ? 0.00729266461f : (i == 4) ? 0.00141421356f : (i == 5) ? 0.000274248188f : (i == 6) ? 5.3182961e-05f : 1.03133862e-05f;
            const float ang = (float)positions[m] * inv_freq;
            double rev = (double)ang * 0.15915494309189535; rev -= __builtin_floor(rev);
            const float rf = (float)rev;
            rope[(size_t)m * 16 + i] = __builtin_amdgcn_cosf(rf); rope[(size_t)m * 16 + 8 + i] = __builtin_amdgcn_sinf(rf);
        }
        }
        if (BOTH(0)) GRID_BAR(0);
    }
    if (IN(1)) {
        pg8::Gemm g{XN, Win_t, M, NPROJ, D}; pg8::StaticOrder S; S.init(M, NPROJ, G, (int)blockIdx.x);
        pg8::EpiQKV E{PROJ, NPROJ, gqa, gka, gqb, gkb, rope};
        REP(1) pg8::gemm_phase<pg8::EpiQKV, pg8::StaticOrder, true>(L + RING_OFF, g, S, E);
        if (BOTH(1)) GRID_BAR(1);
    }
    if (IN(2)) {
#if defined(NAIVE_ATTN)
        attn_naive(PROJ, MIXB, gqa, gka, gqb, gkb, sinks, vcu * (NWAVES * 64) + tid, G * NWAVES * 64);
#else
        REP(2) attn_phase(PROJ, MIXB, gqa, gka, gqb, gkb, sinks, L + RING_OFF, vcu, G, wave, lane);
#endif
        if (BOTH(2)) GRID_BAR(2);
    }
    if (IN(3)) {
        pg8::Gemm g{MIXB, Wout_t, M, D, D}; pg8::StaticOrder S; S.init(M, D, G, (int)blockIdx.x);
        pg8::EpiOut E{x, out, XN, ssp, D};
        REP(3) pg8::gemm_phase<pg8::EpiOut, pg8::StaticOrder, true>(L + RING_OFF, g, S, E);
        if (BOTH(3)) GRID_BAR(3);
    }
    if (IN(4)) {
        pg8::Gemm g{XN, Wup_t, M, FF, D}; pg8::StaticOrder S; S.init(M, FF, G, (int)blockIdx.x);
        pg8::EpiUp E{ssp, HID, FF, 1.0f / D, RMS_EPS};
        REP(4) pg8::gemm_phase<pg8::EpiUp, pg8::StaticOrder, true>(L + RING_OFF, g, S, E);
        if (BOTH(4)) GRID_BAR(4);
    }
    if (IN(5)) {
        pg8::Gemm g{HID, Wdn_t, M, D, FF}; pg8::StaticOrder S; S.init(M, D, G, (int)blockIdx.x);
        pg8::EpiDown E{out, D};
        pg8::gemm_phase<pg8::EpiDown, pg8::StaticOrder, true>(L + RING_OFF, g, S, E);
    }
#undef IN
#undef BOTH
}

extern "C" void kernel_launch(void* const* d_in, const int* in_sizes, int n_in, void* d_out, int out_size, void* d_ws, size_t ws_size, hipStream_t stream) {
    static int grid = 0;
    if (grid == 0) {
        if (n_in != 13 || in_sizes[0] != M * D || out_size != M * D || ws_size < WS_END) { fprintf(stderr, "kernel_launch: shape/workspace mismatch (n_in %d in0 %d out %d ws %zu); nothing launched\n", n_in, n_in > 0 ? in_sizes[0] : -1, out_size, ws_size); grid = -1; return; }
        int dev = 0, cus = 0, per_cu = 0;
        if (hipGetDevice(&dev) != hipSuccess || hipDeviceGetAttribute(&cus, hipDeviceAttributeMultiprocessorCount, dev) != hipSuccess) { fprintf(stderr, "kernel_launch: device query failed\n"); grid = -1; return; }
        if (hipFuncSetAttribute((const void*)hymba_fwd, hipFuncAttributeMaxDynamicSharedMemorySize, LDS_BYTES) != hipSuccess) { fprintf(stderr, "kernel_launch: hipFuncSetAttribute failed\n"); grid = -1; return; }
        if (hipOccupancyMaxActiveBlocksPerMultiprocessor(&per_cu, (const void*)hymba_fwd, NWAVES * 64, LDS_BYTES) != hipSuccess || per_cu < 1)
            fprintf(stderr, "kernel_launch: note: occupancy query reports %d workgroups per CU\n", per_cu);
        (void)hipGetLastError();
        grid = cus;
    }
    if (grid < 0) return;
    if (hipMemsetAsync((char*)d_ws + WS_CTL, 0, CTL_ZERO_BYTES, stream) != hipSuccess) { fprintf(stderr, "kernel_launch: hipMemsetAsync failed\n"); return; }
    Args a{};
    for (int i = 0; i < 13; ++i) a.in[i] = (const float*)d_in[i];
    a.out = (float*)d_out; a.ws = (unsigned char*)d_ws;
    static_assert(N_LAUNCHES == 1 || N_LAUNCHES == PER_PHASE, "MK_N_LAUNCHES must be 1 or 6");
    for (int li = 0; li < N_LAUNCHES; ++li) {
        a.ph_lo = (N_LAUNCHES == PER_PHASE) ? li : 0; a.ph_hi = (N_LAUNCHES == PER_PHASE) ? li + 1 : PER_PHASE; a.li = li;
        hipLaunchKernelGGL(hymba_fwd, dim3(grid), dim3(NWAVES * 64), LDS_BYTES, stream, a);
        const hipError_t le = hipPeekAtLastError();
        if (le != hipSuccess) { fprintf(stderr, "kernel_launch: launch %d failed: %s\n", li, hipGetErrorName(le)); break; }
    }
}
```

```cpp
#include <hip/hip_runtime.h>
#include <cstdio>
#include <cstdint>

#ifndef MK_N_LAUNCHES
#define MK_N_LAUNCHES 1
#endif
#ifndef REPEAT_MASK
#define REPEAT_MASK 0
#endif
#define REP(k) for (int rep_ = 0; rep_ < 1 + ((REPEAT_MASK >> (k)) & 1); ++rep_)

namespace pg8 {
#define PG8_LAS __attribute__((address_space(3)))
typedef unsigned short bf16_t;
typedef short bf16x8 __attribute__((ext_vector_type(8)));
typedef float f32x4 __attribute__((ext_vector_type(4)));
typedef unsigned u32x4 __attribute__((ext_vector_type(4)));
constexpr int BM = 256, BK = 64, HALF = 128, HTB = HALF * BK * 2  , STAGE_BYTES = 8 * HTB, NXCD = 8, WGM = 8;

__host__ __device__ __forceinline__ int lds_byte(int r, int c) { const int st = (r >> 4) * 2 + (c >> 5), rr = r & 15, cc = c & 31, ob = rr * 64 + cc * 2; return st * 1024 + (ob ^ (((ob >> 9) & 1) << 5)); }
__host__ __device__ __forceinline__ void stage_rc(int b, int& R, int& C) { const int st = b / 1024, sb = b % 1024, swz = sb ^ (((sb >> 9) & 1) << 5); R = (st >> 1) * 16 + swz / 64; C = (st & 1) * 32 + (swz % 64) / 2; }
__host__ __device__ __forceinline__ int perm32(int rho) { const int n = rho >> 4, i = rho & 15; return 8 * (i >> 2) + 4 * n + (i & 3); }

struct Unit { int pm, pn; };
struct Gemm { const bf16_t* A; const bf16_t* Bt; int M, N, K; };

struct StaticOrder {
    int nM, nN, nwg, G, c;
    __host__ __device__ void init(int M, int N, int G_, int c_) { nM = M / BM; nN = N / BM; nwg = nM * nN; G = G_; c = c_; }
    __host__ __device__ bool next(int i, Unit& u) const {
        const long L = (long)i * G + c; if (L >= nwg) return false;
        int wgid = (int)L; { const int q = nwg / NXCD, r = nwg % NXCD, xcd = wgid % NXCD, off = wgid / NXCD; wgid = (xcd < r ? xcd * (q + 1) : r * (q + 1) + (xcd - r) * q) + off; }
        const int nig = WGM * nN, gid = wgid / nig, fm = gid * WGM, gsz = (nM - fm) < WGM ? (nM - fm) : WGM;
        u.pm = fm + ((wgid % nig) % gsz); u.pn = (wgid % nig) / gsz; return true;
    }
};

__device__ __forceinline__ unsigned cvt_pk_bf16(float lo, float hi) { unsigned r; asm volatile("v_cvt_pk_bf16_f32 %0, %1, %2" : "=v"(r) : "v"(lo), "v"(hi)); return r; }

constexpr float QK_EPS = 1e-6f;
constexpr float C2 = 0.125f * 1.4426950408889634f;

struct EpiQKV {
    bf16_t* O; int ldc; const float* gqa; const float* gka; const float* gqb; const float* gkb; const float* rope;
    __device__ __forceinline__ void operator()(const f32x4 (&acc)[2][2][4][2], const Unit& u, int wr, int wc, int fr, int fq) const {
        const int pn = u.pn; int mode = 0; const float* g = gqa;
        if (pn < 2) { mode = 1; g = gqa; } else if (pn == 2) { if (wc < 2) { mode = 2; g = gka; } } else if (pn < 5) { mode = 1; g = gqb; } else if (pn < 7) { mode = 2; g = gkb; }
        const int row0 = u.pm * BM + wr * 64 + fr, col0 = pn * BM + wc * 64 + 8 * fq;
        if (mode == 0) {
#pragma unroll
            for (int ai = 0; ai < 2; ++ai)
#pragma unroll
                for (int m = 0; m < 4; ++m) { bf16_t* rowp = O + (size_t)(row0 + ai * HALF + m * 16) * ldc + col0;
#pragma unroll
                    for (int bj = 0; bj < 2; ++bj) { const f32x4 v0 = acc[ai][bj][m][0], v1 = acc[ai][bj][m][1]; u32x4 w;
                        w.x = cvt_pk_bf16(v0[0], v0[1]); w.y = cvt_pk_bf16(v0[2], v0[3]); w.z = cvt_pk_bf16(v1[0], v1[1]); w.w = cvt_pk_bf16(v1[2], v1[3]);
                        *(u32x4*)(rowp + bj * 32) = w; } }
            return;
        }
        f32x4 gv[2][2];
#pragma unroll
        for (int bj = 0; bj < 2; ++bj)
#pragma unroll
            for (int n = 0; n < 2; ++n) gv[bj][n] = *(const f32x4*)(g + 32 * bj + 8 * fq + 4 * n);
        const float sc = (mode == 1) ? C2 : 1.0f;
        const float sgn = (fq == 0) ? -1.0f : 1.0f;
#pragma unroll
        for (int ai = 0; ai < 2; ++ai)
#pragma unroll
            for (int m = 0; m < 4; ++m) {
                const int row = row0 + ai * HALF + m * 16;
                float ss = 0.f;
#pragma unroll
                for (int bj = 0; bj < 2; ++bj)
#pragma unroll
                    for (int n = 0; n < 2; ++n) { const f32x4 x = acc[ai][bj][m][n]; ss += (x[0] * x[0] + x[1] * x[1]) + (x[2] * x[2] + x[3] * x[3]); }
                ss += __shfl_xor(ss, 16); ss += __shfl_xor(ss, 32);
                const float rs = __builtin_amdgcn_rsqf(ss * (1.0f / 64.0f) + QK_EPS);
                f32x4 y[2][2];
#pragma unroll
                for (int bj = 0; bj < 2; ++bj)
#pragma unroll
                    for (int n = 0; n < 2; ++n) y[bj][n] = acc[ai][bj][m][n] * rs * gv[bj][n];
                const f32x4 c0 = *(const f32x4*)(rope + (size_t)row * 16), c1 = *(const f32x4*)(rope + (size_t)row * 16 + 4);
                const f32x4 s0 = *(const f32x4*)(rope + (size_t)row * 16 + 8), s1 = *(const f32x4*)(rope + (size_t)row * 16 + 12);
                f32x4 p0, p1;
#pragma unroll
                for (int e = 0; e < 4; ++e) { p0[e] = __shfl_xor(y[0][0][e], 16); p1[e] = __shfl_xor(y[0][1][e], 16); }
                if (fq < 2) { y[0][0] = y[0][0] * c0 + p0 * s0 * sgn; y[0][1] = y[0][1] * c1 + p1 * s1 * sgn; }
                bf16_t* rowp = O + (size_t)row * ldc + col0;
#pragma unroll
                for (int bj = 0; bj < 2; ++bj) { const f32x4 v0 = y[bj][0] * sc, v1 = y[bj][1] * sc; u32x4 w;
                    w.x = cvt_pk_bf16(v0[0], v0[1]); w.y = cvt_pk_bf16(v0[2], v0[3]); w.z = cvt_pk_bf16(v1[0], v1[1]); w.w = cvt_pk_bf16(v1[2], v1[3]);
                    *(u32x4*)(rowp + bj * 32) = w; }
            }
    }
};

struct EpiOut {
    const float* x; float* h; bf16_t* hb; float* ssp; int ldc;
    __device__ __forceinline__ void operator()(const f32x4 (&acc)[2][2][4][2], const Unit& u, int wr, int wc, int fr, int fq) const {
        const int row0 = u.pm * BM + wr * 64 + fr, col0 = u.pn * BM + wc * 64 + 8 * fq;
#pragma unroll
        for (int ai = 0; ai < 2; ++ai)
#pragma unroll
            for (int m = 0; m < 4; ++m) {
                const int row = row0 + ai * HALF + m * 16; const size_t off = (size_t)row * ldc + col0; float ss = 0.f;
#pragma unroll
                for (int bj = 0; bj < 2; ++bj) {
                    const f32x4 x0 = *(const f32x4*)(x + off + bj * 32), x1 = *(const f32x4*)(x + off + bj * 32 + 4);
                    const f32x4 v0 = acc[ai][bj][m][0] + x0, v1 = acc[ai][bj][m][1] + x1;
                    *(f32x4*)(h + off + bj * 32) = v0; *(f32x4*)(h + off + bj * 32 + 4) = v1;
                    u32x4 w; w.x = cvt_pk_bf16(v0[0], v0[1]); w.y = cvt_pk_bf16(v0[2], v0[3]); w.z = cvt_pk_bf16(v1[0], v1[1]); w.w = cvt_pk_bf16(v1[2], v1[3]);
                    *(u32x4*)(hb + off + bj * 32) = w;
                    ss += (v0[0] * v0[0] + v0[1] * v0[1]) + (v0[2] * v0[2] + v0[3] * v0[3]) + (v1[0] * v1[0] + v1[1] * v1[1]) + (v1[2] * v1[2] + v1[3] * v1[3]);
                }
                ss += __shfl_xor(ss, 16); ss += __shfl_xor(ss, 32);
                if (fq == 0) ssp[(size_t)row * 16 + u.pn * 4 + wc] = ss;
            }
    }
};

struct EpiUp {
    const float* ssp; bf16_t* hid; int ldc; float inv_n, eps;
    __device__ __forceinline__ void operator()(const f32x4 (&acc)[2][2][4][2], const Unit& u, int wr, int wc, int fr, int fq) const {
        const int row0 = u.pm * BM + wr * 64 + fr, col0 = u.pn * BM + wc * 64 + 8 * fq;
#pragma unroll
        for (int ai = 0; ai < 2; ++ai)
#pragma unroll
            for (int m = 0; m < 4; ++m) {
                const int row = row0 + ai * HALF + m * 16;
                const f32x4 a = *(const f32x4*)(ssp + (size_t)row * 16), b = *(const f32x4*)(ssp + (size_t)row * 16 + 4), c = *(const f32x4*)(ssp + (size_t)row * 16 + 8), d = *(const f32x4*)(ssp + (size_t)row * 16 + 12);
                const f32x4 t = (a + b) + (c + d); const float ss = (t[0] + t[1]) + (t[2] + t[3]);
                const float rs = __builtin_amdgcn_rsqf(ss * inv_n + eps);
                bf16_t* rowp = hid + (size_t)row * ldc + col0;
#pragma unroll
                for (int bj = 0; bj < 2; ++bj) { f32x4 v0 = acc[ai][bj][m][0] * rs, v1 = acc[ai][bj][m][1] * rs;
#pragma unroll
                    for (int e = 0; e < 4; ++e) { const float r0 = __builtin_fmaxf(v0[e], 0.f), r1 = __builtin_fmaxf(v1[e], 0.f); v0[e] = r0 * r0; v1[e] = r1 * r1; }
                    u32x4 w; w.x = cvt_pk_bf16(v0[0], v0[1]); w.y = cvt_pk_bf16(v0[2], v0[3]); w.z = cvt_pk_bf16(v1[0], v1[1]); w.w = cvt_pk_bf16(v1[2], v1[3]);
                    *(u32x4*)(rowp + bj * 32) = w; }
            }
    }
};

struct EpiDown {
    float* out; int ldc;
    __device__ __forceinline__ void operator()(const f32x4 (&acc)[2][2][4][2], const Unit& u, int wr, int wc, int fr, int fq) const {
        const int row0 = u.pm * BM + wr * 64 + fr, col0 = u.pn * BM + wc * 64 + 8 * fq;
#pragma unroll
        for (int ai = 0; ai < 2; ++ai)
#pragma unroll
            for (int m = 0; m < 4; ++m) {
                const size_t off = (size_t)(row0 + ai * HALF + m * 16) * ldc + col0;
#pragma unroll
                for (int bj = 0; bj < 2; ++bj) {
                    const f32x4 h0 = *(const f32x4*)(out + off + bj * 32), h1 = *(const f32x4*)(out + off + bj * 32 + 4);
                    *(f32x4*)(out + off + bj * 32) = h0 + acc[ai][bj][m][0]; *(f32x4*)(out + off + bj * 32 + 4) = h1 + acc[ai][bj][m][1];
                }
            }
    }
};

template <class Epi, class Sched, bool ALIGN_EPI>
__device__ __forceinline__ void gemm_phase(PG8_LAS unsigned char* lds, const Gemm g, const Sched& S, const Epi& E) {
    const int tid = threadIdx.x, wid = __builtin_amdgcn_readfirstlane(tid >> 6), lane = tid & 63, wr = wid >> 2, wc = wid & 3, fr = lane & 15, fq = lane >> 4;
    const int K = g.K, nt = K / BK;
    unsigned voffA[2], voffB[2];
#pragma unroll
    for (int i = 0; i < 2; ++i) { int R, C; stage_rc(tid * 16 + i * 8192, R, C); const int Rb = (R >> 5) * 64 + perm32(R & 31);
        voffA[i] = (unsigned)(R * K + C) * 2u; voffB[i] = (unsigned)(Rb * K + C) * 2u; }
    const size_t kstep = (size_t)(BK * 2);
    const size_t hstepA = (size_t)HALF * K * 2;
    const size_t hstepB = (size_t)32 * K * 2;
    const size_t tstep = (size_t)BM * K * 2;
    const unsigned ldsw = (unsigned)wid * 1024u;
    const int aoff = lds_byte(wr * 64 + fr, fq * 8), boff = lds_byte(wc * 32 + fr, fq * 8);
#define PG8_SA(b, h) (((b) * 2 + (h)) * HTB)
#define PG8_SB(b, h) ((4 + (b) * 2 + (h)) * HTB)
#define PG8_STAGE(bufoff, gbase, voff) do { _Pragma("unroll") for (int _i = 0; _i < 2; ++_i) \
        __builtin_amdgcn_global_load_lds((const unsigned*)((const char*)(gbase) + (voff)[_i]), (PG8_LAS unsigned*)(lds + (bufoff) + ldsw + _i * 8192), 16, 0, 0); } while (0)
#define PG8_LDA(dst, b, h) do { _Pragma("unroll") for (int m = 0; m < 4; ++m) _Pragma("unroll") for (int k = 0; k < 2; ++k) dst[m][k] = *(const PG8_LAS bf16x8*)(lds + PG8_SA(b, h) + aoff + m * 2048 + k * 1024); } while (0)
#define PG8_LDB(dst, b, h) do { _Pragma("unroll") for (int n = 0; n < 2; ++n) _Pragma("unroll") for (int k = 0; k < 2; ++k) dst[n][k] = *(const PG8_LAS bf16x8*)(lds + PG8_SB(b, h) + boff + n * 2048 + k * 1024); } while (0)
#define PG8_MMA(ai, bj, At, Bt) do { __builtin_amdgcn_s_setprio(1); _Pragma("unroll") for (int m = 0; m < 4; ++m) _Pragma("unroll") for (int n = 0; n < 2; ++n) _Pragma("unroll") for (int k = 0; k < 2; ++k) \
        acc[ai][bj][m][n] = __builtin_amdgcn_mfma_f32_16x16x32_bf16(Bt[n][k], At[m][k], acc[ai][bj][m][n], 0, 0, 0); __builtin_amdgcn_s_setprio(0); } while (0)
#define PG8_WAIT_V(n) asm volatile("s_waitcnt vmcnt(" #n ")" ::: "memory")
#define PG8_WAIT_L(n) asm volatile("s_waitcnt lgkmcnt(" #n ")" ::: "memory")
#define PG8_BAR __builtin_amdgcn_s_barrier()
#define PG8_SCHED __builtin_amdgcn_sched_barrier(0)
    Unit cur, nxt; int ui = 0;
    if (!S.next(0, cur)) return;
    f32x4 acc[2][2][4][2];
#pragma unroll
    for (int a = 0; a < 2; ++a)
#pragma unroll
        for (int b = 0; b < 2; ++b)
#pragma unroll
            for (int m = 0; m < 4; ++m)
#pragma unroll
                for (int n = 0; n < 2; ++n) acc[a][b][m][n] = (f32x4){0.f, 0.f, 0.f, 0.f};
    bf16x8 At[4][2], B0[2][2], B1[2][2];
    const char* cA = (const char*)g.A + (size_t)cur.pm * tstep; const char* cB = (const char*)g.Bt + (size_t)cur.pn * tstep;
    PG8_STAGE(PG8_SB(0, 0), cB, voffB); PG8_STAGE(PG8_SB(0, 1), cB + hstepB, voffB); PG8_STAGE(PG8_SA(0, 0), cA, voffA); PG8_STAGE(PG8_SA(0, 1), cA + hstepA, voffA);
    if (wr == 1) PG8_BAR;
    PG8_WAIT_V(2); PG8_BAR;
    PG8_STAGE(PG8_SB(1, 0), cB + kstep, voffB); PG8_STAGE(PG8_SA(1, 0), cA + kstep, voffA); PG8_STAGE(PG8_SB(1, 1), cB + hstepB + kstep, voffB);
    PG8_WAIT_V(6); PG8_BAR;
    for (;;) {
        const bool has_next = S.next(ui + 1, nxt);
        const char* nA = has_next ? (const char*)g.A + (size_t)nxt.pm * tstep : cA; const char* nB = has_next ? (const char*)g.Bt + (size_t)nxt.pn * tstep : cB;
        for (int t = 0; t < nt; t += 2) {
            const bool last = (t == nt - 2);
            const char* a1 = cA + (size_t)(t + 1) * kstep;
            const char* a2 = last ? nA : cA + (size_t)(t + 2) * kstep; const char* b2 = last ? nB : cB + (size_t)(t + 2) * kstep;
            const char* a3 = a2 + kstep; const char* b3 = b2 + kstep;
            PG8_LDB(B0, 0, 0); PG8_LDB(B1, 0, 1); PG8_SCHED; PG8_LDA(At, 0, 0); PG8_STAGE(PG8_SA(1, 1), a1 + hstepA, voffA);
            PG8_WAIT_V(8); PG8_WAIT_L(0); PG8_BAR; PG8_MMA(0, 0, At, B0); PG8_MMA(0, 1, At, B1); PG8_BAR; PG8_SCHED;
            PG8_LDA(At, 0, 1); PG8_STAGE(PG8_SB(0, 0), b2, voffB); PG8_STAGE(PG8_SB(0, 1), b2 + hstepB, voffB); PG8_STAGE(PG8_SA(0, 0), a2, voffA);
            PG8_WAIT_V(8); PG8_WAIT_L(0); PG8_BAR; PG8_MMA(1, 0, At, B0); PG8_MMA(1, 1, At, B1); PG8_BAR; PG8_SCHED;
            PG8_LDB(B0, 1, 0); PG8_LDB(B1, 1, 1); PG8_SCHED; PG8_LDA(At, 1, 0); PG8_STAGE(PG8_SA(0, 1), a2 + hstepA, voffA);
            PG8_WAIT_V(8); PG8_WAIT_L(0); PG8_BAR; PG8_MMA(0, 0, At, B0); PG8_MMA(0, 1, At, B1); PG8_BAR; PG8_SCHED;
            PG8_LDA(At, 1, 1); PG8_STAGE(PG8_SB(1, 0), b3, voffB); PG8_STAGE(PG8_SB(1, 1), b3 + hstepB, voffB); PG8_STAGE(PG8_SA(1, 0), a3, voffA);
            PG8_WAIT_V(8); PG8_WAIT_L(0); PG8_BAR; PG8_MMA(1, 0, At, B0); PG8_MMA(1, 1, At, B1); PG8_BAR; PG8_SCHED;
        }
        if constexpr (ALIGN_EPI) { if (wr == 0) PG8_BAR; }
        E(acc, cur, wr, wc, fr, fq);
        if (!has_next) break;
#pragma unroll
        for (int a = 0; a < 2; ++a)
#pragma unroll
            for (int b = 0; b < 2; ++b)
#pragma unroll
                for (int m = 0; m < 4; ++m)
#pragma unroll
                    for (int n = 0; n < 2; ++n) acc[a][b][m][n] = (f32x4){0.f, 0.f, 0.f, 0.f};
        cur = nxt; cA = nA; cB = nB; ++ui;
        if constexpr (ALIGN_EPI) { if (wr == 1) PG8_BAR; }
    }
    PG8_WAIT_V(0);
    if constexpr (!ALIGN_EPI) { if (wr == 0) PG8_BAR; }
    PG8_BAR;
#undef PG8_SA
#undef PG8_SB
#undef PG8_STAGE
#undef PG8_LDA
#undef PG8_LDB
#undef PG8_MMA
#undef PG8_WAIT_V
#undef PG8_WAIT_L
#undef PG8_BAR
#undef PG8_SCHED
}
}

constexpr int NWAVES = 8;
constexpr int BATCH = 32, SEQ = 2048, D = 1024, FF = 4096, HD = 64;
constexpr int M = BATCH * SEQ;
constexpr int NPROJ = 2304;
constexpr int COL_QA = 0, COL_KA = 512, COL_VA = 640, COL_QB = 768, COL_KB = 1280, COL_VB = 1792;
constexpr float RMS_EPS = 1e-6f;
constexpr int N_LAUNCHES = MK_N_LAUNCHES, PER_PHASE = 6;
constexpr int N_BAR_REGIONS = (MK_N_LAUNCHES == PER_PHASE) ? 1 : MK_N_LAUNCHES;

constexpr size_t MiB = 1u << 20;
constexpr size_t WS_CTL = 0, CTL_ZERO_BYTES = 1 * MiB;
constexpr size_t WS_WIN = 2 * MiB, WS_WOUT = 8 * MiB, WS_WUP = 10 * MiB, WS_WDN = 18 * MiB;
constexpr size_t WS_ROPE = 26 * MiB;
constexpr size_t WS_SS = 30 * MiB;
constexpr size_t WS_XN = 64 * MiB;
constexpr size_t WS_PROJ = 192 * MiB;
constexpr size_t WS_MIX = 480 * MiB;
constexpr size_t WS_HID = 192 * MiB;
constexpr size_t WS_END = 704 * MiB;
static_assert(WS_WIN + (size_t)NPROJ * D * 2 <= WS_WOUT && WS_WDN + (size_t)D * FF * 2 <= WS_ROPE && WS_SS + (size_t)M * 64 <= WS_XN, "d_ws map");
static_assert(WS_XN + (size_t)M * D * 2 <= WS_PROJ && WS_PROJ + (size_t)M * NPROJ * 2 <= WS_MIX && WS_MIX + (size_t)M * D * 2 <= WS_END && WS_HID + (size_t)M * FF * 2 <= WS_END, "d_ws map");
constexpr int CW_TMO = 0, CW_CODE = 1;
constexpr int CW_BAR = 4096;

constexpr int RING_OFF = 0, RING_BYTES = 131072;
constexpr int LDSCTL_OFF = 139264, MISC_OFF = LDSCTL_OFF + 320;
constexpr int LDS_BYTES = 147456;

#define GAS __attribute__((address_space(1)))
#define LAS __attribute__((address_space(3)))
typedef unsigned short bf16;
typedef unsigned v4u __attribute__((ext_vector_type(4)));
typedef float f32x4 __attribute__((ext_vector_type(4)));
typedef GAS unsigned gu32;
#define RLX_AGENT __ATOMIC_RELAXED, __HIP_MEMORY_SCOPE_AGENT
#define LDS_WAIT() asm volatile("s_waitcnt lgkmcnt(0)" ::: "memory")
#define VM_WAIT() asm volatile("s_waitcnt vmcnt(0)" ::: "memory")
__device__ __forceinline__ unsigned f2bf(float f) { unsigned u = __builtin_bit_cast(unsigned, f); return (u + 0x7fffu + ((u >> 16) & 1u)) >> 16; }
__device__ __forceinline__ unsigned pk2(float lo, float hi) { return f2bf(lo) | (f2bf(hi) << 16); }
__device__ __forceinline__ float bf_lo(unsigned u) { return __uint_as_float(u << 16); }
__device__ __forceinline__ float bf_hi(unsigned u) { return __uint_as_float(u & 0xffff0000u); }

#define XB_TMO      128
#define XB_XCNT(j)  (256  + 64 * (j))
#define XB_XSUB(j)  (1280 + 64 * (j))
#define XB_XGEN(j)  (2304 + 64 * (j))
#define XB_TOP      3328
#define XB_TOPGEN   3392
#define XCD_BAR_WORDS 3456
#define XB_SPIN_CAP (1u << 18)

__device__ __forceinline__ unsigned xb_ld(unsigned* p)              { return __hip_atomic_load(p, __ATOMIC_RELAXED, __HIP_MEMORY_SCOPE_AGENT); }
__device__ __forceinline__ unsigned xb_add(unsigned* p, unsigned v) { return __hip_atomic_fetch_add(p, v, __ATOMIC_RELAXED, __HIP_MEMORY_SCOPE_AGENT); }
__device__ __forceinline__ unsigned xb_xcc_id() { return (unsigned)__builtin_amdgcn_s_getreg((3 << 11) | 20) & 0xFu; }
#define XB_SPIN(cond, bar) do { unsigned _sp = 0; while (cond) { __builtin_amdgcn_s_sleep(1); \
    if ((++_sp & 255u) == 0u) { if (xb_ld(&(bar)[XB_TMO])) break; if (_sp > XB_SPIN_CAP) { atomicAdd(&(bar)[XB_TMO], 1u); break; } } } } while (0)

struct XcdBarrier { unsigned* bar; unsigned x; volatile LAS unsigned* st; };

__device__ __forceinline__ XcdBarrier xcd_barrier_post(unsigned* bar, volatile LAS unsigned* st) {
    XcdBarrier b; b.bar = bar; b.x = xb_xcc_id(); b.st = st;
    if (threadIdx.x == 0) (void)xb_add(&bar[XB_XCNT(b.x)], 1u);
    return b;
}
__device__ __forceinline__ void xcd_barrier_complete(unsigned* bar, unsigned x, unsigned& nloc, unsigned& nx) {
    const unsigned G = gridDim.x * gridDim.y * gridDim.z;
    unsigned sum, cnt, mine, sp = 0u;
    for (;;) {
        sum = 0u; cnt = 0u; mine = 0u;
#pragma unroll
        for (unsigned j = 0; j < 16; ++j) { const unsigned c = xb_ld(&bar[XB_XCNT(j)]); sum += c; cnt += (c > 0u) ? 1u : 0u; mine = (j == x) ? c : mine; }
        if (sum == G) break;
        __builtin_amdgcn_s_sleep(1);
        if ((++sp & 255u) == 0u) { if (xb_ld(&bar[XB_TMO])) break; if (sp > XB_SPIN_CAP) { atomicAdd(&bar[XB_TMO], 1u); break; } }
    }
    nloc = mine > 0u ? mine : 1u; nx = cnt > 0u ? cnt : 1u;
}
__device__ __forceinline__ void xcd_barrier(const XcdBarrier& b) {
    asm volatile("s_waitcnt vmcnt(0)" ::: "memory");
    __syncthreads();
    if (threadIdx.x == 0) {
        unsigned* bar = b.bar;
        __builtin_amdgcn_s_waitcnt(0);
        unsigned nloc = b.st[0], nx = b.st[1];
        if (nloc == 0u) { xcd_barrier_complete(bar, b.x, nloc, nx); b.st[0] = nloc; b.st[1] = nx; }
        const unsigned old = xb_add(&bar[XB_XSUB(b.x)], 1u);
        const unsigned gen = old / nloc;
        if (old + 1u == (gen + 1u) * nloc) {
            __builtin_amdgcn_fence(__ATOMIC_RELEASE, "agent");
            asm volatile("s_waitcnt vmcnt(0)" ::: "memory");
            const unsigned og = xb_add(&bar[XB_TOP], 1u);
            const unsigned tg = og / nx;
            if (og + 1u == (tg + 1u) * nx) xb_add(&bar[XB_TOPGEN], 1u);
            else XB_SPIN(xb_ld(&bar[XB_TOPGEN]) == tg, bar);
            __builtin_amdgcn_fence(__ATOMIC_ACQUIRE, "agent");
            xb_add(&bar[XB_XGEN(b.x)], 1u);
            asm volatile("s_waitcnt vmcnt(0)" ::: "memory");
        } else {
            XB_SPIN(xb_ld(&bar[XB_XGEN(b.x)]) == gen, bar);
            __builtin_amdgcn_fence(__ATOMIC_ACQUIRE, "agent");
            asm volatile("s_waitcnt vmcnt(0)" ::: "memory");
        }
    }
    __syncthreads();
}

__device__ __forceinline__ float wave_sum(float v) {
#pragma unroll
    for (int o = 1; o < 64; o <<= 1) v += __shfl_xor(v, o);
    return v;
}
__device__ __forceinline__ float wave_max(float v) {
#pragma unroll
    for (int o = 1; o < 64; o <<= 1) v = __builtin_fmaxf(v, __shfl_xor(v, o));
    return v;
}
__device__ __forceinline__ void p0_transpose_item(const float* W, int K, int N, bf16* WT, const float* gk, LAS float* scr, int item, int lane) {
    const int nblk = N / 32, kb = item / nblk, nb = item % nblk, k0 = 64 * kb, n0 = 32 * nb;
#pragma unroll 8
    for (int i = 0; i < 32; ++i) { const int kk = 2 * i + (lane >> 5); float v = W[(size_t)(k0 + kk) * N + n0 + (lane & 31)]; if (gk) v *= gk[k0 + kk]; scr[kk * 33 + (lane & 31)] = v; }
    LDS_WAIT(); asm volatile("" ::: "memory");
    const int c = lane & 7;
#pragma unroll
    for (int j = 0; j < 4; ++j) { const int n = (lane >> 3) + 8 * j; const LAS float* s = scr + (8 * c) * 33 + n;
        v4u o; o.x = pk2(s[0 * 33], s[1 * 33]); o.y = pk2(s[2 * 33], s[3 * 33]); o.z = pk2(s[4 * 33], s[5 * 33]); o.w = pk2(s[6 * 33], s[7 * 33]);
        *(GAS v4u*)(WT + (size_t)(n0 + n) * K + k0 + 8 * c) = o; }
    LDS_WAIT(); asm volatile("" ::: "memory");
}
__device__ __forceinline__ void rms_row_to_bf16(const float* xrow, const float* gain, bf16* orow, int lane) {
    const GAS f32x4* xr = (const GAS f32x4*)xrow + lane; const GAS f32x4* gr = (const GAS f32x4*)gain + lane;
    f32x4 v[4]; float s = 0.f;
#pragma unroll
    for (int j = 0; j < 4; ++j) { v[j] = xr[64 * j]; s += (v[j].x * v[j].x + v[j].y * v[j].y) + (v[j].z * v[j].z + v[j].w * v[j].w); }
    const float rstd = __builtin_amdgcn_rsqf(wave_sum(s) * (1.f / D) + RMS_EPS);
    GAS unsigned long long* o8 = (GAS unsigned long long*)orow + lane;
#pragma unroll
    for (int j = 0; j < 4; ++j) { const f32x4 gg = gr[64 * j]; const f32x4 y = v[j] * rstd * gg;
        o8[64 * j] = (unsigned long long)pk2(y.x, y.y) | ((unsigned long long)pk2(y.z, y.w) << 32); }
}

__device__ __forceinline__ void attn_naive(const bf16* PROJ, bf16* MIX, const float* gqa, const float* gka, const float* gqb, const float* gkb, const float* sinks, int gtid, int nthr) {
    float mqa = 0.f, mka = 0.f, mqb = 0.f, mkb = 0.f;
    for (int d = 0; d < HD; ++d) { mqa = __builtin_fmaxf(mqa, __builtin_fabsf(gqa[d])); mka = __builtin_fmaxf(mka, __builtin_fabsf(gka[d])); mqb = __builtin_fmaxf(mqb, __builtin_fabsf(gqb[d])); mkb = __builtin_fmaxf(mkb, __builtin_fabsf(gkb[d])); }
    const float shiftA = pg8::C2 * 64.f * mqa * mka, shiftB = pg8::C2 * 64.f * mqb * mkb;
    for (long item = gtid; item < (long)M * 16; item += nthr) {
        const int hh = (int)(item / M), m = (int)(item % M), t = m & (SEQ - 1), rowbase = m - t;
        const bool isA = hh < 8; const int h = hh & 7;
        const int qcol = isA ? COL_QA + h * 64 : COL_QB + h * 64, kcol = isA ? COL_KA + (h >> 2) * 64 : COL_KB + h * 64, vcol = isA ? COL_VA + (h >> 2) * 64 : COL_VB + h * 64;
        const float shift = isA ? shiftA : shiftB;
        float q[64], o[64]; float l = 0.f;
        { const v4u* qp = (const v4u*)(PROJ + (size_t)m * NPROJ + qcol);
#pragma unroll
          for (int c = 0; c < 8; ++c) { const v4u u = qp[c]; q[8 * c + 0] = bf_lo(u.x); q[8 * c + 1] = bf_hi(u.x); q[8 * c + 2] = bf_lo(u.y); q[8 * c + 3] = bf_hi(u.y); q[8 * c + 4] = bf_lo(u.z); q[8 * c + 5] = bf_hi(u.z); q[8 * c + 6] = bf_lo(u.w); q[8 * c + 7] = bf_hi(u.w); } }
#pragma unroll
        for (int d = 0; d < 64; ++d) o[d] = 0.f;
#define KEY(srow, wgt) do { const v4u* kp = (const v4u*)(PROJ + (size_t)(rowbase + (srow)) * NPROJ + kcol); float sc = 0.f; \
        _Pragma("unroll") for (int c = 0; c < 8; ++c) { const v4u u = kp[c]; sc += q[8 * c + 0] * bf_lo(u.x) + q[8 * c + 1] * bf_hi(u.x) + q[8 * c + 2] * bf_lo(u.y) + q[8 * c + 3] * bf_hi(u.y) + q[8 * c + 4] * bf_lo(u.z) + q[8 * c + 5] * bf_hi(u.z) + q[8 * c + 6] * bf_lo(u.w) + q[8 * c + 7] * bf_hi(u.w); } \
        const float p = (wgt) * __builtin_amdgcn_exp2f(sc - shift); l += p; const v4u* vp = (const v4u*)(PROJ + (size_t)(rowbase + (srow)) * NPROJ + vcol); \
        _Pragma("unroll") for (int c = 0; c < 8; ++c) { const v4u u = vp[c]; o[8 * c + 0] += p * bf_lo(u.x); o[8 * c + 1] += p * bf_hi(u.x); o[8 * c + 2] += p * bf_lo(u.y); o[8 * c + 3] += p * bf_hi(u.y); o[8 * c + 4] += p * bf_lo(u.z); o[8 * c + 5] += p * bf_hi(u.z); o[8 * c + 6] += p * bf_lo(u.w); o[8 * c + 7] += p * bf_hi(u.w); } } while (0)
        if (isA) {
            for (int dist = 0; dist <= 127 && dist <= t; ++dist) KEY(t - dist, 1.0f);
            l += __builtin_amdgcn_exp2f(sinks[h] * 1.4426950408889634f - shift);
        } else {
            for (int dist = 0; dist <= 128 && dist <= t; ++dist) { const float w = 1.0f + (((dist & 3) == 0) ? 1.0f : 0.0f) + (((dist & 15) == 0) ? 1.0f : 0.0f); KEY(t - dist, w); }
            for (int dist = 132; dist <= 512 && dist <= t; dist += 4) { const float w = 1.0f + (((dist & 15) == 0) ? 1.0f : 0.0f); KEY(t - dist, w); }
            for (int dist = 528; dist <= t; dist += 16) KEY(t - dist, 1.0f);
        }
#undef KEY
        const float rl = 1.0f / l;
        v4u* op = (v4u*)(MIX + (size_t)m * D + hh * 64);
#pragma unroll
        for (int c = 0; c < 8; ++c) { v4u u; u.x = pk2(o[8 * c + 0] * rl, o[8 * c + 1] * rl); u.y = pk2(o[8 * c + 2] * rl, o[8 * c + 3] * rl); u.z = pk2(o[8 * c + 4] * rl, o[8 * c + 5] * rl); u.w = pk2(o[8 * c + 6] * rl, o[8 * c + 7] * rl); op[c] = u; }
    }
}


typedef short a_bf16x8 __attribute__((ext_vector_type(8)));
typedef short a_s16x4 __attribute__((ext_vector_type(4)));
typedef float a_f32x16 __attribute__((ext_vector_type(16)));
typedef float a_f32x2 __attribute__((ext_vector_type(2)));
typedef __bf16 a_bf16x2 __attribute__((ext_vector_type(2)));
__device__ __forceinline__ unsigned a_cvtpk(float lo, float hi) { a_f32x2 v = {lo, hi}; a_bf16x2 b = __builtin_convertvector(v, a_bf16x2); return __builtin_bit_cast(unsigned, b); }
__device__ __forceinline__ a_s16x4 a_vtr(LAS const unsigned char* p) { return __builtin_bit_cast(a_s16x4, __builtin_amdgcn_ds_read_tr16_b64_v4i16((LAS a_s16x4*)p)); }
constexpr int ATT_WLDS = 16384;
constexpr int ATT_STG = 8192, ATT_STG_PITCH = 144;

struct AttnTask { int qrow0, qrs, qcol, kcol, vcol, n1, row1, D01, kt2lo, kt2hi, row2, D02, qstep2, maxd2, orow0, ors, ocol; float shift, sinkterm; };

__device__ __forceinline__ void attn_task(const bf16* __restrict__ PROJ, bf16* __restrict__ MIX, LAS unsigned char* wl, const int lane, const AttnTask& T) {
    const int i = lane & 31, hh = lane >> 5;
    a_bf16x8 qf[4];
    { const bf16* qp = PROJ + (size_t)(T.qrow0 + i * T.qrs) * NPROJ + T.qcol + 8 * hh;
#pragma unroll
      for (int s = 0; s < 4; ++s) qf[s] = *(const a_bf16x8*)(qp + 16 * s); }
    a_f32x16 o0 = {}, o1 = {}; float lsum = 0.f;
    const int Dl1 = T.D01 + i - 4 * hh, Dl2 = T.D02 + T.qstep2 * i - 4 * hh;
    float wg[4];
#pragma unroll
    for (int c = 0; c < 4; ++c) wg[c] = ((Dl1 & 3) == c) ? 1.0f : 0.0f;
    const int nt = T.n1 + (T.kt2hi - T.kt2lo);
    const int klane = i * NPROJ + 8 * hh, vlane = (lane >> 3) * NPROJ + (lane & 7) * 8;
    LAS unsigned char* vw = wl + ((lane & 7) >> 2) * 2048 + (lane >> 3) * 64 + (lane & 3) * 16;
    LAS const unsigned char* tra = wl + (4 * hh + ((lane & 15) >> 2)) * 64 + ((lane >> 4) & 1) * 32 + (lane & 3) * 8;
    a_f32x16 negs;
#pragma unroll
    for (int r = 0; r < 16; ++r) negs[r] = -T.shift;
    v4u kn[4]; v4u vn[4];
#define ATT_LOAD(j) do { const int seg1_ = (j) < T.n1; const int kt_ = seg1_ ? (j) : T.kt2lo + ((j) - T.n1); const int row_ = seg1_ ? T.row1 + 128 * kt_ : T.row2 + 32 * kt_; const int rs_ = seg1_ ? 4 : 1; \
        const bf16* kb_ = PROJ + (size_t)row_ * NPROJ + T.kcol + (size_t)(vlane - (lane & 7) * 8) * rs_ + (lane & 7) * 8; const bf16* vb_ = PROJ + (size_t)row_ * NPROJ + T.vcol + (size_t)(vlane - (lane & 7) * 8) * rs_ + (lane & 7) * 8; \
        _Pragma("unroll") for (int jj = 0; jj < 4; ++jj) kn[jj] = *(const v4u*)(kb_ + (size_t)(8 * jj * rs_) * NPROJ); \
        _Pragma("unroll") for (int jj = 0; jj < 4; ++jj) vn[jj] = *(const v4u*)(vb_ + (size_t)(8 * jj * rs_) * NPROJ); } while (0)
    ATT_LOAD(0);
    for (int j = 0; j < nt; ++j) {
        v4u kr[4]; v4u vr[4];
#pragma unroll
        for (int s = 0; s < 4; ++s) { kr[s] = kn[s]; vr[s] = vn[s]; }
        if (j + 1 < nt) ATT_LOAD(j + 1);
        const bool seg1 = j < T.n1; const int kt = seg1 ? j : T.kt2lo + (j - T.n1);
        const int Dt = (seg1 ? Dl1 : Dl2) - 32 * kt;
        const int D0 = (seg1 ? T.D01 : T.D02) - 32 * kt, qst = seg1 ? 1 : T.qstep2, maxd = seg1 ? 128 : T.maxd2;
        const int dpmin = D0 - 31, dpmax = D0 + 31 * qst;
        const int cls = (dpmin >= 0 && dpmax <= maxd) ? 1 : (dpmin > maxd ? 2 : 0);
#pragma unroll
        for (int jj = 0; jj < 4; ++jj) *(LAS v4u*)(vw + 512 * jj) = vr[jj];
#pragma unroll
        for (int jj = 0; jj < 4; ++jj) *(LAS v4u*)(wl + 4096 + (lane & 7) * 512 + (((8 * jj + (lane >> 3)) ^ (lane & 7)) * 16)) = kr[jj];
        a_bf16x8 kf[4];
#pragma unroll
        for (int s = 0; s < 4; ++s) kf[s] = *(LAS const a_bf16x8*)(wl + 4096 + (2 * s + hh) * 512 + ((i ^ (2 * s + hh)) * 16));
        a_f32x16 S = negs;
#pragma unroll
        for (int s = 0; s < 4; ++s) S = __builtin_amdgcn_mfma_f32_32x32x16_bf16(kf[s], qf[s], S, 0, 0, 0);
        float p[16];
        float wm[4];
#pragma unroll
        for (int c = 0; c < 4; ++c) wm[c] = seg1 ? wg[c] : 0.0f;
        if (cls == 1) {
#pragma unroll
            for (int r = 0; r < 16; ++r) p[r] = (1.0f + wm[r & 3]) * __builtin_amdgcn_exp2f(S[r]);
        } else if (cls == 2) {
#pragma unroll
            for (int r = 0; r < 16; ++r) p[r] = wm[r & 3] * __builtin_amdgcn_exp2f(S[r]);
        } else {
#pragma unroll
            for (int r = 0; r < 16; ++r) { const int dp = Dt - ((r & 3) + 8 * (r >> 2));
                const float w = (((unsigned)dp <= (unsigned)maxd) ? 1.0f : 0.0f) + ((dp >= 0) ? wm[r & 3] : 0.0f);
                p[r] = w * __builtin_amdgcn_exp2f(S[r]); }
        }
        float ls = 0.f;
#pragma unroll
        for (int r = 0; r < 16; ++r) ls += p[r];
        lsum += ls;
        a_bf16x8 pb0, pb1;
        { v4u w0, w1; w0.x = a_cvtpk(p[0], p[1]); w0.y = a_cvtpk(p[2], p[3]); w0.z = a_cvtpk(p[4], p[5]); w0.w = a_cvtpk(p[6], p[7]);
          w1.x = a_cvtpk(p[8], p[9]); w1.y = a_cvtpk(p[10], p[11]); w1.z = a_cvtpk(p[12], p[13]); w1.w = a_cvtpk(p[14], p[15]);
          pb0 = __builtin_bit_cast(a_bf16x8, w0); pb1 = __builtin_bit_cast(a_bf16x8, w1); }
        {
            a_s16x4 lo, hi;
#define ATT_VF (a_bf16x8){lo[0], lo[1], lo[2], lo[3], hi[0], hi[1], hi[2], hi[3]}
            lo = a_vtr(tra);               hi = a_vtr(tra + 512);               o0 = __builtin_amdgcn_mfma_f32_32x32x16_bf16(ATT_VF, pb0, o0, 0, 0, 0);
            lo = a_vtr(tra + 1024);        hi = a_vtr(tra + 1024 + 512);        o0 = __builtin_amdgcn_mfma_f32_32x32x16_bf16(ATT_VF, pb1, o0, 0, 0, 0);
            lo = a_vtr(tra + 2048);        hi = a_vtr(tra + 2048 + 512);        o1 = __builtin_amdgcn_mfma_f32_32x32x16_bf16(ATT_VF, pb0, o1, 0, 0, 0);
            lo = a_vtr(tra + 2048 + 1024); hi = a_vtr(tra + 2048 + 1024 + 512); o1 = __builtin_amdgcn_mfma_f32_32x32x16_bf16(ATT_VF, pb1, o1, 0, 0, 0);
#undef ATT_VF
        }
    }
#undef ATT_LOAD
    const float ltot = lsum + __shfl_xor(lsum, 32) + T.sinkterm;
    const float rl = 1.0f / ltot;
    LAS unsigned char* stg = wl + ATT_STG;
#pragma unroll
    for (int g = 0; g < 4; ++g) {
        typedef unsigned u32x2_t __attribute__((ext_vector_type(2)));
        u32x2_t a, b2;
        a.x = a_cvtpk(o0[4 * g] * rl, o0[4 * g + 1] * rl); a.y = a_cvtpk(o0[4 * g + 2] * rl, o0[4 * g + 3] * rl);
        b2.x = a_cvtpk(o1[4 * g] * rl, o1[4 * g + 1] * rl); b2.y = a_cvtpk(o1[4 * g + 2] * rl, o1[4 * g + 3] * rl);
        *(LAS u32x2_t*)(stg + i * ATT_STG_PITCH + (8 * g + 4 * hh) * 2) = a;
        *(LAS u32x2_t*)(stg + i * ATT_STG_PITCH + (32 + 8 * g + 4 * hh) * 2) = b2;
    }
#pragma unroll
    for (int jj = 0; jj < 4; ++jj) { const int row = jj * 8 + (lane >> 3), ch = lane & 7;
        const v4u v = *(LAS const v4u*)(stg + row * ATT_STG_PITCH + ch * 16);
        *(v4u*)(MIX + (size_t)(T.orow0 + row * T.ors) * D + T.ocol + ch * 8) = v; }
}

__device__ __forceinline__ void attn_phase(const bf16* PROJ, bf16* MIX, const float* gqa, const float* gka, const float* gqb, const float* gkb, const float* sinks, LAS unsigned char* lds, int vcu, int G, int wave, int lane) {
    const float mqa = wave_max(__builtin_fabsf(gqa[lane])), mka = wave_max(__builtin_fabsf(gka[lane])), mqb = wave_max(__builtin_fabsf(gqb[lane])), mkb = wave_max(__builtin_fabsf(gkb[lane]));
    const float shiftA = pg8::C2 * 64.f * mqa * mka, shiftB = pg8::C2 * 64.f * mqb * mkb;
    LAS unsigned char* wl = lds + wave * ATT_WLDS;
    for (int v = vcu; v < BATCH * 8; v += G) {
        const int b = v >> 3, h = v & 7, rowb = b * SEQ;
        for (int k = 0; k < 16; ++k) {
            AttnTask T;
            if (k < 8) {
                const int r = wave & 3, half = wave >> 2, pr = 2 * (k >> 1) + half, c = (k & 1) ? 15 - pr : pr;
                T.qrow0 = rowb + 128 * c + r; T.qrs = 4; T.qcol = COL_QB + h * 64; T.kcol = COL_KB + h * 64; T.vcol = COL_VB + h * 64;
                T.n1 = c + 1; T.row1 = rowb + r; T.D01 = 32 * c;
                T.kt2lo = (c == 0) ? 4 : 0; T.kt2hi = 8; T.row2 = rowb + 128 * c - 128; T.D02 = 128 + r; T.qstep2 = 4; T.maxd2 = 128;
                T.orow0 = T.qrow0; T.ors = 4; T.ocol = 512 + h * 64; T.shift = shiftB; T.sinkterm = 0.f;
            } else {
                const int c = wave + 8 * (k - 8);
                T.qrow0 = rowb + 32 * c; T.qrs = 1; T.qcol = COL_QA + h * 64; T.kcol = COL_KA + (h >> 2) * 64; T.vcol = COL_VA + (h >> 2) * 64;
                T.n1 = 0; T.row1 = rowb; T.D01 = 0;
                T.kt2lo = (c < 4) ? 4 - c : 0; T.kt2hi = 5; T.row2 = rowb + 32 * c - 128; T.D02 = 128; T.qstep2 = 1; T.maxd2 = 127;
                T.orow0 = T.qrow0; T.ors = 1; T.ocol = h * 64; T.shift = shiftA; T.sinkterm = __builtin_amdgcn_exp2f(sinks[h] * 1.4426950408889634f - shiftA);
            }
            attn_task(PROJ, MIX, wl, lane, T);
        }
    }
}


constexpr int A2_SLOT = 32768, A2_STG = 98304, A2_STG_W = 4608, A2_NROUNDS = 72 + 23;
struct RIter { int ph, p, k; };
__device__ __forceinline__ void ri_next(RIter& it) { it.k++; const int n = (it.ph == 0) ? 2 * it.p + 2 : ((it.p == 0) ? 2 : 3); if (it.k == n) { it.k = 0; it.p++; if (it.p == 8) { it.p = 0; it.ph++; } } }
__device__ __forceinline__ int ri_blk(const RIter& it) { return (it.ph == 0) ? it.k : ((it.p == 0) ? it.k : 2 * it.p - 1 + it.k); }

__device__ __forceinline__ void attn_phase2(const bf16* __restrict__ PROJ, bf16* __restrict__ MIX, const float* gqa, const float* gka, const float* gqb, const float* gkb, const float* sinks,
                                            LAS unsigned char* lds, int vcu, int G, int wave, int lane) {
    const float mqa = wave_max(__builtin_fabsf(gqa[lane])), mka = wave_max(__builtin_fabsf(gka[lane])), mqb = wave_max(__builtin_fabsf(gqb[lane])), mkb = wave_max(__builtin_fabsf(gkb[lane]));
    const float shiftA = pg8::C2 * 64.f * mqa * mka, shiftB = pg8::C2 * 64.f * mqb * mkb;
    const int i = lane & 31, hh = lane >> 5, r = wave & 3, grp = wave >> 2;
    unsigned offK[2], offV[2];
#pragma unroll
    for (int j = 0; j < 2; ++j) { const int n = 2 * wave + j, slot = 8 * n + (lane >> 3), cp = lane & 7;
        const int rk = slot ^ ((slot >> 4) & 3), ch = cp ^ ((slot >> 1) & 7); offK[j] = (unsigned)(rk * NPROJ + ch * 8);
        const int rv = slot ^ ((slot >> 2) & 3), dh = (cp >> 2) ^ ((slot >> 1) & 1); offV[j] = (unsigned)(rv * NPROJ + dh * 32 + (cp & 3) * 8); }
    int k1off[4], v1off[8], v2off[8];
    { const int rho = 4 * i + r, slot = rho ^ ((rho >> 4) & 3), sw = (slot >> 1) & 7;
#pragma unroll
      for (int s = 0; s < 4; ++s) k1off[s] = slot * 128 + (((2 * s + hh) ^ sw) * 16); }
    { const int q4 = (lane & 15) >> 2, g = (lane >> 4) & 1, pp = lane & 3;
#pragma unroll
      for (int x = 0; x < 8; ++x) { const int dh = x >> 2, sp = (x >> 1) & 1, e = x & 1, kk = 16 * sp + 8 * e + 4 * hh + q4;
          { const int rho = 4 * kk + r, slot = rho ^ ((rho >> 2) & 3); v1off[x] = 16384 + slot * 128 + ((dh ^ ((slot >> 1) & 1)) * 64) + g * 32 + pp * 8; }
          { const int rho = kk, slot = rho ^ ((rho >> 2) & 3); v2off[x] = 16384 + slot * 128 + ((dh ^ ((slot >> 1) & 1)) * 64) + g * 32 + pp * 8; } } }
    const int xe = i ^ (i >> 4), xo = i ^ (2 | (i >> 4));
    float wg[4];
#pragma unroll
    for (int c = 0; c < 4; ++c) wg[c] = ((i & 3) == c) ? 1.0f : 0.0f;
    LAS unsigned char* stg = lds + A2_STG + wave * A2_STG_W;
#define A2_WAIT_V(n) asm volatile("s_waitcnt vmcnt(" #n ")" ::: "memory")
    for (int v = vcu; v < BATCH * 8; v += G) {
        const int b = v >> 3, h = v & 7, rowb = b * SEQ;
        const float sinkterm = __builtin_amdgcn_exp2f(sinks[h] * 1.4426950408889634f - shiftA);
#define A2_ISSUE(it, sl) do { const int blk_ = ri_blk(it); const bf16* kb_ = PROJ + (size_t)(rowb + 128 * blk_) * NPROJ + ((it).ph == 0 ? COL_KB + h * 64 : COL_KA + (h >> 2) * 64); \
        const bf16* vb_ = PROJ + (size_t)(rowb + 128 * blk_) * NPROJ + ((it).ph == 0 ? COL_VB + h * 64 : COL_VA + (h >> 2) * 64); \
        _Pragma("unroll") for (int j_ = 0; j_ < 2; ++j_) { \
            __builtin_amdgcn_global_load_lds((const unsigned*)(kb_ + offK[j_]), (LAS unsigned*)(lds + (sl) * A2_SLOT + (2 * wave + j_) * 1024), 16, 0, 0); \
            __builtin_amdgcn_global_load_lds((const unsigned*)(vb_ + offV[j_]), (LAS unsigned*)(lds + (sl) * A2_SLOT + 16384 + (2 * wave + j_) * 1024), 16, 0, 0); } } while (0)
        RIter cons = {0, 0, 0}, iss = {0, 0, 0};
        A2_ISSUE(iss, 0); ri_next(iss); A2_ISSUE(iss, 1); ri_next(iss);
        int slot = 0, islot = 2;
        a_bf16x8 qf[4]; a_f32x16 o0 = {}, o1 = {}; float lsum = 0.f;
#pragma unroll
        for (int s = 0; s < 4; ++s) qf[s] = (a_bf16x8){0, 0, 0, 0, 0, 0, 0, 0};
        for (int round = 0; round < A2_NROUNDS; ++round) {
            if (round + 1 < A2_NROUNDS) A2_WAIT_V(4); else A2_WAIT_V(0);
            __builtin_amdgcn_s_barrier(); asm volatile("" ::: "memory");
            if (iss.ph < 2) { A2_ISSUE(iss, islot); ri_next(iss); }
            islot = (islot == 2) ? 0 : islot + 1;
            const bool isB = cons.ph == 0;
            const int cw = isB ? 2 * cons.p + grp : 8 * cons.p + wave;
            const int blk = ri_blk(cons);
            const int nr = isB ? 2 * cons.p + 2 : ((cons.p == 0) ? 2 : 3);
            const bool first = cons.k == 0, last = isB ? (blk == cw) : (cons.k == nr - 1);
            const int qrow0 = isB ? rowb + 128 * cw + r : rowb + 32 * cw, qrs = isB ? 4 : 1;
            if (first) {
                const bf16* qp = PROJ + (size_t)(qrow0 + i * qrs) * NPROJ + (isB ? COL_QB : COL_QA) + h * 64 + 8 * hh;
#pragma unroll
                for (int s = 0; s < 4; ++s) qf[s] = *(const a_bf16x8*)(qp + 16 * s);
                o0 = (a_f32x16){}; o1 = (a_f32x16){}; lsum = 0.f;
            }
            const float shift = isB ? shiftB : shiftA;
            int tlo, thi;
            if (isB) { tlo = (blk <= cw) ? 0 : 5; thi = (blk <= cw) ? ((blk >= cw - 1) ? 5 : 1) : 5; }
            else { const int t0 = 4 * blk; tlo = 1 + ((cw - 4 - t0) > 0 ? (cw - 4 - t0) : 0); thi = 1 + ((cw - t0 + 1) < 4 ? (cw - t0 + 1) : 4); if (thi < tlo) thi = tlo; }
            LAS unsigned char* sb = lds + slot * A2_SLOT;
            for (int tt = tlo; tt < thi; ++tt) {
                const bool seg1 = (tt == 0); const int t2 = tt - 1;
                int D0, qst, maxd;
                if (isB) { if (seg1) { D0 = 32 * (cw - blk); qst = 1; maxd = 128; } else { D0 = 128 + r - 32 * (((blk == cw) ? 4 : 0) + t2); qst = 4; maxd = 128; } }
                else { D0 = 32 * (cw - (4 * blk + t2)); qst = 1; maxd = 127; }
                const int Dt = D0 + qst * i - 4 * hh;
                const int dpmin = D0 - 31, dpmax = D0 + 31 * qst;
                const int cls = (dpmin >= 0 && dpmax <= maxd) ? 1 : (dpmin > maxd ? 2 : 0);
                int ka[4], va[8];
                { const int x = (t2 & 1) ? xo : xe, sw = (x >> 1) & 7, base = t2 * 4096 + x * 128;
#pragma unroll
                  for (int s = 0; s < 4; ++s) ka[s] = seg1 ? k1off[s] : base + (((2 * s + hh) ^ sw) * 16);
#pragma unroll
                  for (int x8 = 0; x8 < 8; ++x8) va[x8] = seg1 ? v1off[x8] : v2off[x8] + t2 * 4096; }
                a_f32x16 S;
#pragma unroll
                for (int q = 0; q < 16; ++q) S[q] = -shift;
#pragma unroll
                for (int s = 0; s < 4; ++s) { const a_bf16x8 kf = *(LAS const a_bf16x8*)(sb + ka[s]); S = __builtin_amdgcn_mfma_f32_32x32x16_bf16(kf, qf[s], S, 0, 0, 0); }
                float p[16], wm[4];
#pragma unroll
                for (int c = 0; c < 4; ++c) wm[c] = seg1 ? wg[c] : 0.0f;
                if (cls == 1) {
#pragma unroll
                    for (int q = 0; q < 16; ++q) p[q] = (1.0f + wm[q & 3]) * __builtin_amdgcn_exp2f(S[q]);
                } else if (cls == 2) {
#pragma unroll
                    for (int q = 0; q < 16; ++q) p[q] = wm[q & 3] * __builtin_amdgcn_exp2f(S[q]);
                } else {
#pragma unroll
                    for (int q = 0; q < 16; ++q) { const int dp = Dt - ((q & 3) + 8 * (q >> 2));
                        const float w = (((unsigned)dp <= (unsigned)maxd) ? 1.0f : 0.0f) + ((dp >= 0) ? wm[q & 3] : 0.0f);
                        p[q] = w * __builtin_amdgcn_exp2f(S[q]); }
                }
                float ls = 0.f;
#pragma unroll
                for (int q = 0; q < 16; ++q) ls += p[q];
                lsum += ls;
                a_bf16x8 pb0, pb1;
                { v4u w0, w1; w0.x = a_cvtpk(p[0], p[1]); w0.y = a_cvtpk(p[2], p[3]); w0.z = a_cvtpk(p[4], p[5]); w0.w = a_cvtpk(p[6], p[7]);
                  w1.x = a_cvtpk(p[8], p[9]); w1.y = a_cvtpk(p[10], p[11]); w1.z = a_cvtpk(p[12], p[13]); w1.w = a_cvtpk(p[14], p[15]);
                  pb0 = __builtin_bit_cast(a_bf16x8, w0); pb1 = __builtin_bit_cast(a_bf16x8, w1); }
                { a_s16x4 lo, hi;
#define A2_VF (a_bf16x8){lo[0], lo[1], lo[2], lo[3], hi[0], hi[1], hi[2], hi[3]}
                  lo = a_vtr(sb + va[0]); hi = a_vtr(sb + va[1]); o0 = __builtin_amdgcn_mfma_f32_32x32x16_bf16(A2_VF, pb0, o0, 0, 0, 0);
                  lo = a_vtr(sb + va[2]); hi = a_vtr(sb + va[3]); o0 = __builtin_amdgcn_mfma_f32_32x32x16_bf16(A2_VF, pb1, o0, 0, 0, 0);
                  lo = a_vtr(sb + va[4]); hi = a_vtr(sb + va[5]); o1 = __builtin_amdgcn_mfma_f32_32x32x16_bf16(A2_VF, pb0, o1, 0, 0, 0);
                  lo = a_vtr(sb + va[6]); hi = a_vtr(sb + va[7]); o1 = __builtin_amdgcn_mfma_f32_32x32x16_bf16(A2_VF, pb1, o1, 0, 0, 0);
#undef A2_VF
                }
            }
            if (last) {
                const float ltot = lsum + __shfl_xor(lsum, 32) + (isB ? 0.f : sinkterm);
                const float rl = 1.0f / ltot;
#pragma unroll
                for (int g = 0; g < 4; ++g) {
                    typedef unsigned u32x2_t __attribute__((ext_vector_type(2)));
                    u32x2_t a, b2;
                    a.x = a_cvtpk(o0[4 * g] * rl, o0[4 * g + 1] * rl); a.y = a_cvtpk(o0[4 * g + 2] * rl, o0[4 * g + 3] * rl);
                    b2.x = a_cvtpk(o1[4 * g] * rl, o1[4 * g + 1] * rl); b2.y = a_cvtpk(o1[4 * g + 2] * rl, o1[4 * g + 3] * rl);
                    *(LAS u32x2_t*)(stg + i * ATT_STG_PITCH + (8 * g + 4 * hh) * 2) = a;
                    *(LAS u32x2_t*)(stg + i * ATT_STG_PITCH + (32 + 8 * g + 4 * hh) * 2) = b2;
                }
                const int ocol = isB ? 512 + h * 64 : h * 64;
#pragma unroll
                for (int jj = 0; jj < 4; ++jj) { const int row = jj * 8 + (lane >> 3), ch = lane & 7;
                    const v4u vv = *(LAS const v4u*)(stg + row * ATT_STG_PITCH + ch * 16);
                    *(v4u*)(MIX + (size_t)(qrow0 + row * qrs) * D + ocol + ch * 8) = vv; }
            }
            slot = (slot == 2) ? 0 : slot + 1; ri_next(cons);
        }
        A2_WAIT_V(0); __builtin_amdgcn_s_barrier(); asm volatile("" ::: "memory");
#undef A2_ISSUE
    }
#undef A2_WAIT_V
}

struct Args { const float* in[13]; float* out; unsigned char* ws; int ph_lo, ph_hi, li, pad; };
__global__ void __launch_bounds__(NWAVES * 64, 2) hymba_fwd(Args args) {
    extern __shared__ __attribute__((aligned(16))) unsigned char lds[];
    LAS unsigned char* L = (LAS unsigned char*)lds;
    volatile LAS unsigned* MISC = (volatile LAS unsigned*)(L + MISC_OFF);
    const int tid = threadIdx.x, lane = tid & 63, wave = __builtin_amdgcn_readfirstlane(tid >> 6);
    const int G = gridDim.x; const int bx = blockIdx.x; const int vcu = (G % 8 == 0) ? (bx % 8) * (G / 8) + bx / 8 : bx;
    unsigned char* ws = args.ws;
    gu32* ctl = (gu32*)(ws + WS_CTL);
    const float* x = args.in[0]; const int* positions = (const int*)args.in[1]; const float* g_attn = args.in[2]; const float* w_in = args.in[3];
    const float* gqa = args.in[4]; const float* gka = args.in[5]; const float* sinks = args.in[6]; const float* gqb = args.in[7]; const float* gkb = args.in[8];
    const float* w_out = args.in[9]; const float* g_mlp = args.in[10]; const float* w_up = args.in[11]; const float* w_dn = args.in[12];
    float* out = args.out;
    bf16* Win_t = (bf16*)(ws + WS_WIN); bf16* Wout_t = (bf16*)(ws + WS_WOUT); bf16* Wup_t = (bf16*)(ws + WS_WUP); bf16* Wdn_t = (bf16*)(ws + WS_WDN);
    float* rope = (float*)(ws + WS_ROPE); float* ssp = (float*)(ws + WS_SS);
    bf16* XN = (bf16*)(ws + WS_XN); bf16* PROJ = (bf16*)(ws + WS_PROJ); bf16* MIXB = (bf16*)(ws + WS_MIX); bf16* HID = (bf16*)(ws + WS_HID);
    for (int u = tid; u < (LDS_BYTES - LDSCTL_OFF) / 4; u += NWAVES * 64) ((LAS unsigned*)(L + LDSCTL_OFF))[u] = 0u;
    __syncthreads();
    const int bli = (N_LAUNCHES == PER_PHASE) ? 0 : args.li;
    XcdBarrier bar; bar.bar = (unsigned*)(ctl + CW_BAR) + bli * XCD_BAR_WORDS; bar.x = 0; bar.st = nullptr;
    if (N_LAUNCHES != PER_PHASE) bar = xcd_barrier_post((unsigned*)(ctl + CW_BAR) + bli * XCD_BAR_WORDS, MISC + 8);
#define GRID_BAR(seam) do { if (N_LAUNCHES == PER_PHASE) { if (tid == 0) __hip_atomic_store(ctl + CW_TMO, 0xBADBA0u | (unsigned)(seam), RLX_AGENT); } else { xcd_barrier(bar); } } while (0)
    const int lo = args.ph_lo, hi = args.ph_hi;
#define IN(k) (lo <= (k) && (k) < hi)
#define BOTH(k) (IN(k) && IN((k) + 1))

    if (IN(0)) { REP(0) {
        LAS float* scr = (LAS float*)(L + RING_OFF + wave * 16384);
        const int gw = vcu * NWAVES + wave, NGW = G * NWAVES;
        constexpr int I_IN = (D / 64) * (NPROJ / 32), I_OUT = (D / 64) * (D / 32), I_UP = (D / 64) * (FF / 32), I_DN = (FF / 64) * (D / 32);
        constexpr int NITEMS = I_IN + I_OUT + I_UP + I_DN;
        for (int it = gw; it < NITEMS; it += NGW) {
            int r = it;
            if (r < I_IN) { p0_transpose_item(w_in, D, NPROJ, Win_t, nullptr, scr, r, lane); continue; } r -= I_IN;
            if (r < I_OUT) { p0_transpose_item(w_out, D, D, Wout_t, nullptr, scr, r, lane); continue; } r -= I_OUT;
            if (r < I_UP) { p0_transpose_item(w_up, D, FF, Wup_t, g_mlp, scr, r, lane); continue; } r -= I_UP;
            p0_transpose_item(w_dn, FF, D, Wdn_t, nullptr, scr, r, lane);
        }
        for (int m = gw; m < M; m += NGW) rms_row_to_bf16(x + (size_t)m * D, g_attn, XN + (size_t)m * D, lane);
        for (int it = gw * 64 + lane; it < M * 8; it += NGW * 64) {
            const int m = it >> 3, i = it & 7;
            const float inv_freq = (i == 0) ? 1.0f : (i == 1) ? 0.193922743f : (i == 2) ? 0.0376060307f : (i == 3) ? 0.00729266461f : (i == 4) ? 0.00141421356f : (i == 5) ? 0.000274248188f : (i == 6) ? 5.3182961e-05f : 1.03133862e-05f;
            const float ang = (float)positions[m] * inv_freq;
            double rev = (double)ang * 0.15915494309189535; rev -= __builtin_floor(rev);
            const float rf = (float)rev;
            rope[(size_t)m * 16 + i] = __builtin_amdgcn_cosf(rf); rope[(size_t)m * 16 + 8 + i] = __builtin_amdgcn_sinf(rf);
        }
        }
        if (BOTH(0)) GRID_BAR(0);
    }
    if (IN(1)) {
        pg8::Gemm g{XN, Win_t, M, NPROJ, D}; pg8::StaticOrder S; S.init(M, NPROJ, G, (int)blockIdx.x);
        pg8::EpiQKV E{PROJ, NPROJ, gqa, gka, gqb, gkb, rope};
        REP(1) pg8::gemm_phase<pg8::EpiQKV, pg8::StaticOrder, true>(L + RING_OFF, g, S, E);
        if (BOTH(1)) GRID_BAR(1);
    }
    if (IN(2)) {
#if defined(NAIVE_ATTN)
        attn_naive(PROJ, MIXB, gqa, gka, gqb, gkb, sinks, vcu * (NWAVES * 64) + tid, G * NWAVES * 64);
#else
#if defined(ATTN_V1)
        REP(2) attn_phase(PROJ, MIXB, gqa, gka, gqb, gkb, sinks, L + RING_OFF, vcu, G, wave, lane);
#else
        REP(2) attn_phase2(PROJ, MIXB, gqa, gka, gqb, gkb, sinks, L + RING_OFF, vcu, G, wave, lane);
#endif
#endif
        if (BOTH(2)) GRID_BAR(2);
    }
    if (IN(3)) {
        pg8::Gemm g{MIXB, Wout_t, M, D, D}; pg8::StaticOrder S; S.init(M, D, G, (int)blockIdx.x);
        pg8::EpiOut E{x, out, XN, ssp, D};
        REP(3) pg8::gemm_phase<pg8::EpiOut, pg8::StaticOrder, true>(L + RING_OFF, g, S, E);
        if (BOTH(3)) GRID_BAR(3);
    }
    if (IN(4)) {
        pg8::Gemm g{XN, Wup_t, M, FF, D}; pg8::StaticOrder S; S.init(M, FF, G, (int)blockIdx.x);
        pg8::EpiUp E{ssp, HID, FF, 1.0f / D, RMS_EPS};
        REP(4) pg8::gemm_phase<pg8::EpiUp, pg8::StaticOrder, true>(L + RING_OFF, g, S, E);
        if (BOTH(4)) GRID_BAR(4);
    }
    if (IN(5)) {
        pg8::Gemm g{HID, Wdn_t, M, D, FF}; pg8::StaticOrder S; S.init(M, D, G, (int)blockIdx.x);
        pg8::EpiDown E{out, D};
        pg8::gemm_phase<pg8::EpiDown, pg8::StaticOrder, true>(L + RING_OFF, g, S, E);
    }
#undef IN
#undef BOTH
}

extern "C" void kernel_launch(void* const* d_in, const int* in_sizes, int n_in, void* d_out, int out_size, void* d_ws, size_t ws_size, hipStream_t stream) {
    static int grid = 0;
    if (grid == 0) {
        if (n_in != 13 || in_sizes[0] != M * D || out_size != M * D || ws_size < WS_END) { fprintf(stderr, "kernel_launch: shape/workspace mismatch (n_in %d in0 %d out %d ws %zu); nothing launched\n", n_in, n_in > 0 ? in_sizes[0] : -1, out_size, ws_size); grid = -1; return; }
        int dev = 0, cus = 0, per_cu = 0;
        if (hipGetDevice(&dev) != hipSuccess || hipDeviceGetAttribute(&cus, hipDeviceAttributeMultiprocessorCount, dev) != hipSuccess) { fprintf(stderr, "kernel_launch: device query failed\n"); grid = -1; return; }
        if (hipFuncSetAttribute((const void*)hymba_fwd, hipFuncAttributeMaxDynamicSharedMemorySize, LDS_BYTES) != hipSuccess) { fprintf(stderr, "kernel_launch: hipFuncSetAttribute failed\n"); grid = -1; return; }
        if (hipOccupancyMaxActiveBlocksPerMultiprocessor(&per_cu, (const void*)hymba_fwd, NWAVES * 64, LDS_BYTES) != hipSuccess || per_cu < 1)
            fprintf(stderr, "kernel_launch: note: occupancy query reports %d workgroups per CU\n", per_cu);
        (void)hipGetLastError();
        grid = cus;
    }
    if (grid < 0) return;
    if (hipMemsetAsync((char*)d_ws + WS_CTL, 0, CTL_ZERO_BYTES, stream) != hipSuccess) { fprintf(stderr, "kernel_launch: hipMemsetAsync failed\n"); return; }
    Args a{};
    for (int i = 0; i < 13; ++i) a.in[i] = (const float*)d_in[i];
    a.out = (float*)d_out; a.ws = (unsigned char*)d_ws;
    static_assert(N_LAUNCHES == 1 || N_LAUNCHES == PER_PHASE, "MK_N_LAUNCHES must be 1 or 6");
    for (int li = 0; li < N_LAUNCHES; ++li) {
        a.ph_lo = (N_LAUNCHES == PER_PHASE) ? li : 0; a.ph_hi = (N_LAUNCHES == PER_PHASE) ? li + 1 : PER_PHASE; a.li = li;
        hipLaunchKernelGGL(hymba_fwd, dim3(grid), dim3(NWAVES * 64), LDS_BYTES, stream, a);
        const hipError_t le = hipPeekAtLastError();
        if (le != hipSuccess) { fprintf(stderr, "kernel_launch: launch %d failed: %s\n", li, hipGetErrorName(le)); break; }
    }
}
```

```cpp
#include <hip/hip_runtime.h>
#include <cstdio>
#include <cstdint>

#ifndef MK_N_LAUNCHES
#define MK_N_LAUNCHES 1
#endif
#ifndef REPEAT_MASK
#define REPEAT_MASK 0
#endif
#ifndef PROBE_MODE
#define PROBE_MODE 0
#endif
#define REP(k) for (int rep_ = 0; rep_ < 1 + ((REPEAT_MASK >> (k)) & 1); ++rep_)

namespace pg8 {
#define PG8_LAS __attribute__((address_space(3)))
typedef unsigned short bf16_t;
typedef short bf16x8 __attribute__((ext_vector_type(8)));
typedef float f32x4 __attribute__((ext_vector_type(4)));
typedef unsigned u32x4 __attribute__((ext_vector_type(4)));
constexpr int BM = 256, BK = 64, HALF = 128, HTB = HALF * BK * 2  , STAGE_BYTES = 8 * HTB, NXCD = 8, WGM = 8;

__host__ __device__ __forceinline__ int lds_byte(int r, int c) { const int st = (r >> 4) * 2 + (c >> 5), rr = r & 15, cc = c & 31, ob = rr * 64 + cc * 2; return st * 1024 + (ob ^ (((ob >> 9) & 1) << 5)); }
__host__ __device__ __forceinline__ void stage_rc(int b, int& R, int& C) { const int st = b / 1024, sb = b % 1024, swz = sb ^ (((sb >> 9) & 1) << 5); R = (st >> 1) * 16 + swz / 64; C = (st & 1) * 32 + (swz % 64) / 2; }
__host__ __device__ __forceinline__ int perm32(int rho) { const int n = rho >> 4, i = rho & 15; return 8 * (i >> 2) + 4 * n + (i & 3); }

struct Unit { int pm, pn; };
struct Gemm { const bf16_t* A; const bf16_t* Bt; int M, N, K; };

struct StaticOrder {
    int nM, nN, nwg, G, c;
    __host__ __device__ void init(int M, int N, int G_, int c_) { nM = M / BM; nN = N / BM; nwg = nM * nN; G = G_; c = c_; }
    __host__ __device__ bool next(int i, Unit& u) const {
        const long L = (long)i * G + c; if (L >= nwg) return false;
        int wgid = (int)L; { const int q = nwg / NXCD, r = nwg % NXCD, xcd = wgid % NXCD, off = wgid / NXCD; wgid = (xcd < r ? xcd * (q + 1) : r * (q + 1) + (xcd - r) * q) + off; }
        const int nig = WGM * nN, gid = wgid / nig, fm = gid * WGM, gsz = (nM - fm) < WGM ? (nM - fm) : WGM;
        u.pm = fm + ((wgid % nig) % gsz); u.pn = (wgid % nig) / gsz; return true;
    }
};

__device__ __forceinline__ unsigned cvt_pk_bf16(float lo, float hi) { unsigned r; asm volatile("v_cvt_pk_bf16_f32 %0, %1, %2" : "=v"(r) : "v"(lo), "v"(hi)); return r; }

constexpr float QK_EPS = 1e-6f;
constexpr float C2 = 0.125f * 1.4426950408889634f;

struct EpiQKV {
    bf16_t* O; int ldc; const float* gqa; const float* gka; const float* gqb; const float* gkb; const float* rope;
    __device__ __forceinline__ void operator()(const f32x4 (&acc)[2][2][4][2], const Unit& u, int wr, int wc, int fr, int fq) const {
        const int pn = u.pn; int mode = 0; const float* g = gqa;
        if (pn < 2) { mode = 1; g = gqa; } else if (pn == 2) { if (wc < 2) { mode = 2; g = gka; } } else if (pn < 5) { mode = 1; g = gqb; } else if (pn < 7) { mode = 2; g = gkb; }
        const int row0 = u.pm * BM + wr * 64 + fr, col0 = pn * BM + wc * 64 + 8 * fq;
        if (mode == 0) {
#pragma unroll
            for (int ai = 0; ai < 2; ++ai)
#pragma unroll
                for (int m = 0; m < 4; ++m) { bf16_t* rowp = O + (size_t)(row0 + ai * HALF + m * 16) * ldc + col0;
#pragma unroll
                    for (int bj = 0; bj < 2; ++bj) { const f32x4 v0 = acc[ai][bj][m][0], v1 = acc[ai][bj][m][1]; u32x4 w;
                        w.x = cvt_pk_bf16(v0[0], v0[1]); w.y = cvt_pk_bf16(v0[2], v0[3]); w.z = cvt_pk_bf16(v1[0], v1[1]); w.w = cvt_pk_bf16(v1[2], v1[3]);
                        *(u32x4*)(rowp + bj * 32) = w; } }
            return;
        }
        f32x4 gv[2][2];
#pragma unroll
        for (int bj = 0; bj < 2; ++bj)
#pragma unroll
            for (int n = 0; n < 2; ++n) gv[bj][n] = *(const f32x4*)(g + 32 * bj + 8 * fq + 4 * n);
        const float sc = (mode == 1) ? C2 : 1.0f;
        const float sgn = (fq == 0) ? -1.0f : 1.0f;
#pragma unroll
        for (int ai = 0; ai < 2; ++ai)
#pragma unroll
            for (int m = 0; m < 4; ++m) {
                const int row = row0 + ai * HALF + m * 16;
                float ss = 0.f;
#pragma unroll
                for (int bj = 0; bj < 2; ++bj)
#pragma unroll
                    for (int n = 0; n < 2; ++n) { const f32x4 x = acc[ai][bj][m][n]; ss += (x[0] * x[0] + x[1] * x[1]) + (x[2] * x[2] + x[3] * x[3]); }
                ss += __shfl_xor(ss, 16); ss += __shfl_xor(ss, 32);
                const float rs = __builtin_amdgcn_rsqf(ss * (1.0f / 64.0f) + QK_EPS);
                f32x4 y[2][2];
#pragma unroll
                for (int bj = 0; bj < 2; ++bj)
#pragma unroll
                    for (int n = 0; n < 2; ++n) y[bj][n] = acc[ai][bj][m][n] * rs * gv[bj][n];
                const f32x4 c0 = *(const f32x4*)(rope + (size_t)row * 16), c1 = *(const f32x4*)(rope + (size_t)row * 16 + 4);
                const f32x4 s0 = *(const f32x4*)(rope + (size_t)row * 16 + 8), s1 = *(const f32x4*)(rope + (size_t)row * 16 + 12);
                f32x4 p0, p1;
#pragma unroll
                for (int e = 0; e < 4; ++e) { p0[e] = __shfl_xor(y[0][0][e], 16); p1[e] = __shfl_xor(y[0][1][e], 16); }
                if (fq < 2) { y[0][0] = y[0][0] * c0 + p0 * s0 * sgn; y[0][1] = y[0][1] * c1 + p1 * s1 * sgn; }
                bf16_t* rowp = O + (size_t)row * ldc + col0;
#pragma unroll
                for (int bj = 0; bj < 2; ++bj) { const f32x4 v0 = y[bj][0] * sc, v1 = y[bj][1] * sc; u32x4 w;
                    w.x = cvt_pk_bf16(v0[0], v0[1]); w.y = cvt_pk_bf16(v0[2], v0[3]); w.z = cvt_pk_bf16(v1[0], v1[1]); w.w = cvt_pk_bf16(v1[2], v1[3]);
                    *(u32x4*)(rowp + bj * 32) = w; }
            }
    }
};

struct EpiOut {
    const float* x; float* h; bf16_t* hb; float* ssp; int ldc;
    __device__ __forceinline__ void operator()(const f32x4 (&acc)[2][2][4][2], const Unit& u, int wr, int wc, int fr, int fq) const {
        const int row0 = u.pm * BM + wr * 64 + fr, col0 = u.pn * BM + wc * 64 + 8 * fq;
#pragma unroll
        for (int ai = 0; ai < 2; ++ai)
#pragma unroll
            for (int m = 0; m < 4; ++m) {
                const int row = row0 + ai * HALF + m * 16; const size_t off = (size_t)row * ldc + col0; float ss = 0.f;
#pragma unroll
                for (int bj = 0; bj < 2; ++bj) {
                    const f32x4 x0 = *(const f32x4*)(x + off + bj * 32), x1 = *(const f32x4*)(x + off + bj * 32 + 4);
                    const f32x4 v0 = acc[ai][bj][m][0] + x0, v1 = acc[ai][bj][m][1] + x1;
                    *(f32x4*)(h + off + bj * 32) = v0; *(f32x4*)(h + off + bj * 32 + 4) = v1;
                    u32x4 w; w.x = cvt_pk_bf16(v0[0], v0[1]); w.y = cvt_pk_bf16(v0[2], v0[3]); w.z = cvt_pk_bf16(v1[0], v1[1]); w.w = cvt_pk_bf16(v1[2], v1[3]);
                    *(u32x4*)(hb + off + bj * 32) = w;
                    ss += (v0[0] * v0[0] + v0[1] * v0[1]) + (v0[2] * v0[2] + v0[3] * v0[3]) + (v1[0] * v1[0] + v1[1] * v1[1]) + (v1[2] * v1[2] + v1[3] * v1[3]);
                }
                ss += __shfl_xor(ss, 16); ss += __shfl_xor(ss, 32);
                if (fq == 0) ssp[(size_t)row * 16 + u.pn * 4 + wc] = ss;
            }
    }
};

struct EpiUp {
    const float* ssp; bf16_t* hid; int ldc; float inv_n, eps;
    __device__ __forceinline__ void operator()(const f32x4 (&acc)[2][2][4][2], const Unit& u, int wr, int wc, int fr, int fq) const {
        const int row0 = u.pm * BM + wr * 64 + fr, col0 = u.pn * BM + wc * 64 + 8 * fq;
#pragma unroll
        for (int ai = 0; ai < 2; ++ai)
#pragma unroll
            for (int m = 0; m < 4; ++m) {
                const int row = row0 + ai * HALF + m * 16;
                const f32x4 a = *(const f32x4*)(ssp + (size_t)row * 16), b = *(const f32x4*)(ssp + (size_t)row * 16 + 4), c = *(const f32x4*)(ssp + (size_t)row * 16 + 8), d = *(const f32x4*)(ssp + (size_t)row * 16 + 12);
                const f32x4 t = (a + b) + (c + d); const float ss = (t[0] + t[1]) + (t[2] + t[3]);
                const float rs = __builtin_amdgcn_rsqf(ss * inv_n + eps);
                bf16_t* rowp = hid + (size_t)row * ldc + col0;
#pragma unroll
                for (int bj = 0; bj < 2; ++bj) { f32x4 v0 = acc[ai][bj][m][0] * rs, v1 = acc[ai][bj][m][1] * rs;
#pragma unroll
                    for (int e = 0; e < 4; ++e) { const float r0 = __builtin_fmaxf(v0[e], 0.f), r1 = __builtin_fmaxf(v1[e], 0.f); v0[e] = r0 * r0; v1[e] = r1 * r1; }
                    u32x4 w; w.x = cvt_pk_bf16(v0[0], v0[1]); w.y = cvt_pk_bf16(v0[2], v0[3]); w.z = cvt_pk_bf16(v1[0], v1[1]); w.w = cvt_pk_bf16(v1[2], v1[3]);
                    *(u32x4*)(rowp + bj * 32) = w; }
            }
    }
};

struct EpiDown {
    float* out; int ldc;
    __device__ __forceinline__ void operator()(const f32x4 (&acc)[2][2][4][2], const Unit& u, int wr, int wc, int fr, int fq) const {
        const int row0 = u.pm * BM + wr * 64 + fr, col0 = u.pn * BM + wc * 64 + 8 * fq;
#pragma unroll
        for (int ai = 0; ai < 2; ++ai)
#pragma unroll
            for (int m = 0; m < 4; ++m) {
                const size_t off = (size_t)(row0 + ai * HALF + m * 16) * ldc + col0;
#pragma unroll
                for (int bj = 0; bj < 2; ++bj) {
                    const f32x4 h0 = *(const f32x4*)(out + off + bj * 32), h1 = *(const f32x4*)(out + off + bj * 32 + 4);
                    *(f32x4*)(out + off + bj * 32) = h0 + acc[ai][bj][m][0]; *(f32x4*)(out + off + bj * 32 + 4) = h1 + acc[ai][bj][m][1];
                }
            }
    }
};

template <class Epi, class Sched, bool ALIGN_EPI>
__device__ __forceinline__ void gemm_phase(PG8_LAS unsigned char* lds, const Gemm g, const Sched& S, const Epi& E) {
    const int tid = threadIdx.x, wid = __builtin_amdgcn_readfirstlane(tid >> 6), lane = tid & 63, wr = wid >> 2, wc = wid & 3, fr = lane & 15, fq = lane >> 4;
    const int K = g.K, nt = K / BK;
    unsigned voffA[2], voffB[2];
#pragma unroll
    for (int i = 0; i < 2; ++i) { int R, C; stage_rc(tid * 16 + i * 8192, R, C); const int Rb = (R >> 5) * 64 + perm32(R & 31);
        voffA[i] = (unsigned)(R * K + C) * 2u; voffB[i] = (unsigned)(Rb * K + C) * 2u; }
    const size_t kstep = (size_t)(BK * 2);
    const size_t hstepA = (size_t)HALF * K * 2;
    const size_t hstepB = (size_t)32 * K * 2;
    const size_t tstep = (size_t)BM * K * 2;
    const unsigned ldsw = (unsigned)wid * 1024u;
    const int aoff = lds_byte(wr * 64 + fr, fq * 8), boff = lds_byte(wc * 32 + fr, fq * 8);
#define PG8_SA(b, h) (((b) * 2 + (h)) * HTB)
#define PG8_SB(b, h) ((4 + (b) * 2 + (h)) * HTB)
#define PG8_STAGE(bufoff, gbase, voff) do { _Pragma("unroll") for (int _i = 0; _i < 2; ++_i) \
        __builtin_amdgcn_global_load_lds((const unsigned*)((const char*)(gbase) + (voff)[_i]), (PG8_LAS unsigned*)(lds + (bufoff) + ldsw + _i * 8192), 16, 0, 0); } while (0)
#define PG8_LDA(dst, b, h) do { _Pragma("unroll") for (int m = 0; m < 4; ++m) _Pragma("unroll") for (int k = 0; k < 2; ++k) dst[m][k] = *(const PG8_LAS bf16x8*)(lds + PG8_SA(b, h) + aoff + m * 2048 + k * 1024); } while (0)
#define PG8_LDB(dst, b, h) do { _Pragma("unroll") for (int n = 0; n < 2; ++n) _Pragma("unroll") for (int k = 0; k < 2; ++k) dst[n][k] = *(const PG8_LAS bf16x8*)(lds + PG8_SB(b, h) + boff + n * 2048 + k * 1024); } while (0)
#define PG8_MMA(ai, bj, At, Bt) do { __builtin_amdgcn_s_setprio(1); _Pragma("unroll") for (int m = 0; m < 4; ++m) _Pragma("unroll") for (int n = 0; n < 2; ++n) _Pragma("unroll") for (int k = 0; k < 2; ++k) \
        acc[ai][bj][m][n] = __builtin_amdgcn_mfma_f32_16x16x32_bf16(Bt[n][k], At[m][k], acc[ai][bj][m][n], 0, 0, 0); __builtin_amdgcn_s_setprio(0); } while (0)
#define PG8_WAIT_V(n) asm volatile("s_waitcnt vmcnt(" #n ")" ::: "memory")
#define PG8_WAIT_L(n) asm volatile("s_waitcnt lgkmcnt(" #n ")" ::: "memory")
#define PG8_BAR __builtin_amdgcn_s_barrier()
#define PG8_SCHED __builtin_amdgcn_sched_barrier(0)
    Unit cur, nxt; int ui = 0;
    if (!S.next(0, cur)) return;
    f32x4 acc[2][2][4][2];
#pragma unroll
    for (int a = 0; a < 2; ++a)
#pragma unroll
        for (int b = 0; b < 2; ++b)
#pragma unroll
            for (int m = 0; m < 4; ++m)
#pragma unroll
                for (int n = 0; n < 2; ++n) acc[a][b][m][n] = (f32x4){0.f, 0.f, 0.f, 0.f};
    bf16x8 At[4][2], B0[2][2], B1[2][2];
    const char* cA = (const char*)g.A + (size_t)cur.pm * tstep; const char* cB = (const char*)g.Bt + (size_t)cur.pn * tstep;
    PG8_STAGE(PG8_SB(0, 0), cB, voffB); PG8_STAGE(PG8_SB(0, 1), cB + hstepB, voffB); PG8_STAGE(PG8_SA(0, 0), cA, voffA); PG8_STAGE(PG8_SA(0, 1), cA + hstepA, voffA);
    if (wr == 1) PG8_BAR;
    PG8_WAIT_V(2); PG8_BAR;
    PG8_STAGE(PG8_SB(1, 0), cB + kstep, voffB); PG8_STAGE(PG8_SA(1, 0), cA + kstep, voffA); PG8_STAGE(PG8_SB(1, 1), cB + hstepB + kstep, voffB);
    PG8_WAIT_V(6); PG8_BAR;
    for (;;) {
        const bool has_next = S.next(ui + 1, nxt);
        const char* nA = has_next ? (const char*)g.A + (size_t)nxt.pm * tstep : cA; const char* nB = has_next ? (const char*)g.Bt + (size_t)nxt.pn * tstep : cB;
        for (int t = 0; t < nt; t += 2) {
            const bool last = (t == nt - 2);
            const char* a1 = cA + (size_t)(t + 1) * kstep;
            const char* a2 = last ? nA : cA + (size_t)(t + 2) * kstep; const char* b2 = last ? nB : cB + (size_t)(t + 2) * kstep;
            const char* a3 = a2 + kstep; const char* b3 = b2 + kstep;
            PG8_LDB(B0, 0, 0); PG8_LDB(B1, 0, 1); PG8_SCHED; PG8_LDA(At, 0, 0); PG8_STAGE(PG8_SA(1, 1), a1 + hstepA, voffA);
            PG8_WAIT_V(8); PG8_WAIT_L(0); PG8_BAR; PG8_MMA(0, 0, At, B0); PG8_MMA(0, 1, At, B1); PG8_BAR; PG8_SCHED;
            PG8_LDA(At, 0, 1); PG8_STAGE(PG8_SB(0, 0), b2, voffB); PG8_STAGE(PG8_SB(0, 1), b2 + hstepB, voffB); PG8_STAGE(PG8_SA(0, 0), a2, voffA);
            PG8_WAIT_V(8); PG8_WAIT_L(0); PG8_BAR; PG8_MMA(1, 0, At, B0); PG8_MMA(1, 1, At, B1); PG8_BAR; PG8_SCHED;
            PG8_LDB(B0, 1, 0); PG8_LDB(B1, 1, 1); PG8_SCHED; PG8_LDA(At, 1, 0); PG8_STAGE(PG8_SA(0, 1), a2 + hstepA, voffA);
            PG8_WAIT_V(8); PG8_WAIT_L(0); PG8_BAR; PG8_MMA(0, 0, At, B0); PG8_MMA(0, 1, At, B1); PG8_BAR; PG8_SCHED;
            PG8_LDA(At, 1, 1); PG8_STAGE(PG8_SB(1, 0), b3, voffB); PG8_STAGE(PG8_SB(1, 1), b3 + hstepB, voffB); PG8_STAGE(PG8_SA(1, 0), a3, voffA);
            PG8_WAIT_V(8); PG8_WAIT_L(0); PG8_BAR; PG8_MMA(1, 0, At, B0); PG8_MMA(1, 1, At, B1); PG8_BAR; PG8_SCHED;
        }
        if constexpr (ALIGN_EPI) { if (wr == 0) PG8_BAR; }
        E(acc, cur, wr, wc, fr, fq);
        if (!has_next) break;
#pragma unroll
        for (int a = 0; a < 2; ++a)
#pragma unroll
            for (int b = 0; b < 2; ++b)
#pragma unroll
                for (int m = 0; m < 4; ++m)
#pragma unroll
                    for (int n = 0; n < 2; ++n) acc[a][b][m][n] = (f32x4){0.f, 0.f, 0.f, 0.f};
        cur = nxt; cA = nA; cB = nB; ++ui;
        if constexpr (ALIGN_EPI) { if (wr == 1) PG8_BAR; }
    }
    PG8_WAIT_V(0);
    if constexpr (!ALIGN_EPI) { if (wr == 0) PG8_BAR; }
    PG8_BAR;
#undef PG8_SA
#undef PG8_SB
#undef PG8_STAGE
#undef PG8_LDA
#undef PG8_LDB
#undef PG8_MMA
#undef PG8_WAIT_V
#undef PG8_WAIT_L
#undef PG8_BAR
#undef PG8_SCHED
}
}

constexpr int NWAVES = 8;
constexpr int BATCH = 32, SEQ = 2048, D = 1024, FF = 4096, HD = 64;
constexpr int M = BATCH * SEQ;
constexpr int NPROJ = 2304;
constexpr int COL_QA = 0, COL_KA = 512, COL_VA = 640, COL_QB = 768, COL_KB = 1280, COL_VB = 1792;
constexpr float RMS_EPS = 1e-6f;
constexpr int N_LAUNCHES = MK_N_LAUNCHES, PER_PHASE = 6;
constexpr int N_BAR_REGIONS = (MK_N_LAUNCHES == PER_PHASE) ? 1 : MK_N_LAUNCHES;

constexpr size_t MiB = 1u << 20;
constexpr size_t WS_CTL = 0, CTL_ZERO_BYTES = 1 * MiB;
constexpr size_t WS_WIN = 2 * MiB, WS_WOUT = 8 * MiB, WS_WUP = 10 * MiB, WS_WDN = 18 * MiB;
constexpr size_t WS_ROPE = 26 * MiB;
constexpr size_t WS_SS = 30 * MiB;
constexpr size_t WS_XN = 64 * MiB;
constexpr size_t WS_PROJ = 192 * MiB;
constexpr size_t WS_MIX = 480 * MiB;
constexpr size_t WS_HID = 192 * MiB;
constexpr size_t WS_END = 704 * MiB;
static_assert(WS_WIN + (size_t)NPROJ * D * 2 <= WS_WOUT && WS_WDN + (size_t)D * FF * 2 <= WS_ROPE && WS_SS + (size_t)M * 64 <= WS_XN, "d_ws map");
static_assert(WS_XN + (size_t)M * D * 2 <= WS_PROJ && WS_PROJ + (size_t)M * NPROJ * 2 <= WS_MIX && WS_MIX + (size_t)M * D * 2 <= WS_END && WS_HID + (size_t)M * FF * 2 <= WS_END, "d_ws map");
constexpr int CW_TMO = 0, CW_CODE = 1;
constexpr int CW_BAR = 4096;

constexpr int RING_OFF = 0, RING_BYTES = 131072;
constexpr int LDSCTL_OFF = 139264, MISC_OFF = LDSCTL_OFF + 320;
constexpr int LDS_BYTES = 147456;

#define GAS __attribute__((address_space(1)))
#define LAS __attribute__((address_space(3)))
typedef unsigned short bf16;
typedef unsigned v4u __attribute__((ext_vector_type(4)));
typedef float f32x4 __attribute__((ext_vector_type(4)));
typedef GAS unsigned gu32;
#define RLX_AGENT __ATOMIC_RELAXED, __HIP_MEMORY_SCOPE_AGENT
#define LDS_WAIT() asm volatile("s_waitcnt lgkmcnt(0)" ::: "memory")
#define VM_WAIT() asm volatile("s_waitcnt vmcnt(0)" ::: "memory")
__device__ __forceinline__ unsigned f2bf(float f) { unsigned u = __builtin_bit_cast(unsigned, f); return (u + 0x7fffu + ((u >> 16) & 1u)) >> 16; }
__device__ __forceinline__ unsigned pk2(float lo, float hi) { return f2bf(lo) | (f2bf(hi) << 16); }
__device__ __forceinline__ float bf_lo(unsigned u) { return __uint_as_float(u << 16); }
__device__ __forceinline__ float bf_hi(unsigned u) { return __uint_as_float(u & 0xffff0000u); }

#define XB_TMO      128
#define XB_XCNT(j)  (256  + 64 * (j))
#define XB_XSUB(j)  (1280 + 64 * (j))
#define XB_XGEN(j)  (2304 + 64 * (j))
#define XB_TOP      3328
#define XB_TOPGEN   3392
#define XCD_BAR_WORDS 3456
#define XB_SPIN_CAP (1u << 18)

__device__ __forceinline__ unsigned xb_ld(unsigned* p)              { return __hip_atomic_load(p, __ATOMIC_RELAXED, __HIP_MEMORY_SCOPE_AGENT); }
__device__ __forceinline__ unsigned xb_add(unsigned* p, unsigned v) { return __hip_atomic_fetch_add(p, v, __ATOMIC_RELAXED, __HIP_MEMORY_SCOPE_AGENT); }
__device__ __forceinline__ unsigned xb_xcc_id() { return (unsigned)__builtin_amdgcn_s_getreg((3 << 11) | 20) & 0xFu; }
#define XB_SPIN(cond, bar) do { unsigned _sp = 0; while (cond) { __builtin_amdgcn_s_sleep(1); \
    if ((++_sp & 255u) == 0u) { if (xb_ld(&(bar)[XB_TMO])) break; if (_sp > XB_SPIN_CAP) { atomicAdd(&(bar)[XB_TMO], 1u); break; } } } } while (0)

struct XcdBarrier { unsigned* bar; unsigned x; volatile LAS unsigned* st; };

__device__ __forceinline__ XcdBarrier xcd_barrier_post(unsigned* bar, volatile LAS unsigned* st) {
    XcdBarrier b; b.bar = bar; b.x = xb_xcc_id(); b.st = st;
    if (threadIdx.x == 0) (void)xb_add(&bar[XB_XCNT(b.x)], 1u);
    return b;
}
__device__ __forceinline__ void xcd_barrier_complete(unsigned* bar, unsigned x, unsigned& nloc, unsigned& nx) {
    const unsigned G = gridDim.x * gridDim.y * gridDim.z;
    unsigned sum, cnt, mine, sp = 0u;
    for (;;) {
        sum = 0u; cnt = 0u; mine = 0u;
#pragma unroll
        for (unsigned j = 0; j < 16; ++j) { const unsigned c = xb_ld(&bar[XB_XCNT(j)]); sum += c; cnt += (c > 0u) ? 1u : 0u; mine = (j == x) ? c : mine; }
        if (sum == G) break;
        __builtin_amdgcn_s_sleep(1);
        if ((++sp & 255u) == 0u) { if (xb_ld(&bar[XB_TMO])) break; if (sp > XB_SPIN_CAP) { atomicAdd(&bar[XB_TMO], 1u); break; } }
    }
    nloc = mine > 0u ? mine : 1u; nx = cnt > 0u ? cnt : 1u;
}
__device__ __forceinline__ void xcd_barrier(const XcdBarrier& b) {
    asm volatile("s_waitcnt vmcnt(0)" ::: "memory");
    __syncthreads();
    if (threadIdx.x == 0) {
        unsigned* bar = b.bar;
        __builtin_amdgcn_s_waitcnt(0);
        unsigned nloc = b.st[0], nx = b.st[1];
        if (nloc == 0u) { xcd_barrier_complete(bar, b.x, nloc, nx); b.st[0] = nloc; b.st[1] = nx; }
        const unsigned old = xb_add(&bar[XB_XSUB(b.x)], 1u);
        const unsigned gen = old / nloc;
        if (old + 1u == (gen + 1u) * nloc) {
            __builtin_amdgcn_fence(__ATOMIC_RELEASE, "agent");
            asm volatile("s_waitcnt vmcnt(0)" ::: "memory");
            const unsigned og = xb_add(&bar[XB_TOP], 1u);
            const unsigned tg = og / nx;
            if (og + 1u == (tg + 1u) * nx) xb_add(&bar[XB_TOPGEN], 1u);
            else XB_SPIN(xb_ld(&bar[XB_TOPGEN]) == tg, bar);
            __builtin_amdgcn_fence(__ATOMIC_ACQUIRE, "agent");
            xb_add(&bar[XB_XGEN(b.x)], 1u);
            asm volatile("s_waitcnt vmcnt(0)" ::: "memory");
        } else {
            XB_SPIN(xb_ld(&bar[XB_XGEN(b.x)]) == gen, bar);
            __builtin_amdgcn_fence(__ATOMIC_ACQUIRE, "agent");
            asm volatile("s_waitcnt vmcnt(0)" ::: "memory");
        }
    }
    __syncthreads();
}

__device__ __forceinline__ float wave_sum(float v) {
#pragma unroll
    for (int o = 1; o < 64; o <<= 1) v += __shfl_xor(v, o);
    return v;
}
__device__ __forceinline__ float wave_max(float v) {
#pragma unroll
    for (int o = 1; o < 64; o <<= 1) v = __builtin_fmaxf(v, __shfl_xor(v, o));
    return v;
}
__device__ __forceinline__ void p0_transpose_item(const float* W, int K, int N, bf16* WT, const float* gk, LAS float* scr, int item, int lane) {
    const int nblk = N / 32, kb = item / nblk, nb = item % nblk, k0 = 64 * kb, n0 = 32 * nb;
#pragma unroll 8
    for (int i = 0; i < 32; ++i) { const int kk = 2 * i + (lane >> 5); float v = W[(size_t)(k0 + kk) * N + n0 + (lane & 31)]; if (gk) v *= gk[k0 + kk]; scr[kk * 33 + (lane & 31)] = v; }
    LDS_WAIT(); asm volatile("" ::: "memory");
    const int c = lane & 7;
#pragma unroll
    for (int j = 0; j < 4; ++j) { const int n = (lane >> 3) + 8 * j; const LAS float* s = scr + (8 * c) * 33 + n;
        v4u o; o.x = pk2(s[0 * 33], s[1 * 33]); o.y = pk2(s[2 * 33], s[3 * 33]); o.z = pk2(s[4 * 33], s[5 * 33]); o.w = pk2(s[6 * 33], s[7 * 33]);
        *(GAS v4u*)(WT + (size_t)(n0 + n) * K + k0 + 8 * c) = o; }
    LDS_WAIT(); asm volatile("" ::: "memory");
}
__device__ __forceinline__ void rms_row_to_bf16(const float* xrow, const float* gain, bf16* orow, int lane) {
    const GAS f32x4* xr = (const GAS f32x4*)xrow + lane; const GAS f32x4* gr = (const GAS f32x4*)gain + lane;
    f32x4 v[4]; float s = 0.f;
#pragma unroll
    for (int j = 0; j < 4; ++j) { v[j] = xr[64 * j]; s += (v[j].x * v[j].x + v[j].y * v[j].y) + (v[j].z * v[j].z + v[j].w * v[j].w); }
    const float rstd = __builtin_amdgcn_rsqf(wave_sum(s) * (1.f / D) + RMS_EPS);
    GAS unsigned long long* o8 = (GAS unsigned long long*)orow + lane;
#pragma unroll
    for (int j = 0; j < 4; ++j) { const f32x4 gg = gr[64 * j]; const f32x4 y = v[j] * rstd * gg;
        o8[64 * j] = (unsigned long long)pk2(y.x, y.y) | ((unsigned long long)pk2(y.z, y.w) << 32); }
}

__device__ __forceinline__ void attn_naive(const bf16* PROJ, bf16* MIX, const float* gqa, const float* gka, const float* gqb, const float* gkb, const float* sinks, int gtid, int nthr) {
    float mqa = 0.f, mka = 0.f, mqb = 0.f, mkb = 0.f;
    for (int d = 0; d < HD; ++d) { mqa = __builtin_fmaxf(mqa, __builtin_fabsf(gqa[d])); mka = __builtin_fmaxf(mka, __builtin_fabsf(gka[d])); mqb = __builtin_fmaxf(mqb, __builtin_fabsf(gqb[d])); mkb = __builtin_fmaxf(mkb, __builtin_fabsf(gkb[d])); }
    const float shiftA = pg8::C2 * 64.f * mqa * mka, shiftB = pg8::C2 * 64.f * mqb * mkb;
    for (long item = gtid; item < (long)M * 16; item += nthr) {
        const int hh = (int)(item / M), m = (int)(item % M), t = m & (SEQ - 1), rowbase = m - t;
        const bool isA = hh < 8; const int h = hh & 7;
        const int qcol = isA ? COL_QA + h * 64 : COL_QB + h * 64, kcol = isA ? COL_KA + (h >> 2) * 64 : COL_KB + h * 64, vcol = isA ? COL_VA + (h >> 2) * 64 : COL_VB + h * 64;
        const float shift = isA ? shiftA : shiftB;
        float q[64], o[64]; float l = 0.f;
        { const v4u* qp = (const v4u*)(PROJ + (size_t)m * NPROJ + qcol);
#pragma unroll
          for (int c = 0; c < 8; ++c) { const v4u u = qp[c]; q[8 * c + 0] = bf_lo(u.x); q[8 * c + 1] = bf_hi(u.x); q[8 * c + 2] = bf_lo(u.y); q[8 * c + 3] = bf_hi(u.y); q[8 * c + 4] = bf_lo(u.z); q[8 * c + 5] = bf_hi(u.z); q[8 * c + 6] = bf_lo(u.w); q[8 * c + 7] = bf_hi(u.w); } }
#pragma unroll
        for (int d = 0; d < 64; ++d) o[d] = 0.f;
#define KEY(srow, wgt) do { const v4u* kp = (const v4u*)(PROJ + (size_t)(rowbase + (srow)) * NPROJ + kcol); float sc = 0.f; \
        _Pragma("unroll") for (int c = 0; c < 8; ++c) { const v4u u = kp[c]; sc += q[8 * c + 0] * bf_lo(u.x) + q[8 * c + 1] * bf_hi(u.x) + q[8 * c + 2] * bf_lo(u.y) + q[8 * c + 3] * bf_hi(u.y) + q[8 * c + 4] * bf_lo(u.z) + q[8 * c + 5] * bf_hi(u.z) + q[8 * c + 6] * bf_lo(u.w) + q[8 * c + 7] * bf_hi(u.w); } \
        const float p = (wgt) * __builtin_amdgcn_exp2f(sc - shift); l += p; const v4u* vp = (const v4u*)(PROJ + (size_t)(rowbase + (srow)) * NPROJ + vcol); \
        _Pragma("unroll") for (int c = 0; c < 8; ++c) { const v4u u = vp[c]; o[8 * c + 0] += p * bf_lo(u.x); o[8 * c + 1] += p * bf_hi(u.x); o[8 * c + 2] += p * bf_lo(u.y); o[8 * c + 3] += p * bf_hi(u.y); o[8 * c + 4] += p * bf_lo(u.z); o[8 * c + 5] += p * bf_hi(u.z); o[8 * c + 6] += p * bf_lo(u.w); o[8 * c + 7] += p * bf_hi(u.w); } } while (0)
        if (isA) {
            for (int dist = 0; dist <= 127 && dist <= t; ++dist) KEY(t - dist, 1.0f);
            l += __builtin_amdgcn_exp2f(sinks[h] * 1.4426950408889634f - shift);
        } else {
            for (int dist = 0; dist <= 128 && dist <= t; ++dist) { const float w = 1.0f + (((dist & 3) == 0) ? 1.0f : 0.0f) + (((dist & 15) == 0) ? 1.0f : 0.0f); KEY(t - dist, w); }
            for (int dist = 132; dist <= 512 && dist <= t; dist += 4) { const float w = 1.0f + (((dist & 15) == 0) ? 1.0f : 0.0f); KEY(t - dist, w); }
            for (int dist = 528; dist <= t; dist += 16) KEY(t - dist, 1.0f);
        }
#undef KEY
        const float rl = 1.0f / l;
        v4u* op = (v4u*)(MIX + (size_t)m * D + hh * 64);
#pragma unroll
        for (int c = 0; c < 8; ++c) { v4u u; u.x = pk2(o[8 * c + 0] * rl, o[8 * c + 1] * rl); u.y = pk2(o[8 * c + 2] * rl, o[8 * c + 3] * rl); u.z = pk2(o[8 * c + 4] * rl, o[8 * c + 5] * rl); u.w = pk2(o[8 * c + 6] * rl, o[8 * c + 7] * rl); op[c] = u; }
    }
}


typedef short a_bf16x8 __attribute__((ext_vector_type(8)));
typedef short a_s16x4 __attribute__((ext_vector_type(4)));
typedef float a_f32x16 __attribute__((ext_vector_type(16)));
typedef float a_f32x2 __attribute__((ext_vector_type(2)));
typedef __bf16 a_bf16x2 __attribute__((ext_vector_type(2)));
__device__ __forceinline__ unsigned a_cvtpk(float lo, float hi) { a_f32x2 v = {lo, hi}; a_bf16x2 b = __builtin_convertvector(v, a_bf16x2); return __builtin_bit_cast(unsigned, b); }
__device__ __forceinline__ a_s16x4 a_vtr(LAS const unsigned char* p) { return __builtin_bit_cast(a_s16x4, __builtin_amdgcn_ds_read_tr16_b64_v4i16((LAS a_s16x4*)p)); }
constexpr int ATT_WLDS = 16384;
constexpr int ATT_STG = 8192, ATT_STG_PITCH = 144;

struct AttnTask { int qrow0, qrs, qcol, kcol, vcol, n1, row1, D01, kt2lo, kt2hi, row2, D02, qstep2, maxd2, orow0, ors, ocol; float shift, sinkterm; };

__device__ __forceinline__ void attn_task(const bf16* __restrict__ PROJ, bf16* __restrict__ MIX, LAS unsigned char* wl, const int lane, const AttnTask& T) {
    const int i = lane & 31, hh = lane >> 5;
    a_bf16x8 qf[4];
    { const bf16* qp = PROJ + (size_t)(T.qrow0 + i * T.qrs) * NPROJ + T.qcol + 8 * hh;
#pragma unroll
      for (int s = 0; s < 4; ++s) qf[s] = *(const a_bf16x8*)(qp + 16 * s); }
    a_f32x16 o0 = {}, o1 = {}; float lsum = 0.f;
    const int Dl1 = T.D01 + i - 4 * hh, Dl2 = T.D02 + T.qstep2 * i - 4 * hh;
    float wg[4];
#pragma unroll
    for (int c = 0; c < 4; ++c) wg[c] = ((Dl1 & 3) == c) ? 1.0f : 0.0f;
    const int nt = T.n1 + (T.kt2hi - T.kt2lo);
    const int klane = i * NPROJ + 8 * hh, vlane = (lane >> 3) * NPROJ + (lane & 7) * 8;
    LAS unsigned char* vw = wl + ((lane & 7) >> 2) * 2048 + (lane >> 3) * 64 + (lane & 3) * 16;
    LAS const unsigned char* tra = wl + (4 * hh + ((lane & 15) >> 2)) * 64 + ((lane >> 4) & 1) * 32 + (lane & 3) * 8;
    a_f32x16 negs;
#pragma unroll
    for (int r = 0; r < 16; ++r) negs[r] = -T.shift;
    v4u kn[4]; v4u vn[4];
#define ATT_LOAD(j) do { const int seg1_ = (j) < T.n1; const int kt_ = seg1_ ? (j) : T.kt2lo + ((j) - T.n1); const int row_ = seg1_ ? T.row1 + 128 * kt_ : T.row2 + 32 * kt_; const int rs_ = seg1_ ? 4 : 1; \
        const bf16* kb_ = PROJ + (size_t)row_ * NPROJ + T.kcol + (size_t)(vlane - (lane & 7) * 8) * rs_ + (lane & 7) * 8; const bf16* vb_ = PROJ + (size_t)row_ * NPROJ + T.vcol + (size_t)(vlane - (lane & 7) * 8) * rs_ + (lane & 7) * 8; \
        _Pragma("unroll") for (int jj = 0; jj < 4; ++jj) kn[jj] = *(const v4u*)(kb_ + (size_t)(8 * jj * rs_) * NPROJ); \
        _Pragma("unroll") for (int jj = 0; jj < 4; ++jj) vn[jj] = *(const v4u*)(vb_ + (size_t)(8 * jj * rs_) * NPROJ); } while (0)
    ATT_LOAD(0);
    for (int j = 0; j < nt; ++j) {
        v4u kr[4]; v4u vr[4];
#pragma unroll
        for (int s = 0; s < 4; ++s) { kr[s] = kn[s]; vr[s] = vn[s]; }
        if (j + 1 < nt) ATT_LOAD(j + 1);
        const bool seg1 = j < T.n1; const int kt = seg1 ? j : T.kt2lo + (j - T.n1);
        const int Dt = (seg1 ? Dl1 : Dl2) - 32 * kt;
        const int D0 = (seg1 ? T.D01 : T.D02) - 32 * kt, qst = seg1 ? 1 : T.qstep2, maxd = seg1 ? 128 : T.maxd2;
        const int dpmin = D0 - 31, dpmax = D0 + 31 * qst;
        const int cls = (dpmin >= 0 && dpmax <= maxd) ? 1 : (dpmin > maxd ? 2 : 0);
#pragma unroll
        for (int jj = 0; jj < 4; ++jj) *(LAS v4u*)(vw + 512 * jj) = vr[jj];
#pragma unroll
        for (int jj = 0; jj < 4; ++jj) *(LAS v4u*)(wl + 4096 + (lane & 7) * 512 + (((8 * jj + (lane >> 3)) ^ (lane & 7)) * 16)) = kr[jj];
        a_bf16x8 kf[4];
#pragma unroll
        for (int s = 0; s < 4; ++s) kf[s] = *(LAS const a_bf16x8*)(wl + 4096 + (2 * s + hh) * 512 + ((i ^ (2 * s + hh)) * 16));
        a_f32x16 S = negs;
#pragma unroll
        for (int s = 0; s < 4; ++s) S = __builtin_amdgcn_mfma_f32_32x32x16_bf16(kf[s], qf[s], S, 0, 0, 0);
        float p[16];
        float wm[4];
#pragma unroll
        for (int c = 0; c < 4; ++c) wm[c] = seg1 ? wg[c] : 0.0f;
        if (cls == 1) {
#pragma unroll
            for (int r = 0; r < 16; ++r) p[r] = (1.0f + wm[r & 3]) * __builtin_amdgcn_exp2f(S[r]);
        } else if (cls == 2) {
#pragma unroll
            for (int r = 0; r < 16; ++r) p[r] = wm[r & 3] * __builtin_amdgcn_exp2f(S[r]);
        } else {
#pragma unroll
            for (int r = 0; r < 16; ++r) { const int dp = Dt - ((r & 3) + 8 * (r >> 2));
                const float w = (((unsigned)dp <= (unsigned)maxd) ? 1.0f : 0.0f) + ((dp >= 0) ? wm[r & 3] : 0.0f);
                p[r] = w * __builtin_amdgcn_exp2f(S[r]); }
        }
        float ls = 0.f;
#pragma unroll
        for (int r = 0; r < 16; ++r) ls += p[r];
        lsum += ls;
        a_bf16x8 pb0, pb1;
        { v4u w0, w1; w0.x = a_cvtpk(p[0], p[1]); w0.y = a_cvtpk(p[2], p[3]); w0.z = a_cvtpk(p[4], p[5]); w0.w = a_cvtpk(p[6], p[7]);
          w1.x = a_cvtpk(p[8], p[9]); w1.y = a_cvtpk(p[10], p[11]); w1.z = a_cvtpk(p[12], p[13]); w1.w = a_cvtpk(p[14], p[15]);
          pb0 = __builtin_bit_cast(a_bf16x8, w0); pb1 = __builtin_bit_cast(a_bf16x8, w1); }
        {
            a_s16x4 lo, hi;
#define ATT_VF (a_bf16x8){lo[0], lo[1], lo[2], lo[3], hi[0], hi[1], hi[2], hi[3]}
            lo = a_vtr(tra);               hi = a_vtr(tra + 512);               o0 = __builtin_amdgcn_mfma_f32_32x32x16_bf16(ATT_VF, pb0, o0, 0, 0, 0);
            lo = a_vtr(tra + 1024);        hi = a_vtr(tra + 1024 + 512);        o0 = __builtin_amdgcn_mfma_f32_32x32x16_bf16(ATT_VF, pb1, o0, 0, 0, 0);
            lo = a_vtr(tra + 2048);        hi = a_vtr(tra + 2048 + 512);        o1 = __builtin_amdgcn_mfma_f32_32x32x16_bf16(ATT_VF, pb0, o1, 0, 0, 0);
            lo = a_vtr(tra + 2048 + 1024); hi = a_vtr(tra + 2048 + 1024 + 512); o1 = __builtin_amdgcn_mfma_f32_32x32x16_bf16(ATT_VF, pb1, o1, 0, 0, 0);
#undef ATT_VF
        }
    }
#undef ATT_LOAD
    const float ltot = lsum + __shfl_xor(lsum, 32) + T.sinkterm;
    const float rl = 1.0f / ltot;
    LAS unsigned char* stg = wl + ATT_STG;
#pragma unroll
    for (int g = 0; g < 4; ++g) {
        typedef unsigned u32x2_t __attribute__((ext_vector_type(2)));
        u32x2_t a, b2;
        a.x = a_cvtpk(o0[4 * g] * rl, o0[4 * g + 1] * rl); a.y = a_cvtpk(o0[4 * g + 2] * rl, o0[4 * g + 3] * rl);
        b2.x = a_cvtpk(o1[4 * g] * rl, o1[4 * g + 1] * rl); b2.y = a_cvtpk(o1[4 * g + 2] * rl, o1[4 * g + 3] * rl);
        *(LAS u32x2_t*)(stg + i * ATT_STG_PITCH + (8 * g + 4 * hh) * 2) = a;
        *(LAS u32x2_t*)(stg + i * ATT_STG_PITCH + (32 + 8 * g + 4 * hh) * 2) = b2;
    }
#pragma unroll
    for (int jj = 0; jj < 4; ++jj) { const int row = jj * 8 + (lane >> 3), ch = lane & 7;
        const v4u v = *(LAS const v4u*)(stg + row * ATT_STG_PITCH + ch * 16);
        *(v4u*)(MIX + (size_t)(T.orow0 + row * T.ors) * D + T.ocol + ch * 8) = v; }
}

__device__ __forceinline__ void attn_phase(const bf16* PROJ, bf16* MIX, const float* gqa, const float* gka, const float* gqb, const float* gkb, const float* sinks, LAS unsigned char* lds, int vcu, int G, int wave, int lane) {
    const float mqa = wave_max(__builtin_fabsf(gqa[lane])), mka = wave_max(__builtin_fabsf(gka[lane])), mqb = wave_max(__builtin_fabsf(gqb[lane])), mkb = wave_max(__builtin_fabsf(gkb[lane]));
    const float shiftA = pg8::C2 * 64.f * mqa * mka, shiftB = pg8::C2 * 64.f * mqb * mkb;
    LAS unsigned char* wl = lds + wave * ATT_WLDS;
    for (int v = vcu; v < BATCH * 8; v += G) {
        const int b = v >> 3, h = v & 7, rowb = b * SEQ;
        for (int k = 0; k < 16; ++k) {
            AttnTask T;
            if (k < 8) {
                const int r = wave & 3, half = wave >> 2, pr = 2 * (k >> 1) + half, c = (k & 1) ? 15 - pr : pr;
                T.qrow0 = rowb + 128 * c + r; T.qrs = 4; T.qcol = COL_QB + h * 64; T.kcol = COL_KB + h * 64; T.vcol = COL_VB + h * 64;
                T.n1 = c + 1; T.row1 = rowb + r; T.D01 = 32 * c;
                T.kt2lo = (c == 0) ? 4 : 0; T.kt2hi = 8; T.row2 = rowb + 128 * c - 128; T.D02 = 128 + r; T.qstep2 = 4; T.maxd2 = 128;
                T.orow0 = T.qrow0; T.ors = 4; T.ocol = 512 + h * 64; T.shift = shiftB; T.sinkterm = 0.f;
            } else {
                const int c = wave + 8 * (k - 8);
                T.qrow0 = rowb + 32 * c; T.qrs = 1; T.qcol = COL_QA + h * 64; T.kcol = COL_KA + (h >> 2) * 64; T.vcol = COL_VA + (h >> 2) * 64;
                T.n1 = 0; T.row1 = rowb; T.D01 = 0;
                T.kt2lo = (c < 4) ? 4 - c : 0; T.kt2hi = 5; T.row2 = rowb + 32 * c - 128; T.D02 = 128; T.qstep2 = 1; T.maxd2 = 127;
                T.orow0 = T.qrow0; T.ors = 1; T.ocol = h * 64; T.shift = shiftA; T.sinkterm = __builtin_amdgcn_exp2f(sinks[h] * 1.4426950408889634f - shiftA);
            }
            attn_task(PROJ, MIX, wl, lane, T);
        }
    }
}


constexpr int A2_SLOT = 32768, A2_STG = 98304, A2_STG_W = 4608, A2_NROUNDS = 72 + 23;
struct RIter { int ph, p, k; };
__device__ __forceinline__ void ri_next(RIter& it) { it.k++; const int n = (it.ph == 0) ? 2 * it.p + 2 : ((it.p == 0) ? 2 : 3); if (it.k == n) { it.k = 0; it.p++; if (it.p == 8) { it.p = 0; it.ph++; } } }
__device__ __forceinline__ int ri_blk(const RIter& it) { return (it.ph == 0) ? it.k : ((it.p == 0) ? it.k : 2 * it.p - 1 + it.k); }

__device__ __forceinline__ void attn_phase2(const bf16* __restrict__ PROJ, bf16* __restrict__ MIX, const float* sinks,
                                            LAS unsigned char* lds, int vcu, int G, int wave, int lane, const int mode) {
    const int i = lane & 31, hh = lane >> 5, r = wave & 3, grp = wave >> 2;
    const float NINF = -__builtin_inff();
    unsigned offK[2], offV[2];
#pragma unroll
    for (int j = 0; j < 2; ++j) { const int n = 2 * wave + j, slot = 8 * n + (lane >> 3), cp = lane & 7;
        const int rk = slot ^ ((slot >> 4) & 3), ch = cp ^ ((slot >> 1) & 7); offK[j] = (unsigned)(rk * NPROJ + ch * 8);
        const int rv = slot ^ ((slot >> 2) & 3), dh = (cp >> 2) ^ ((slot >> 1) & 1); offV[j] = (unsigned)(rv * NPROJ + dh * 32 + (cp & 3) * 8); }
    int k1[4], ke[4], ko[4], v1[2], v2[4];
    { const int rho = 4 * i + r, slot = rho ^ ((rho >> 4) & 3), sw = (slot >> 1) & 7;
#pragma unroll
      for (int s = 0; s < 4; ++s) k1[s] = slot * 128 + (((2 * s + hh) ^ sw) * 16); }
    { const int xe = i ^ (i >> 4), xo = i ^ (2 | (i >> 4));
#pragma unroll
      for (int s = 0; s < 4; ++s) { ke[s] = xe * 128 + (((2 * s + hh) ^ ((xe >> 1) & 7)) * 16); ko[s] = xo * 128 + (((2 * s + hh) ^ ((xo >> 1) & 7)) * 16); } }
    { const int q4 = (lane & 15) >> 2, g = (lane >> 4) & 1, pp = lane & 3;
#pragma unroll
      for (int dh = 0; dh < 2; ++dh) { const int sl = 16 * hh + 4 * q4 + (r ^ q4); v1[dh] = 16384 + sl * 128 + ((dh ^ ((sl >> 1) & 1)) * 64) + g * 32 + pp * 8; }
#pragma unroll
      for (int x = 0; x < 4; ++x) { const int dh = x >> 1, e = x & 1, kk = 8 * e + 4 * hh + q4, sl = kk ^ ((kk >> 2) & 3); v2[x] = 16384 + sl * 128 + ((dh ^ ((sl >> 1) & 1)) * 64) + g * 32 + pp * 8; } }
    a_f32x16 c1F, c1R;
#pragma unroll
    for (int q = 0; q < 16; ++q) { const bool mt = ((q & 3) == (i & 3)); c1F[q] = mt ? 1.0f : 0.0f; c1R[q] = mt ? 0.0f : NINF; }
    LAS unsigned char* stg = lds + A2_STG + wave * A2_STG_W;
#define A2_WAIT_V(n) asm volatile("s_waitcnt vmcnt(" #n ")" ::: "memory")
#define A2_OFFQ(q) (((q) & 3) + 8 * ((q) >> 2))
#define A2_CHAIN(S, C, KA) do { a_bf16x8 kf0_ = *(LAS const a_bf16x8*)(lds + (KA)[0]), kf1_ = *(LAS const a_bf16x8*)(lds + (KA)[1]), kf2_ = *(LAS const a_bf16x8*)(lds + (KA)[2]), kf3_ = *(LAS const a_bf16x8*)(lds + (KA)[3]); \
        S = __builtin_amdgcn_mfma_f32_32x32x16_bf16(kf0_, qf[0], C, 0, 0, 0); S = __builtin_amdgcn_mfma_f32_32x32x16_bf16(kf1_, qf[1], S, 0, 0, 0); \
        S = __builtin_amdgcn_mfma_f32_32x32x16_bf16(kf2_, qf[2], S, 0, 0, 0); S = __builtin_amdgcn_mfma_f32_32x32x16_bf16(kf3_, qf[3], S, 0, 0, 0); } while (0)
#define A2_TAIL(S, VA) do { float p_[16]; _Pragma("unroll") for (int q = 0; q < 16; ++q) p_[q] = __builtin_amdgcn_exp2f(S[q]); \
        lsum += ((p_[0] + p_[1]) + (p_[2] + p_[3])) + ((p_[4] + p_[5]) + (p_[6] + p_[7])) + (((p_[8] + p_[9]) + (p_[10] + p_[11])) + ((p_[12] + p_[13]) + (p_[14] + p_[15]))); \
        a_bf16x8 pb0_, pb1_; { v4u w0_, w1_; w0_.x = a_cvtpk(p_[0], p_[1]); w0_.y = a_cvtpk(p_[2], p_[3]); w0_.z = a_cvtpk(p_[4], p_[5]); w0_.w = a_cvtpk(p_[6], p_[7]); \
          w1_.x = a_cvtpk(p_[8], p_[9]); w1_.y = a_cvtpk(p_[10], p_[11]); w1_.z = a_cvtpk(p_[12], p_[13]); w1_.w = a_cvtpk(p_[14], p_[15]); \
          pb0_ = __builtin_bit_cast(a_bf16x8, w0_); pb1_ = __builtin_bit_cast(a_bf16x8, w1_); } \
        a_s16x4 lo_, hi_; \
        lo_ = a_vtr(lds + VA(0, 0, 0)); hi_ = a_vtr(lds + VA(0, 0, 1)); o0 = __builtin_amdgcn_mfma_f32_32x32x16_bf16((a_bf16x8){lo_[0], lo_[1], lo_[2], lo_[3], hi_[0], hi_[1], hi_[2], hi_[3]}, pb0_, o0, 0, 0, 0); \
        lo_ = a_vtr(lds + VA(0, 1, 0)); hi_ = a_vtr(lds + VA(0, 1, 1)); o0 = __builtin_amdgcn_mfma_f32_32x32x16_bf16((a_bf16x8){lo_[0], lo_[1], lo_[2], lo_[3], hi_[0], hi_[1], hi_[2], hi_[3]}, pb1_, o0, 0, 0, 0); \
        lo_ = a_vtr(lds + VA(1, 0, 0)); hi_ = a_vtr(lds + VA(1, 0, 1)); o1 = __builtin_amdgcn_mfma_f32_32x32x16_bf16((a_bf16x8){lo_[0], lo_[1], lo_[2], lo_[3], hi_[0], hi_[1], hi_[2], hi_[3]}, pb0_, o1, 0, 0, 0); \
        lo_ = a_vtr(lds + VA(1, 1, 0)); hi_ = a_vtr(lds + VA(1, 1, 1)); o1 = __builtin_amdgcn_mfma_f32_32x32x16_bf16((a_bf16x8){lo_[0], lo_[1], lo_[2], lo_[3], hi_[0], hi_[1], hi_[2], hi_[3]}, pb1_, o1, 0, 0, 0); } while (0)
    for (int v = vcu; v < BATCH * 8; v += G) {
        const int b = v >> 3, h = v & 7, rowb = b * SEQ;
        const float sinkterm = __builtin_amdgcn_exp2f(sinks[h] * 1.4426950408889634f);
#define A2_ISSUE(it, sl) do { const int blk_ = ri_blk(it); const bf16* kb_ = PROJ + (size_t)(rowb + 128 * blk_) * NPROJ + ((it).ph == 0 ? COL_KB + h * 64 : COL_KA + (h >> 2) * 64); \
        const bf16* vb_ = PROJ + (size_t)(rowb + 128 * blk_) * NPROJ + ((it).ph == 0 ? COL_VB + h * 64 : COL_VA + (h >> 2) * 64); \
        _Pragma("unroll") for (int j_ = 0; j_ < 2; ++j_) { \
            __builtin_amdgcn_global_load_lds((const unsigned*)(kb_ + offK[j_]), (LAS unsigned*)(lds + (sl) * A2_SLOT + (2 * wave + j_) * 1024), 16, 0, 0); \
            __builtin_amdgcn_global_load_lds((const unsigned*)(vb_ + offV[j_]), (LAS unsigned*)(lds + (sl) * A2_SLOT + 16384 + (2 * wave + j_) * 1024), 16, 0, 0); } } while (0)
        RIter cons = {0, 0, 0}, iss = {0, 0, 0};
        if (mode != 2) A2_ISSUE(iss, 0); ri_next(iss); if (mode != 2) A2_ISSUE(iss, 1); ri_next(iss);
        int slot = 0, islot = 2;
        a_bf16x8 qf[4]; a_f32x16 o0 = {}, o1 = {}; float lsum = 0.f;
#pragma unroll
        for (int s = 0; s < 4; ++s) qf[s] = (a_bf16x8){0, 0, 0, 0, 0, 0, 0, 0};
        for (int round = 0; round < A2_NROUNDS; ++round) {
            if (round + 1 < A2_NROUNDS) A2_WAIT_V(4); else A2_WAIT_V(0);
            __builtin_amdgcn_s_barrier(); asm volatile("" ::: "memory");
            if (iss.ph < 2) { if (mode != 2) A2_ISSUE(iss, islot); ri_next(iss); }
            islot = (islot == 2) ? 0 : islot + 1;
            const bool isB = cons.ph == 0;
            const int cw = isB ? 2 * cons.p + grp : 8 * cons.p + wave;
            const int blk = ri_blk(cons);
            const int nr = isB ? 2 * cons.p + 2 : ((cons.p == 0) ? 2 : 3);
            const bool first = cons.k == 0, last = isB ? (blk == cw) : (cons.k == nr - 1);
            const int qrow0 = isB ? rowb + 128 * cw + r : rowb + 32 * cw, qrs = isB ? 4 : 1;
            if (first && mode != 1) {
                const bf16* qp = PROJ + (size_t)(qrow0 + i * qrs) * NPROJ + (isB ? COL_QB : COL_QA) + h * 64 + 8 * hh;
#pragma unroll
                for (int s = 0; s < 4; ++s) qf[s] = *(const a_bf16x8*)(qp + 16 * s);
#pragma unroll
                for (int s = 0; s < 4; ++s) asm volatile("" : "+v"(qf[s]));
                o0 = (a_f32x16){}; o1 = (a_f32x16){}; lsum = 0.f;
            }
            const int sbo = slot * A2_SLOT;
            if (mode != 1) {
            if (isB && blk <= cw) {
                const int d = cw - blk;
                int ka[4];
#pragma unroll
                for (int s = 0; s < 4; ++s) ka[s] = k1[s] + sbo;
                a_f32x16 S;
                if (d >= 5) { A2_CHAIN(S, c1R, ka); }
                else if (d >= 1 && d <= 3) { A2_CHAIN(S, c1F, ka); }
                else { const int Dt = 32 * d + i - 4 * hh; a_f32x16 C;
                    if (d == 0) {
#pragma unroll
                        for (int q = 0; q < 16; ++q) C[q] = (A2_OFFQ(q) <= Dt) ? c1F[q] : NINF;
                    } else {
#pragma unroll
                        for (int q = 0; q < 16; ++q) C[q] = (A2_OFFQ(q) >= Dt - 128) ? c1F[q] : c1R[q];
                    }
                    A2_CHAIN(S, C, ka); }
                const int vb0 = v1[0] + sbo, vb1 = v1[1] + sbo;
#define A2_VA1(dh, sp, e) (((dh) ? vb1 : vb0) + (sp) * 8192 + (e) * 4096)
                A2_TAIL(S, A2_VA1);
#undef A2_VA1
            }
            int t2lo, t2hi;
            if (isB) { t2lo = 0; t2hi = (blk == cw || blk == cw - 1) ? 4 : 0; }
            else { const int t0 = 4 * blk; t2lo = (cw - 4 - t0) > 0 ? (cw - 4 - t0) : 0; t2hi = (cw - t0 + 1) < 4 ? (cw - t0 + 1) : 4; }
            for (int t2 = t2lo; t2 < t2hi; ++t2) {
                const int tbo = sbo + t2 * 4096;
                int ka[4];
#pragma unroll
                for (int s = 0; s < 4; ++s) ka[s] = ((t2 & 1) ? ko[s] : ke[s]) + tbo;
                int D0, qst, maxd, kind;
                if (isB) { const int kt2 = ((blk == cw) ? 4 : 0) + t2; D0 = 128 + r - 32 * kt2; qst = 4; maxd = 128; kind = (kt2 < 4) ? 1 : 2; }
                else { D0 = 32 * (cw - (4 * blk + t2)); qst = 1; maxd = 127; kind = (D0 == 128) ? 1 : ((D0 == 0) ? 2 : 0); }
                const int Dt = D0 + qst * i - 4 * hh;
                a_f32x16 S;
                if (kind == 0) { a_f32x16 Z = {}; A2_CHAIN(S, Z, ka); }
                else { a_f32x16 C;
                    if (kind == 1) {
#pragma unroll
                        for (int q = 0; q < 16; ++q) C[q] = (A2_OFFQ(q) >= Dt - maxd) ? 0.0f : NINF;
                    } else {
#pragma unroll
                        for (int q = 0; q < 16; ++q) C[q] = (A2_OFFQ(q) <= Dt) ? 0.0f : NINF;
                    }
                    A2_CHAIN(S, C, ka); }
                const int vx0 = v2[0] + tbo, vx1 = v2[1] + tbo, vx2 = v2[2] + tbo, vx3 = v2[3] + tbo;
#define A2_VA2(dh, sp, e) (((dh) ? ((e) ? vx3 : vx2) : ((e) ? vx1 : vx0)) + (sp) * 2048)
                A2_TAIL(S, A2_VA2);
#undef A2_VA2
            }
            }
            if (last && mode != 1) {
                const float ltot = lsum + __shfl_xor(lsum, 32) + (isB ? 0.f : sinkterm);
                const float rl = 1.0f / ltot;
#pragma unroll
                for (int g = 0; g < 4; ++g) {
                    typedef unsigned u32x2_t __attribute__((ext_vector_type(2)));
                    u32x2_t a, b2;
                    a.x = a_cvtpk(o0[4 * g] * rl, o0[4 * g + 1] * rl); a.y = a_cvtpk(o0[4 * g + 2] * rl, o0[4 * g + 3] * rl);
                    b2.x = a_cvtpk(o1[4 * g] * rl, o1[4 * g + 1] * rl); b2.y = a_cvtpk(o1[4 * g + 2] * rl, o1[4 * g + 3] * rl);
                    *(LAS u32x2_t*)(stg + i * ATT_STG_PITCH + (8 * g + 4 * hh) * 2) = a;
                    *(LAS u32x2_t*)(stg + i * ATT_STG_PITCH + (32 + 8 * g + 4 * hh) * 2) = b2;
                }
                const int ocol = isB ? 512 + h * 64 : h * 64;
#pragma unroll
                for (int jj = 0; jj < 4; ++jj) { const int row = jj * 8 + (lane >> 3), ch = lane & 7;
                    const v4u vv = *(LAS const v4u*)(stg + row * ATT_STG_PITCH + ch * 16);
                    if (mode == 0) *(v4u*)(MIX + (size_t)(qrow0 + row * qrs) * D + ocol + ch * 8) = vv; else asm volatile("" :: "v"(vv)); }
            }
            slot = (slot == 2) ? 0 : slot + 1; ri_next(cons);
        }
        A2_WAIT_V(0); __builtin_amdgcn_s_barrier(); asm volatile("" ::: "memory");
#undef A2_ISSUE
    }
#undef A2_WAIT_V
#undef A2_OFFQ
#undef A2_CHAIN
#undef A2_TAIL
}

struct Args { const float* in[13]; float* out; unsigned char* ws; int ph_lo, ph_hi, li, pad; };
__global__ void __launch_bounds__(NWAVES * 64, 2) hymba_fwd(Args args) {
    extern __shared__ __attribute__((aligned(16))) unsigned char lds[];
    LAS unsigned char* L = (LAS unsigned char*)lds;
    volatile LAS unsigned* MISC = (volatile LAS unsigned*)(L + MISC_OFF);
    const int tid = threadIdx.x, lane = tid & 63, wave = __builtin_amdgcn_readfirstlane(tid >> 6);
    const int G = gridDim.x; const int bx = blockIdx.x; const int vcu = (G % 8 == 0) ? (bx % 8) * (G / 8) + bx / 8 : bx;
    unsigned char* ws = args.ws;
    gu32* ctl = (gu32*)(ws + WS_CTL);
    const float* x = args.in[0]; const int* positions = (const int*)args.in[1]; const float* g_attn = args.in[2]; const float* w_in = args.in[3];
    const float* gqa = args.in[4]; const float* gka = args.in[5]; const float* sinks = args.in[6]; const float* gqb = args.in[7]; const float* gkb = args.in[8];
    const float* w_out = args.in[9]; const float* g_mlp = args.in[10]; const float* w_up = args.in[11]; const float* w_dn = args.in[12];
    float* out = args.out;
    bf16* Win_t = (bf16*)(ws + WS_WIN); bf16* Wout_t = (bf16*)(ws + WS_WOUT); bf16* Wup_t = (bf16*)(ws + WS_WUP); bf16* Wdn_t = (bf16*)(ws + WS_WDN);
    float* rope = (float*)(ws + WS_ROPE); float* ssp = (float*)(ws + WS_SS);
    bf16* XN = (bf16*)(ws + WS_XN); bf16* PROJ = (bf16*)(ws + WS_PROJ); bf16* MIXB = (bf16*)(ws + WS_MIX); bf16* HID = (bf16*)(ws + WS_HID);
    for (int u = tid; u < (LDS_BYTES - LDSCTL_OFF) / 4; u += NWAVES * 64) ((LAS unsigned*)(L + LDSCTL_OFF))[u] = 0u;
    __syncthreads();
    const int bli = (N_LAUNCHES == PER_PHASE) ? 0 : args.li;
    XcdBarrier bar; bar.bar = (unsigned*)(ctl + CW_BAR) + bli * XCD_BAR_WORDS; bar.x = 0; bar.st = nullptr;
    if (N_LAUNCHES != PER_PHASE) bar = xcd_barrier_post((unsigned*)(ctl + CW_BAR) + bli * XCD_BAR_WORDS, MISC + 8);
#define GRID_BAR(seam) do { if (N_LAUNCHES == PER_PHASE) { if (tid == 0) __hip_atomic_store(ctl + CW_TMO, 0xBADBA0u | (unsigned)(seam), RLX_AGENT); } else { xcd_barrier(bar); } } while (0)
    const int lo = args.ph_lo, hi = args.ph_hi;
#define IN(k) (lo <= (k) && (k) < hi)
#define BOTH(k) (IN(k) && IN((k) + 1))

    if (IN(0)) { REP(0) {
        LAS float* scr = (LAS float*)(L + RING_OFF + wave * 16384);
        const int gw = vcu * NWAVES + wave, NGW = G * NWAVES;
        constexpr int I_IN = (D / 64) * (NPROJ / 32), I_OUT = (D / 64) * (D / 32), I_UP = (D / 64) * (FF / 32), I_DN = (FF / 64) * (D / 32);
        constexpr int NITEMS = I_IN + I_OUT + I_UP + I_DN;
        for (int it = gw; it < NITEMS; it += NGW) {
            int r = it;
            if (r < I_IN) { p0_transpose_item(w_in, D, NPROJ, Win_t, nullptr, scr, r, lane); continue; } r -= I_IN;
            if (r < I_OUT) { p0_transpose_item(w_out, D, D, Wout_t, nullptr, scr, r, lane); continue; } r -= I_OUT;
            if (r < I_UP) { p0_transpose_item(w_up, D, FF, Wup_t, g_mlp, scr, r, lane); continue; } r -= I_UP;
            p0_transpose_item(w_dn, FF, D, Wdn_t, nullptr, scr, r, lane);
        }
        for (int m = gw; m < M; m += NGW) rms_row_to_bf16(x + (size_t)m * D, g_attn, XN + (size_t)m * D, lane);
        for (int it = gw * 64 + lane; it < M * 8; it += NGW * 64) {
            const int m = it >> 3, i = it & 7;
            const float inv_freq = (i == 0) ? 1.0f : (i == 1) ? 0.193922743f : (i == 2) ? 0.0376060307f : (i == 3) ? 0.00729266461f : (i == 4) ? 0.00141421356f : (i == 5) ? 0.000274248188f : (i == 6) ? 5.3182961e-05f : 1.03133862e-05f;
            const float ang = (float)positions[m] * inv_freq;
            double rev = (double)ang * 0.15915494309189535; rev -= __builtin_floor(rev);
            const float rf = (float)rev;
            rope[(size_t)m * 16 + i] = __builtin_amdgcn_cosf(rf); rope[(size_t)m * 16 + 8 + i] = __builtin_amdgcn_sinf(rf);
        }
        }
        if (BOTH(0)) GRID_BAR(0);
    }
    if (IN(1)) {
        pg8::Gemm g{XN, Win_t, M, NPROJ, D}; pg8::StaticOrder S; S.init(M, NPROJ, G, (int)blockIdx.x);
        pg8::EpiQKV E{PROJ, NPROJ, gqa, gka, gqb, gkb, rope};
        REP(1) pg8::gemm_phase<pg8::EpiQKV, pg8::StaticOrder, true>(L + RING_OFF, g, S, E);
        if (BOTH(1)) GRID_BAR(1);
    }
    if (IN(2)) {
#if defined(NAIVE_ATTN)
        attn_naive(PROJ, MIXB, gqa, gka, gqb, gkb, sinks, vcu * (NWAVES * 64) + tid, G * NWAVES * 64);
#else
#if defined(ATTN_V1)
        REP(2) attn_phase(PROJ, MIXB, gqa, gka, gqb, gkb, sinks, L + RING_OFF, vcu, G, wave, lane);
#else
        REP(2) attn_phase2(PROJ, MIXB, sinks, L + RING_OFF, vcu, G, wave, lane, rep_ == 0 ? 0 : PROBE_MODE);
#endif
#endif
        if (BOTH(2)) GRID_BAR(2);
    }
    if (IN(3)) {
        pg8::Gemm g{MIXB, Wout_t, M, D, D}; pg8::StaticOrder S; S.init(M, D, G, (int)blockIdx.x);
        pg8::EpiOut E{x, out, XN, ssp, D};
        REP(3) pg8::gemm_phase<pg8::EpiOut, pg8::StaticOrder, true>(L + RING_OFF, g, S, E);
        if (BOTH(3)) GRID_BAR(3);
    }
    if (IN(4)) {
        pg8::Gemm g{XN, Wup_t, M, FF, D}; pg8::StaticOrder S; S.init(M, FF, G, (int)blockIdx.x);
        pg8::EpiUp E{ssp, HID, FF, 1.0f / D, RMS_EPS};
        REP(4) pg8::gemm_phase<pg8::EpiUp, pg8::StaticOrder, true>(L + RING_OFF, g, S, E);
        if (BOTH(4)) GRID_BAR(4);
    }
    if (IN(5)) {
        pg8::Gemm g{HID, Wdn_t, M, D, FF}; pg8::StaticOrder S; S.init(M, D, G, (int)blockIdx.x);
        pg8::EpiDown E{out, D};
        pg8::gemm_phase<pg8::EpiDown, pg8::StaticOrder, true>(L + RING_OFF, g, S, E);
    }
#undef IN
#undef BOTH
}

extern "C" void kernel_launch(void* const* d_in, const int* in_sizes, int n_in, void* d_out, int out_size, void* d_ws, size_t ws_size, hipStream_t stream) {
    static int grid = 0;
    if (grid == 0) {
        if (n_in != 13 || in_sizes[0] != M * D || out_size != M * D || ws_size < WS_END) { fprintf(stderr, "kernel_launch: shape/workspace mismatch (n_in %d in0 %d out %d ws %zu); nothing launched\n", n_in, n_in > 0 ? in_sizes[0] : -1, out_size, ws_size); grid = -1; return; }
        int dev = 0, cus = 0, per_cu = 0;
        if (hipGetDevice(&dev) != hipSuccess || hipDeviceGetAttribute(&cus, hipDeviceAttributeMultiprocessorCount, dev) != hipSuccess) { fprintf(stderr, "kernel_launch: device query failed\n"); grid = -1; return; }
        if (hipFuncSetAttribute((const void*)hymba_fwd, hipFuncAttributeMaxDynamicSharedMemorySize, LDS_BYTES) != hipSuccess) { fprintf(stderr, "kernel_launch: hipFuncSetAttribute failed\n"); grid = -1; return; }
        if (hipOccupancyMaxActiveBlocksPerMultiprocessor(&per_cu, (const void*)hymba_fwd, NWAVES * 64, LDS_BYTES) != hipSuccess || per_cu < 1)
            fprintf(stderr, "kernel_launch: note: occupancy query reports %d workgroups per CU\n", per_cu);
        (void)hipGetLastError();
        grid = cus;
    }
    if (grid < 0) return;
    if (hipMemsetAsync((char*)d_ws + WS_CTL, 0, CTL_ZERO_BYTES, stream) != hipSuccess) { fprintf(stderr, "kernel_launch: hipMemsetAsync failed\n"); return; }
    Args a{};
    for (int i = 0; i < 13; ++i) a.in[i] = (const float*)d_in[i];
    a.out = (float*)d_out; a.ws = (unsigned char*)d_ws;
    static_assert(N_LAUNCHES == 1 || N_LAUNCHES == PER_PHASE, "MK_N_LAUNCHES must be 1 or 6");
    for (int li = 0; li < N_LAUNCHES; ++li) {
        a.ph_lo = (N_LAUNCHES == PER_PHASE) ? li : 0; a.ph_hi = (N_LAUNCHES == PER_PHASE) ? li + 1 : PER_PHASE; a.li = li;
        hipLaunchKernelGGL(hymba_fwd, dim3(grid), dim3(NWAVES * 64), LDS_BYTES, stream, a);
        const hipError_t le = hipPeekAtLastError();
        if (le != hipSuccess) { fprintf(stderr, "kernel_launch: launch %d failed: %s\n", li, hipGetErrorName(le)); break; }
    }
}
```

```cpp
#include <hip/hip_runtime.h>
#include <cstdio>
#include <cstdint>

#ifndef MK_N_LAUNCHES
#define MK_N_LAUNCHES 1
#endif
#ifndef REPEAT_MASK
#define REPEAT_MASK 0
#endif
#ifndef PROBE_MODE
#define PROBE_MODE 0
#endif
#define REP(k) for (int rep_ = 0; rep_ < 1 + ((REPEAT_MASK >> (k)) & 1); ++rep_)

namespace pg8 {
#define PG8_LAS __attribute__((address_space(3)))
typedef unsigned short bf16_t;
typedef short bf16x8 __attribute__((ext_vector_type(8)));
typedef float f32x4 __attribute__((ext_vector_type(4)));
typedef unsigned u32x4 __attribute__((ext_vector_type(4)));
constexpr int BM = 256, BK = 64, HALF = 128, HTB = HALF * BK * 2  , STAGE_BYTES = 8 * HTB, NXCD = 8, WGM = 8;

__host__ __device__ __forceinline__ int lds_byte(int r, int c) { const int st = (r >> 4) * 2 + (c >> 5), rr = r & 15, cc = c & 31, ob = rr * 64 + cc * 2; return st * 1024 + (ob ^ (((ob >> 9) & 1) << 5)); }
__host__ __device__ __forceinline__ void stage_rc(int b, int& R, int& C) { const int st = b / 1024, sb = b % 1024, swz = sb ^ (((sb >> 9) & 1) << 5); R = (st >> 1) * 16 + swz / 64; C = (st & 1) * 32 + (swz % 64) / 2; }
__host__ __device__ __forceinline__ int perm32(int rho) { const int n = rho >> 4, i = rho & 15; return 8 * (i >> 2) + 4 * n + (i & 3); }

struct Unit { int pm, pn; };
struct Gemm { const bf16_t* A; const bf16_t* Bt; int M, N, K; };

struct StaticOrder {
    int nM, nN, nwg, G, c;
    __host__ __device__ void init(int M, int N, int G_, int c_) { nM = M / BM; nN = N / BM; nwg = nM * nN; G = G_; c = c_; }
    __host__ __device__ bool next(int i, Unit& u) const {
        const long L = (long)i * G + c; if (L >= nwg) return false;
        int wgid = (int)L; { const int q = nwg / NXCD, r = nwg % NXCD, xcd = wgid % NXCD, off = wgid / NXCD; wgid = (xcd < r ? xcd * (q + 1) : r * (q + 1) + (xcd - r) * q) + off; }
        const int nig = WGM * nN, gid = wgid / nig, fm = gid * WGM, gsz = (nM - fm) < WGM ? (nM - fm) : WGM;
        u.pm = fm + ((wgid % nig) % gsz); u.pn = (wgid % nig) / gsz; return true;
    }
};

__device__ __forceinline__ unsigned cvt_pk_bf16(float lo, float hi) { unsigned r; asm volatile("v_cvt_pk_bf16_f32 %0, %1, %2" : "=v"(r) : "v"(lo), "v"(hi)); return r; }

constexpr float QK_EPS = 1e-6f;
constexpr float C2 = 0.125f * 1.4426950408889634f;

struct EpiQKV {
    bf16_t* O; int ldc; const float* gqa; const float* gka; const float* gqb; const float* gkb; const float* rope;
    __device__ __forceinline__ void operator()(const f32x4 (&acc)[2][2][4][2], const Unit& u, int wr, int wc, int fr, int fq) const {
        const int pn = u.pn; int mode = 0; const float* g = gqa;
        if (pn < 2) { mode = 1; g = gqa; } else if (pn == 2) { if (wc < 2) { mode = 2; g = gka; } } else if (pn < 5) { mode = 1; g = gqb; } else if (pn < 7) { mode = 2; g = gkb; }
        const int row0 = u.pm * BM + wr * 64 + fr, col0 = pn * BM + wc * 64 + 8 * fq;
        if (mode == 0) {
#pragma unroll
            for (int ai = 0; ai < 2; ++ai)
#pragma unroll
                for (int m = 0; m < 4; ++m) { bf16_t* rowp = O + (size_t)(row0 + ai * HALF + m * 16) * ldc + col0;
#pragma unroll
                    for (int bj = 0; bj < 2; ++bj) { const f32x4 v0 = acc[ai][bj][m][0], v1 = acc[ai][bj][m][1]; u32x4 w;
                        w.x = cvt_pk_bf16(v0[0], v0[1]); w.y = cvt_pk_bf16(v0[2], v0[3]); w.z = cvt_pk_bf16(v1[0], v1[1]); w.w = cvt_pk_bf16(v1[2], v1[3]);
                        *(u32x4*)(rowp + bj * 32) = w; } }
            return;
        }
        f32x4 gv[2][2];
#pragma unroll
        for (int bj = 0; bj < 2; ++bj)
#pragma unroll
            for (int n = 0; n < 2; ++n) gv[bj][n] = *(const f32x4*)(g + 32 * bj + 8 * fq + 4 * n);
        const float sc = (mode == 1) ? C2 : 1.0f;
        const float sgn = (fq == 0) ? -1.0f : 1.0f;
#pragma unroll
        for (int ai = 0; ai < 2; ++ai)
#pragma unroll
            for (int m = 0; m < 4; ++m) {
                const int row = row0 + ai * HALF + m * 16;
                float ss = 0.f;
#pragma unroll
                for (int bj = 0; bj < 2; ++bj)
#pragma unroll
                    for (int n = 0; n < 2; ++n) { const f32x4 x = acc[ai][bj][m][n]; ss += (x[0] * x[0] + x[1] * x[1]) + (x[2] * x[2] + x[3] * x[3]); }
                ss += __shfl_xor(ss, 16); ss += __shfl_xor(ss, 32);
                const float rs = __builtin_amdgcn_rsqf(ss * (1.0f / 64.0f) + QK_EPS);
                f32x4 y[2][2];
#pragma unroll
                for (int bj = 0; bj < 2; ++bj)
#pragma unroll
                    for (int n = 0; n < 2; ++n) y[bj][n] = acc[ai][bj][m][n] * rs * gv[bj][n];
                const f32x4 c0 = *(const f32x4*)(rope + (size_t)row * 16), c1 = *(const f32x4*)(rope + (size_t)row * 16 + 4);
                const f32x4 s0 = *(const f32x4*)(rope + (size_t)row * 16 + 8), s1 = *(const f32x4*)(rope + (size_t)row * 16 + 12);
                f32x4 p0, p1;
#pragma unroll
                for (int e = 0; e < 4; ++e) { p0[e] = __shfl_xor(y[0][0][e], 16); p1[e] = __shfl_xor(y[0][1][e], 16); }
                if (fq < 2) { y[0][0] = y[0][0] * c0 + p0 * s0 * sgn; y[0][1] = y[0][1] * c1 + p1 * s1 * sgn; }
                bf16_t* rowp = O + (size_t)row * ldc + col0;
#pragma unroll
                for (int bj = 0; bj < 2; ++bj) { const f32x4 v0 = y[bj][0] * sc, v1 = y[bj][1] * sc; u32x4 w;
                    w.x = cvt_pk_bf16(v0[0], v0[1]); w.y = cvt_pk_bf16(v0[2], v0[3]); w.z = cvt_pk_bf16(v1[0], v1[1]); w.w = cvt_pk_bf16(v1[2], v1[3]);
                    *(u32x4*)(rowp + bj * 32) = w; }
            }
    }
};

struct EpiOut {
    const float* x; bf16_t* hb; float* ssp; int ldc;
    __device__ __forceinline__ void operator()(const f32x4 (&acc)[2][2][4][2], const Unit& u, int wr, int wc, int fr, int fq) const {
        const int row0 = u.pm * BM + wr * 64 + fr, col0 = u.pn * BM + wc * 64 + 8 * fq;
#pragma unroll
        for (int ai = 0; ai < 2; ++ai)
#pragma unroll
            for (int m = 0; m < 4; ++m) {
                const int row = row0 + ai * HALF + m * 16; const size_t off = (size_t)row * ldc + col0; float ss = 0.f;
#pragma unroll
                for (int bj = 0; bj < 2; ++bj) {
                    const f32x4 x0 = *(const f32x4*)(x + off + bj * 32), x1 = *(const f32x4*)(x + off + bj * 32 + 4);
                    const f32x4 v0 = acc[ai][bj][m][0] + x0, v1 = acc[ai][bj][m][1] + x1;
                    u32x4 w; w.x = cvt_pk_bf16(v0[0], v0[1]); w.y = cvt_pk_bf16(v0[2], v0[3]); w.z = cvt_pk_bf16(v1[0], v1[1]); w.w = cvt_pk_bf16(v1[2], v1[3]);
                    *(u32x4*)(hb + off + bj * 32) = w;
                    ss += (v0[0] * v0[0] + v0[1] * v0[1]) + (v0[2] * v0[2] + v0[3] * v0[3]) + (v1[0] * v1[0] + v1[1] * v1[1]) + (v1[2] * v1[2] + v1[3] * v1[3]);
                }
                ss += __shfl_xor(ss, 16); ss += __shfl_xor(ss, 32);
                if (fq == 0) ssp[(size_t)row * 16 + u.pn * 4 + wc] = ss;
            }
    }
};

struct EpiUp {
    const float* ssp; bf16_t* hid; int ldc; float inv_n, eps;
    __device__ __forceinline__ void operator()(const f32x4 (&acc)[2][2][4][2], const Unit& u, int wr, int wc, int fr, int fq) const {
        const int row0 = u.pm * BM + wr * 64 + fr, col0 = u.pn * BM + wc * 64 + 8 * fq;
#pragma unroll
        for (int ai = 0; ai < 2; ++ai)
#pragma unroll
            for (int m = 0; m < 4; ++m) {
                const int row = row0 + ai * HALF + m * 16;
                const f32x4 a = *(const f32x4*)(ssp + (size_t)row * 16), b = *(const f32x4*)(ssp + (size_t)row * 16 + 4), c = *(const f32x4*)(ssp + (size_t)row * 16 + 8), d = *(const f32x4*)(ssp + (size_t)row * 16 + 12);
                const f32x4 t = (a + b) + (c + d); const float ss = (t[0] + t[1]) + (t[2] + t[3]);
                const float rs = __builtin_amdgcn_rsqf(ss * inv_n + eps);
                bf16_t* rowp = hid + (size_t)row * ldc + col0;
#pragma unroll
                for (int bj = 0; bj < 2; ++bj) { f32x4 v0 = acc[ai][bj][m][0] * rs, v1 = acc[ai][bj][m][1] * rs;
#pragma unroll
                    for (int e = 0; e < 4; ++e) { const float r0 = __builtin_fmaxf(v0[e], 0.f), r1 = __builtin_fmaxf(v1[e], 0.f); v0[e] = r0 * r0; v1[e] = r1 * r1; }
                    u32x4 w; w.x = cvt_pk_bf16(v0[0], v0[1]); w.y = cvt_pk_bf16(v0[2], v0[3]); w.z = cvt_pk_bf16(v1[0], v1[1]); w.w = cvt_pk_bf16(v1[2], v1[3]);
                    *(u32x4*)(rowp + bj * 32) = w; }
            }
    }
};

struct EpiDown {
    const bf16_t* hb; float* out; int ldc;
    __device__ __forceinline__ void operator()(const f32x4 (&acc)[2][2][4][2], const Unit& u, int wr, int wc, int fr, int fq) const {
        const int row0 = u.pm * BM + wr * 64 + fr, col0 = u.pn * BM + wc * 64 + 8 * fq;
#pragma unroll
        for (int ai = 0; ai < 2; ++ai)
#pragma unroll
            for (int m = 0; m < 4; ++m) {
                const size_t off = (size_t)(row0 + ai * HALF + m * 16) * ldc + col0;
#pragma unroll
                for (int bj = 0; bj < 2; ++bj) {
                    const u32x4 hw = *(const u32x4*)(hb + off + bj * 32);
                    const f32x4 h0 = {__uint_as_float(hw.x << 16), __uint_as_float(hw.x & 0xffff0000u), __uint_as_float(hw.y << 16), __uint_as_float(hw.y & 0xffff0000u)};
                    const f32x4 h1 = {__uint_as_float(hw.z << 16), __uint_as_float(hw.z & 0xffff0000u), __uint_as_float(hw.w << 16), __uint_as_float(hw.w & 0xffff0000u)};
                    *(f32x4*)(out + off + bj * 32) = h0 + acc[ai][bj][m][0]; *(f32x4*)(out + off + bj * 32 + 4) = h1 + acc[ai][bj][m][1];
                }
            }
    }
};

template <class Epi, class Sched, bool ALIGN_EPI>
__device__ __forceinline__ void gemm_phase(PG8_LAS unsigned char* lds, const Gemm g, const Sched& S, const Epi& E) {
    const int tid = threadIdx.x, wid = __builtin_amdgcn_readfirstlane(tid >> 6), lane = tid & 63, wr = wid >> 2, wc = wid & 3, fr = lane & 15, fq = lane >> 4;
    const int K = g.K, nt = K / BK;
    unsigned voffA[2], voffB[2];
#pragma unroll
    for (int i = 0; i < 2; ++i) { int R, C; stage_rc(tid * 16 + i * 8192, R, C); const int Rb = (R >> 5) * 64 + perm32(R & 31);
        voffA[i] = (unsigned)(R * K + C) * 2u; voffB[i] = (unsigned)(Rb * K + C) * 2u; }
    const size_t kstep = (size_t)(BK * 2);
    const size_t hstepA = (size_t)HALF * K * 2;
    const size_t hstepB = (size_t)32 * K * 2;
    const size_t tstep = (size_t)BM * K * 2;
    const unsigned ldsw = (unsigned)wid * 1024u;
    const int aoff = lds_byte(wr * 64 + fr, fq * 8), boff = lds_byte(wc * 32 + fr, fq * 8);
#define PG8_SA(b, h) (((b) * 2 + (h)) * HTB)
#define PG8_SB(b, h) ((4 + (b) * 2 + (h)) * HTB)
#define PG8_STAGE(bufoff, gbase, voff) do { _Pragma("unroll") for (int _i = 0; _i < 2; ++_i) \
        __builtin_amdgcn_global_load_lds((const unsigned*)((const char*)(gbase) + (voff)[_i]), (PG8_LAS unsigned*)(lds + (bufoff) + ldsw + _i * 8192), 16, 0, 0); } while (0)
#define PG8_LDA(dst, b, h) do { _Pragma("unroll") for (int m = 0; m < 4; ++m) _Pragma("unroll") for (int k = 0; k < 2; ++k) dst[m][k] = *(const PG8_LAS bf16x8*)(lds + PG8_SA(b, h) + aoff + m * 2048 + k * 1024); } while (0)
#define PG8_LDB(dst, b, h) do { _Pragma("unroll") for (int n = 0; n < 2; ++n) _Pragma("unroll") for (int k = 0; k < 2; ++k) dst[n][k] = *(const PG8_LAS bf16x8*)(lds + PG8_SB(b, h) + boff + n * 2048 + k * 1024); } while (0)
#define PG8_MMA(ai, bj, At, Bt) do { __builtin_amdgcn_s_setprio(1); _Pragma("unroll") for (int m = 0; m < 4; ++m) _Pragma("unroll") for (int n = 0; n < 2; ++n) _Pragma("unroll") for (int k = 0; k < 2; ++k) \
        acc[ai][bj][m][n] = __builtin_amdgcn_mfma_f32_16x16x32_bf16(Bt[n][k], At[m][k], acc[ai][bj][m][n], 0, 0, 0); __builtin_amdgcn_s_setprio(0); } while (0)
#define PG8_WAIT_V(n) asm volatile("s_waitcnt vmcnt(" #n ")" ::: "memory")
#define PG8_WAIT_L(n) asm volatile("s_waitcnt lgkmcnt(" #n ")" ::: "memory")
#define PG8_BAR __builtin_amdgcn_s_barrier()
#define PG8_SCHED __builtin_amdgcn_sched_barrier(0)
    Unit cur, nxt; int ui = 0;
    if (!S.next(0, cur)) return;
    f32x4 acc[2][2][4][2];
#pragma unroll
    for (int a = 0; a < 2; ++a)
#pragma unroll
        for (int b = 0; b < 2; ++b)
#pragma unroll
            for (int m = 0; m < 4; ++m)
#pragma unroll
                for (int n = 0; n < 2; ++n) acc[a][b][m][n] = (f32x4){0.f, 0.f, 0.f, 0.f};
    bf16x8 At[4][2], B0[2][2], B1[2][2];
    const char* cA = (const char*)g.A + (size_t)cur.pm * tstep; const char* cB = (const char*)g.Bt + (size_t)cur.pn * tstep;
    PG8_STAGE(PG8_SB(0, 0), cB, voffB); PG8_STAGE(PG8_SB(0, 1), cB + hstepB, voffB); PG8_STAGE(PG8_SA(0, 0), cA, voffA); PG8_STAGE(PG8_SA(0, 1), cA + hstepA, voffA);
    if (wr == 1) PG8_BAR;
    PG8_WAIT_V(2); PG8_BAR;
    PG8_STAGE(PG8_SB(1, 0), cB + kstep, voffB); PG8_STAGE(PG8_SA(1, 0), cA + kstep, voffA); PG8_STAGE(PG8_SB(1, 1), cB + hstepB + kstep, voffB);
    PG8_WAIT_V(6); PG8_BAR;
    for (;;) {
        const bool has_next = S.next(ui + 1, nxt);
        const char* nA = has_next ? (const char*)g.A + (size_t)nxt.pm * tstep : cA; const char* nB = has_next ? (const char*)g.Bt + (size_t)nxt.pn * tstep : cB;
        for (int t = 0; t < nt; t += 2) {
            const bool last = (t == nt - 2);
            const char* a1 = cA + (size_t)(t + 1) * kstep;
            const char* a2 = last ? nA : cA + (size_t)(t + 2) * kstep; const char* b2 = last ? nB : cB + (size_t)(t + 2) * kstep;
            const char* a3 = a2 + kstep; const char* b3 = b2 + kstep;
            PG8_LDB(B0, 0, 0); PG8_LDB(B1, 0, 1); PG8_SCHED; PG8_LDA(At, 0, 0); PG8_STAGE(PG8_SA(1, 1), a1 + hstepA, voffA);
            PG8_WAIT_V(8); PG8_WAIT_L(0); PG8_BAR; PG8_MMA(0, 0, At, B0); PG8_MMA(0, 1, At, B1); PG8_BAR; PG8_SCHED;
            PG8_LDA(At, 0, 1); PG8_STAGE(PG8_SB(0, 0), b2, voffB); PG8_STAGE(PG8_SB(0, 1), b2 + hstepB, voffB); PG8_STAGE(PG8_SA(0, 0), a2, voffA);
            PG8_WAIT_V(8); PG8_WAIT_L(0); PG8_BAR; PG8_MMA(1, 0, At, B0); PG8_MMA(1, 1, At, B1); PG8_BAR; PG8_SCHED;
            PG8_LDB(B0, 1, 0); PG8_LDB(B1, 1, 1); PG8_SCHED; PG8_LDA(At, 1, 0); PG8_STAGE(PG8_SA(0, 1), a2 + hstepA, voffA);
            PG8_WAIT_V(8); PG8_WAIT_L(0); PG8_BAR; PG8_MMA(0, 0, At, B0); PG8_MMA(0, 1, At, B1); PG8_BAR; PG8_SCHED;
            PG8_LDA(At, 1, 1); PG8_STAGE(PG8_SB(1, 0), b3, voffB); PG8_STAGE(PG8_SB(1, 1), b3 + hstepB, voffB); PG8_STAGE(PG8_SA(1, 0), a3, voffA);
            PG8_WAIT_V(8); PG8_WAIT_L(0); PG8_BAR; PG8_MMA(1, 0, At, B0); PG8_MMA(1, 1, At, B1); PG8_BAR; PG8_SCHED;
        }
        if constexpr (ALIGN_EPI) { if (wr == 0) PG8_BAR; }
        E(acc, cur, wr, wc, fr, fq);
        if (!has_next) break;
#pragma unroll
        for (int a = 0; a < 2; ++a)
#pragma unroll
            for (int b = 0; b < 2; ++b)
#pragma unroll
                for (int m = 0; m < 4; ++m)
#pragma unroll
                    for (int n = 0; n < 2; ++n) acc[a][b][m][n] = (f32x4){0.f, 0.f, 0.f, 0.f};
        cur = nxt; cA = nA; cB = nB; ++ui;
        if constexpr (ALIGN_EPI) { if (wr == 1) PG8_BAR; }
    }
    PG8_WAIT_V(0);
    if constexpr (!ALIGN_EPI) { if (wr == 0) PG8_BAR; }
    PG8_BAR;
#undef PG8_SA
#undef PG8_SB
#undef PG8_STAGE
#undef PG8_LDA
#undef PG8_LDB
#undef PG8_MMA
#undef PG8_WAIT_V
#undef PG8_WAIT_L
#undef PG8_BAR
#undef PG8_SCHED
}
}

constexpr int NWAVES = 8;
constexpr int BATCH = 32, SEQ = 2048, D = 1024, FF = 4096, HD = 64;
constexpr int M = BATCH * SEQ;
constexpr int NPROJ = 2304;
constexpr int COL_QA = 0, COL_KA = 512, COL_VA = 640, COL_QB = 768, COL_KB = 1280, COL_VB = 1792;
constexpr float RMS_EPS = 1e-6f;
constexpr int N_LAUNCHES = MK_N_LAUNCHES, PER_PHASE = 6;
constexpr int N_BAR_REGIONS = (MK_N_LAUNCHES == PER_PHASE) ? 1 : MK_N_LAUNCHES;

constexpr size_t MiB = 1u << 20;
constexpr size_t WS_CTL = 0, CTL_ZERO_BYTES = 1 * MiB;
constexpr size_t WS_WIN = 2 * MiB, WS_WOUT = 8 * MiB, WS_WUP = 10 * MiB, WS_WDN = 18 * MiB;
constexpr size_t WS_ROPE = 26 * MiB;
constexpr size_t WS_SS = 30 * MiB;
constexpr size_t WS_XN = 64 * MiB;
constexpr size_t WS_PROJ = 192 * MiB;
constexpr size_t WS_MIX = 480 * MiB;
constexpr size_t WS_HID = 192 * MiB;
constexpr size_t WS_END = 704 * MiB;
static_assert(WS_WIN + (size_t)NPROJ * D * 2 <= WS_WOUT && WS_WDN + (size_t)D * FF * 2 <= WS_ROPE && WS_SS + (size_t)M * 64 <= WS_XN, "d_ws map");
static_assert(WS_XN + (size_t)M * D * 2 <= WS_PROJ && WS_PROJ + (size_t)M * NPROJ * 2 <= WS_MIX && WS_MIX + (size_t)M * D * 2 <= WS_END && WS_HID + (size_t)M * FF * 2 <= WS_END, "d_ws map");
constexpr int CW_TMO = 0, CW_CODE = 1;
constexpr int CW_BAR = 4096;

constexpr int RING_OFF = 0, RING_BYTES = 131072;
constexpr int LDSCTL_OFF = 139264, MISC_OFF = LDSCTL_OFF + 320;
constexpr int LDS_BYTES = 147456;

#define GAS __attribute__((address_space(1)))
#define LAS __attribute__((address_space(3)))
typedef unsigned short bf16;
typedef unsigned v4u __attribute__((ext_vector_type(4)));
typedef float f32x4 __attribute__((ext_vector_type(4)));
typedef GAS unsigned gu32;
#define RLX_AGENT __ATOMIC_RELAXED, __HIP_MEMORY_SCOPE_AGENT
#define LDS_WAIT() asm volatile("s_waitcnt lgkmcnt(0)" ::: "memory")
#define VM_WAIT() asm volatile("s_waitcnt vmcnt(0)" ::: "memory")
__device__ __forceinline__ unsigned f2bf(float f) { unsigned u = __builtin_bit_cast(unsigned, f); return (u + 0x7fffu + ((u >> 16) & 1u)) >> 16; }
__device__ __forceinline__ unsigned pk2(float lo, float hi) { return f2bf(lo) | (f2bf(hi) << 16); }
__device__ __forceinline__ float bf_lo(unsigned u) { return __uint_as_float(u << 16); }
__device__ __forceinline__ float bf_hi(unsigned u) { return __uint_as_float(u & 0xffff0000u); }

#define XB_TMO      128
#define XB_XCNT(j)  (256  + 64 * (j))
#define XB_XSUB(j)  (1280 + 64 * (j))
#define XB_XGEN(j)  (2304 + 64 * (j))
#define XB_TOP      3328
#define XB_TOPGEN   3392
#define XCD_BAR_WORDS 3456
#define XB_SPIN_CAP (1u << 18)

__device__ __forceinline__ unsigned xb_ld(unsigned* p)              { return __hip_atomic_load(p, __ATOMIC_RELAXED, __HIP_MEMORY_SCOPE_AGENT); }
__device__ __forceinline__ unsigned xb_add(unsigned* p, unsigned v) { return __hip_atomic_fetch_add(p, v, __ATOMIC_RELAXED, __HIP_MEMORY_SCOPE_AGENT); }
__device__ __forceinline__ unsigned xb_xcc_id() { return (unsigned)__builtin_amdgcn_s_getreg((3 << 11) | 20) & 0xFu; }
#define XB_SPIN(cond, bar) do { unsigned _sp = 0; while (cond) { __builtin_amdgcn_s_sleep(1); \
    if ((++_sp & 255u) == 0u) { if (xb_ld(&(bar)[XB_TMO])) break; if (_sp > XB_SPIN_CAP) { atomicAdd(&(bar)[XB_TMO], 1u); break; } } } } while (0)

struct XcdBarrier { unsigned* bar; unsigned x; volatile LAS unsigned* st; };

__device__ __forceinline__ XcdBarrier xcd_barrier_post(unsigned* bar, volatile LAS unsigned* st) {
    XcdBarrier b; b.bar = bar; b.x = xb_xcc_id(); b.st = st;
    if (threadIdx.x == 0) (void)xb_add(&bar[XB_XCNT(b.x)], 1u);
    return b;
}
__device__ __forceinline__ void xcd_barrier_complete(unsigned* bar, unsigned x, unsigned& nloc, unsigned& nx) {
    const unsigned G = gridDim.x * gridDim.y * gridDim.z;
    unsigned sum, cnt, mine, sp = 0u;
    for (;;) {
        sum = 0u; cnt = 0u; mine = 0u;
#pragma unroll
        for (unsigned j = 0; j < 16; ++j) { const unsigned c = xb_ld(&bar[XB_XCNT(j)]); sum += c; cnt += (c > 0u) ? 1u : 0u; mine = (j == x) ? c : mine; }
        if (sum == G) break;
        __builtin_amdgcn_s_sleep(1);
        if ((++sp & 255u) == 0u) { if (xb_ld(&bar[XB_TMO])) break; if (sp > XB_SPIN_CAP) { atomicAdd(&bar[XB_TMO], 1u); break; } }
    }
    nloc = mine > 0u ? mine : 1u; nx = cnt > 0u ? cnt : 1u;
}
__device__ __forceinline__ void xcd_barrier(const XcdBarrier& b) {
    asm volatile("s_waitcnt vmcnt(0)" ::: "memory");
    __syncthreads();
    if (threadIdx.x == 0) {
        unsigned* bar = b.bar;
        __builtin_amdgcn_s_waitcnt(0);
        unsigned nloc = b.st[0], nx = b.st[1];
        if (nloc == 0u) { xcd_barrier_complete(bar, b.x, nloc, nx); b.st[0] = nloc; b.st[1] = nx; }
        const unsigned old = xb_add(&bar[XB_XSUB(b.x)], 1u);
        const unsigned gen = old / nloc;
        if (old + 1u == (gen + 1u) * nloc) {
            __builtin_amdgcn_fence(__ATOMIC_RELEASE, "agent");
            asm volatile("s_waitcnt vmcnt(0)" ::: "memory");
            const unsigned og = xb_add(&bar[XB_TOP], 1u);
            const unsigned tg = og / nx;
            if (og + 1u == (tg + 1u) * nx) xb_add(&bar[XB_TOPGEN], 1u);
            else XB_SPIN(xb_ld(&bar[XB_TOPGEN]) == tg, bar);
            __builtin_amdgcn_fence(__ATOMIC_ACQUIRE, "agent");
            xb_add(&bar[XB_XGEN(b.x)], 1u);
            asm volatile("s_waitcnt vmcnt(0)" ::: "memory");
        } else {
            XB_SPIN(xb_ld(&bar[XB_XGEN(b.x)]) == gen, bar);
            __builtin_amdgcn_fence(__ATOMIC_ACQUIRE, "agent");
            asm volatile("s_waitcnt vmcnt(0)" ::: "memory");
        }
    }
    __syncthreads();
}

__device__ __forceinline__ float wave_sum(float v) {
#pragma unroll
    for (int o = 1; o < 64; o <<= 1) v += __shfl_xor(v, o);
    return v;
}
__device__ __forceinline__ float wave_max(float v) {
#pragma unroll
    for (int o = 1; o < 64; o <<= 1) v = __builtin_fmaxf(v, __shfl_xor(v, o));
    return v;
}
__device__ __forceinline__ void p0_transpose_item(const float* W, int K, int N, bf16* WT, const float* gk, LAS float* scr, int item, int lane) {
    const int nblk = N / 32, kb = item / nblk, nb = item % nblk, k0 = 64 * kb, n0 = 32 * nb;
    float wv[32];
#pragma unroll
    for (int i = 0; i < 32; ++i) wv[i] = W[(size_t)(k0 + 2 * i + (lane >> 5)) * N + n0 + (lane & 31)];
    if (gk) {
#pragma unroll
        for (int i = 0; i < 32; ++i) wv[i] *= gk[k0 + 2 * i + (lane >> 5)]; }
#pragma unroll
    for (int i = 0; i < 32; ++i) scr[(2 * i + (lane >> 5)) * 33 + (lane & 31)] = wv[i];
    LDS_WAIT(); asm volatile("" ::: "memory");
    const int c = lane & 7;
#pragma unroll
    for (int j = 0; j < 4; ++j) { const int n = (lane >> 3) + 8 * j; const LAS float* s = scr + (8 * c) * 33 + n;
        v4u o; o.x = pk2(s[0 * 33], s[1 * 33]); o.y = pk2(s[2 * 33], s[3 * 33]); o.z = pk2(s[4 * 33], s[5 * 33]); o.w = pk2(s[6 * 33], s[7 * 33]);
        *(GAS v4u*)(WT + (size_t)(n0 + n) * K + k0 + 8 * c) = o; }
    LDS_WAIT(); asm volatile("" ::: "memory");
}
template <int NR>
__device__ __forceinline__ void rms_rows_to_bf16(const float* xrow, const float* gain, bf16* orow, int lane) {
    f32x4 v[NR][4]; float s[NR];
#pragma unroll
    for (int r = 0; r < NR; ++r) { const GAS f32x4* xr = (const GAS f32x4*)(xrow + (size_t)r * D) + lane;
#pragma unroll
        for (int j = 0; j < 4; ++j) v[r][j] = __builtin_nontemporal_load(xr + 64 * j); }
    const GAS f32x4* gr = (const GAS f32x4*)gain + lane;
    f32x4 gg[4];
#pragma unroll
    for (int j = 0; j < 4; ++j) gg[j] = gr[64 * j];
#pragma unroll
    for (int r = 0; r < NR; ++r) { s[r] = 0.f;
#pragma unroll
        for (int j = 0; j < 4; ++j) s[r] += (v[r][j].x * v[r][j].x + v[r][j].y * v[r][j].y) + (v[r][j].z * v[r][j].z + v[r][j].w * v[r][j].w); }
#pragma unroll
    for (int o = 1; o < 64; o <<= 1) {
#pragma unroll
        for (int r = 0; r < NR; ++r) s[r] += __shfl_xor(s[r], o); }
#pragma unroll
    for (int r = 0; r < NR; ++r) { const float rstd = __builtin_amdgcn_rsqf(s[r] * (1.f / D) + RMS_EPS);
        GAS unsigned long long* o8 = (GAS unsigned long long*)(orow + (size_t)r * D) + lane;
#pragma unroll
        for (int j = 0; j < 4; ++j) { const f32x4 y = v[r][j] * rstd * gg[j];
            o8[64 * j] = (unsigned long long)pk2(y.x, y.y) | ((unsigned long long)pk2(y.z, y.w) << 32); } }
}

__device__ __forceinline__ void attn_naive(const bf16* PROJ, bf16* MIX, const float* gqa, const float* gka, const float* gqb, const float* gkb, const float* sinks, int gtid, int nthr) {
    float mqa = 0.f, mka = 0.f, mqb = 0.f, mkb = 0.f;
    for (int d = 0; d < HD; ++d) { mqa = __builtin_fmaxf(mqa, __builtin_fabsf(gqa[d])); mka = __builtin_fmaxf(mka, __builtin_fabsf(gka[d])); mqb = __builtin_fmaxf(mqb, __builtin_fabsf(gqb[d])); mkb = __builtin_fmaxf(mkb, __builtin_fabsf(gkb[d])); }
    const float shiftA = pg8::C2 * 64.f * mqa * mka, shiftB = pg8::C2 * 64.f * mqb * mkb;
    for (long item = gtid; item < (long)M * 16; item += nthr) {
        const int hh = (int)(item / M), m = (int)(item % M), t = m & (SEQ - 1), rowbase = m - t;
        const bool isA = hh < 8; const int h = hh & 7;
        const int qcol = isA ? COL_QA + h * 64 : COL_QB + h * 64, kcol = isA ? COL_KA + (h >> 2) * 64 : COL_KB + h * 64, vcol = isA ? COL_VA + (h >> 2) * 64 : COL_VB + h * 64;
        const float shift = isA ? shiftA : shiftB;
        float q[64], o[64]; float l = 0.f;
        { const v4u* qp = (const v4u*)(PROJ + (size_t)m * NPROJ + qcol);
#pragma unroll
          for (int c = 0; c < 8; ++c) { const v4u u = qp[c]; q[8 * c + 0] = bf_lo(u.x); q[8 * c + 1] = bf_hi(u.x); q[8 * c + 2] = bf_lo(u.y); q[8 * c + 3] = bf_hi(u.y); q[8 * c + 4] = bf_lo(u.z); q[8 * c + 5] = bf_hi(u.z); q[8 * c + 6] = bf_lo(u.w); q[8 * c + 7] = bf_hi(u.w); } }
#pragma unroll
        for (int d = 0; d < 64; ++d) o[d] = 0.f;
#define KEY(srow, wgt) do { const v4u* kp = (const v4u*)(PROJ + (size_t)(rowbase + (srow)) * NPROJ + kcol); float sc = 0.f; \
        _Pragma("unroll") for (int c = 0; c < 8; ++c) { const v4u u = kp[c]; sc += q[8 * c + 0] * bf_lo(u.x) + q[8 * c + 1] * bf_hi(u.x) + q[8 * c + 2] * bf_lo(u.y) + q[8 * c + 3] * bf_hi(u.y) + q[8 * c + 4] * bf_lo(u.z) + q[8 * c + 5] * bf_hi(u.z) + q[8 * c + 6] * bf_lo(u.w) + q[8 * c + 7] * bf_hi(u.w); } \
        const float p = (wgt) * __builtin_amdgcn_exp2f(sc - shift); l += p; const v4u* vp = (const v4u*)(PROJ + (size_t)(rowbase + (srow)) * NPROJ + vcol); \
        _Pragma("unroll") for (int c = 0; c < 8; ++c) { const v4u u = vp[c]; o[8 * c + 0] += p * bf_lo(u.x); o[8 * c + 1] += p * bf_hi(u.x); o[8 * c + 2] += p * bf_lo(u.y); o[8 * c + 3] += p * bf_hi(u.y); o[8 * c + 4] += p * bf_lo(u.z); o[8 * c + 5] += p * bf_hi(u.z); o[8 * c + 6] += p * bf_lo(u.w); o[8 * c + 7] += p * bf_hi(u.w); } } while (0)
        if (isA) {
            for (int dist = 0; dist <= 127 && dist <= t; ++dist) KEY(t - dist, 1.0f);
            l += __builtin_amdgcn_exp2f(sinks[h] * 1.4426950408889634f - shift);
        } else {
            for (int dist = 0; dist <= 128 && dist <= t; ++dist) { const float w = 1.0f + (((dist & 3) == 0) ? 1.0f : 0.0f) + (((dist & 15) == 0) ? 1.0f : 0.0f); KEY(t - dist, w); }
            for (int dist = 132; dist <= 512 && dist <= t; dist += 4) { const float w = 1.0f + (((dist & 15) == 0) ? 1.0f : 0.0f); KEY(t - dist, w); }
            for (int dist = 528; dist <= t; dist += 16) KEY(t - dist, 1.0f);
        }
#undef KEY
        const float rl = 1.0f / l;
        v4u* op = (v4u*)(MIX + (size_t)m * D + hh * 64);
#pragma unroll
        for (int c = 0; c < 8; ++c) { v4u u; u.x = pk2(o[8 * c + 0] * rl, o[8 * c + 1] * rl); u.y = pk2(o[8 * c + 2] * rl, o[8 * c + 3] * rl); u.z = pk2(o[8 * c + 4] * rl, o[8 * c + 5] * rl); u.w = pk2(o[8 * c + 6] * rl, o[8 * c + 7] * rl); op[c] = u; }
    }
}


typedef short a_bf16x8 __attribute__((ext_vector_type(8)));
typedef short a_s16x4 __attribute__((ext_vector_type(4)));
typedef float a_f32x16 __attribute__((ext_vector_type(16)));
typedef float a_f32x2 __attribute__((ext_vector_type(2)));
typedef __bf16 a_bf16x2 __attribute__((ext_vector_type(2)));
__device__ __forceinline__ unsigned a_cvtpk(float lo, float hi) { a_f32x2 v = {lo, hi}; a_bf16x2 b = __builtin_convertvector(v, a_bf16x2); return __builtin_bit_cast(unsigned, b); }
__device__ __forceinline__ a_s16x4 a_vtr(LAS const unsigned char* p) { return __builtin_bit_cast(a_s16x4, __builtin_amdgcn_ds_read_tr16_b64_v4i16((LAS a_s16x4*)p)); }
constexpr int ATT_WLDS = 16384;
constexpr int ATT_STG = 8192, ATT_STG_PITCH = 144;

struct AttnTask { int qrow0, qrs, qcol, kcol, vcol, n1, row1, D01, kt2lo, kt2hi, row2, D02, qstep2, maxd2, orow0, ors, ocol; float shift, sinkterm; };

__device__ __forceinline__ void attn_task(const bf16* __restrict__ PROJ, bf16* __restrict__ MIX, LAS unsigned char* wl, const int lane, const AttnTask& T) {
    const int i = lane & 31, hh = lane >> 5;
    a_bf16x8 qf[4];
    { const bf16* qp = PROJ + (size_t)(T.qrow0 + i * T.qrs) * NPROJ + T.qcol + 8 * hh;
#pragma unroll
      for (int s = 0; s < 4; ++s) qf[s] = *(const a_bf16x8*)(qp + 16 * s); }
    a_f32x16 o0 = {}, o1 = {}; float lsum = 0.f;
    const int Dl1 = T.D01 + i - 4 * hh, Dl2 = T.D02 + T.qstep2 * i - 4 * hh;
    float wg[4];
#pragma unroll
    for (int c = 0; c < 4; ++c) wg[c] = ((Dl1 & 3) == c) ? 1.0f : 0.0f;
    const int nt = T.n1 + (T.kt2hi - T.kt2lo);
    const int klane = i * NPROJ + 8 * hh, vlane = (lane >> 3) * NPROJ + (lane & 7) * 8;
    LAS unsigned char* vw = wl + ((lane & 7) >> 2) * 2048 + (lane >> 3) * 64 + (lane & 3) * 16;
    LAS const unsigned char* tra = wl + (4 * hh + ((lane & 15) >> 2)) * 64 + ((lane >> 4) & 1) * 32 + (lane & 3) * 8;
    a_f32x16 negs;
#pragma unroll
    for (int r = 0; r < 16; ++r) negs[r] = -T.shift;
    v4u kn[4]; v4u vn[4];
#define ATT_LOAD(j) do { const int seg1_ = (j) < T.n1; const int kt_ = seg1_ ? (j) : T.kt2lo + ((j) - T.n1); const int row_ = seg1_ ? T.row1 + 128 * kt_ : T.row2 + 32 * kt_; const int rs_ = seg1_ ? 4 : 1; \
        const bf16* kb_ = PROJ + (size_t)row_ * NPROJ + T.kcol + (size_t)(vlane - (lane & 7) * 8) * rs_ + (lane & 7) * 8; const bf16* vb_ = PROJ + (size_t)row_ * NPROJ + T.vcol + (size_t)(vlane - (lane & 7) * 8) * rs_ + (lane & 7) * 8; \
        _Pragma("unroll") for (int jj = 0; jj < 4; ++jj) kn[jj] = *(const v4u*)(kb_ + (size_t)(8 * jj * rs_) * NPROJ); \
        _Pragma("unroll") for (int jj = 0; jj < 4; ++jj) vn[jj] = *(const v4u*)(vb_ + (size_t)(8 * jj * rs_) * NPROJ); } while (0)
    ATT_LOAD(0);
    for (int j = 0; j < nt; ++j) {
        v4u kr[4]; v4u vr[4];
#pragma unroll
        for (int s = 0; s < 4; ++s) { kr[s] = kn[s]; vr[s] = vn[s]; }
        if (j + 1 < nt) ATT_LOAD(j + 1);
        const bool seg1 = j < T.n1; const int kt = seg1 ? j : T.kt2lo + (j - T.n1);
        const int Dt = (seg1 ? Dl1 : Dl2) - 32 * kt;
        const int D0 = (seg1 ? T.D01 : T.D02) - 32 * kt, qst = seg1 ? 1 : T.qstep2, maxd = seg1 ? 128 : T.maxd2;
        const int dpmin = D0 - 31, dpmax = D0 + 31 * qst;
        const int cls = (dpmin >= 0 && dpmax <= maxd) ? 1 : (dpmin > maxd ? 2 : 0);
#pragma unroll
        for (int jj = 0; jj < 4; ++jj) *(LAS v4u*)(vw + 512 * jj) = vr[jj];
#pragma unroll
        for (int jj = 0; jj < 4; ++jj) *(LAS v4u*)(wl + 4096 + (lane & 7) * 512 + (((8 * jj + (lane >> 3)) ^ (lane & 7)) * 16)) = kr[jj];
        a_bf16x8 kf[4];
#pragma unroll
        for (int s = 0; s < 4; ++s) kf[s] = *(LAS const a_bf16x8*)(wl + 4096 + (2 * s + hh) * 512 + ((i ^ (2 * s + hh)) * 16));
        a_f32x16 S = negs;
#pragma unroll
        for (int s = 0; s < 4; ++s) S = __builtin_amdgcn_mfma_f32_32x32x16_bf16(kf[s], qf[s], S, 0, 0, 0);
        float p[16];
        float wm[4];
#pragma unroll
        for (int c = 0; c < 4; ++c) wm[c] = seg1 ? wg[c] : 0.0f;
        if (cls == 1) {
#pragma unroll
            for (int r = 0; r < 16; ++r) p[r] = (1.0f + wm[r & 3]) * __builtin_amdgcn_exp2f(S[r]);
        } else if (cls == 2) {
#pragma unroll
            for (int r = 0; r < 16; ++r) p[r] = wm[r & 3] * __builtin_amdgcn_exp2f(S[r]);
        } else {
#pragma unroll
            for (int r = 0; r < 16; ++r) { const int dp = Dt - ((r & 3) + 8 * (r >> 2));
                const float w = (((unsigned)dp <= (unsigned)maxd) ? 1.0f : 0.0f) + ((dp >= 0) ? wm[r & 3] : 0.0f);
                p[r] = w * __builtin_amdgcn_exp2f(S[r]); }
        }
        float ls = 0.f;
#pragma unroll
        for (int r = 0; r < 16; ++r) ls += p[r];
        lsum += ls;
        a_bf16x8 pb0, pb1;
        { v4u w0, w1; w0.x = a_cvtpk(p[0], p[1]); w0.y = a_cvtpk(p[2], p[3]); w0.z = a_cvtpk(p[4], p[5]); w0.w = a_cvtpk(p[6], p[7]);
          w1.x = a_cvtpk(p[8], p[9]); w1.y = a_cvtpk(p[10], p[11]); w1.z = a_cvtpk(p[12], p[13]); w1.w = a_cvtpk(p[14], p[15]);
          pb0 = __builtin_bit_cast(a_bf16x8, w0); pb1 = __builtin_bit_cast(a_bf16x8, w1); }
        {
            a_s16x4 lo, hi;
#define ATT_VF (a_bf16x8){lo[0], lo[1], lo[2], lo[3], hi[0], hi[1], hi[2], hi[3]}
            lo = a_vtr(tra);               hi = a_vtr(tra + 512);               o0 = __builtin_amdgcn_mfma_f32_32x32x16_bf16(ATT_VF, pb0, o0, 0, 0, 0);
            lo = a_vtr(tra + 1024);        hi = a_vtr(tra + 1024 + 512);        o0 = __builtin_amdgcn_mfma_f32_32x32x16_bf16(ATT_VF, pb1, o0, 0, 0, 0);
            lo = a_vtr(tra + 2048);        hi = a_vtr(tra + 2048 + 512);        o1 = __builtin_amdgcn_mfma_f32_32x32x16_bf16(ATT_VF, pb0, o1, 0, 0, 0);
            lo = a_vtr(tra + 2048 + 1024); hi = a_vtr(tra + 2048 + 1024 + 512); o1 = __builtin_amdgcn_mfma_f32_32x32x16_bf16(ATT_VF, pb1, o1, 0, 0, 0);
#undef ATT_VF
        }
    }
#undef ATT_LOAD
    const float ltot = lsum + __shfl_xor(lsum, 32) + T.sinkterm;
    const float rl = 1.0f / ltot;
    LAS unsigned char* stg = wl + ATT_STG;
#pragma unroll
    for (int g = 0; g < 4; ++g) {
        typedef unsigned u32x2_t __attribute__((ext_vector_type(2)));
        u32x2_t a, b2;
        a.x = a_cvtpk(o0[4 * g] * rl, o0[4 * g + 1] * rl); a.y = a_cvtpk(o0[4 * g + 2] * rl, o0[4 * g + 3] * rl);
        b2.x = a_cvtpk(o1[4 * g] * rl, o1[4 * g + 1] * rl); b2.y = a_cvtpk(o1[4 * g + 2] * rl, o1[4 * g + 3] * rl);
        *(LAS u32x2_t*)(stg + i * ATT_STG_PITCH + (8 * g + 4 * hh) * 2) = a;
        *(LAS u32x2_t*)(stg + i * ATT_STG_PITCH + (32 + 8 * g + 4 * hh) * 2) = b2;
    }
#pragma unroll
    for (int jj = 0; jj < 4; ++jj) { const int row = jj * 8 + (lane >> 3), ch = lane & 7;
        const v4u v = *(LAS const v4u*)(stg + row * ATT_STG_PITCH + ch * 16);
        *(v4u*)(MIX + (size_t)(T.orow0 + row * T.ors) * D + T.ocol + ch * 8) = v; }
}

__device__ __forceinline__ void attn_phase(const bf16* PROJ, bf16* MIX, const float* gqa, const float* gka, const float* gqb, const float* gkb, const float* sinks, LAS unsigned char* lds, int vcu, int G, int wave, int lane) {
    const float mqa = wave_max(__builtin_fabsf(gqa[lane])), mka = wave_max(__builtin_fabsf(gka[lane])), mqb = wave_max(__builtin_fabsf(gqb[lane])), mkb = wave_max(__builtin_fabsf(gkb[lane]));
    const float shiftA = pg8::C2 * 64.f * mqa * mka, shiftB = pg8::C2 * 64.f * mqb * mkb;
    LAS unsigned char* wl = lds + wave * ATT_WLDS;
    for (int v = vcu; v < BATCH * 8; v += G) {
        const int b = v >> 3, h = v & 7, rowb = b * SEQ;
        for (int k = 0; k < 16; ++k) {
            AttnTask T;
            if (k < 8) {
                const int r = wave & 3, half = wave >> 2, pr = 2 * (k >> 1) + half, c = (k & 1) ? 15 - pr : pr;
                T.qrow0 = rowb + 128 * c + r; T.qrs = 4; T.qcol = COL_QB + h * 64; T.kcol = COL_KB + h * 64; T.vcol = COL_VB + h * 64;
                T.n1 = c + 1; T.row1 = rowb + r; T.D01 = 32 * c;
                T.kt2lo = (c == 0) ? 4 : 0; T.kt2hi = 8; T.row2 = rowb + 128 * c - 128; T.D02 = 128 + r; T.qstep2 = 4; T.maxd2 = 128;
                T.orow0 = T.qrow0; T.ors = 4; T.ocol = 512 + h * 64; T.shift = shiftB; T.sinkterm = 0.f;
            } else {
                const int c = wave + 8 * (k - 8);
                T.qrow0 = rowb + 32 * c; T.qrs = 1; T.qcol = COL_QA + h * 64; T.kcol = COL_KA + (h >> 2) * 64; T.vcol = COL_VA + (h >> 2) * 64;
                T.n1 = 0; T.row1 = rowb; T.D01 = 0;
                T.kt2lo = (c < 4) ? 4 - c : 0; T.kt2hi = 5; T.row2 = rowb + 32 * c - 128; T.D02 = 128; T.qstep2 = 1; T.maxd2 = 127;
                T.orow0 = T.qrow0; T.ors = 1; T.ocol = h * 64; T.shift = shiftA; T.sinkterm = __builtin_amdgcn_exp2f(sinks[h] * 1.4426950408889634f - shiftA);
            }
            attn_task(PROJ, MIX, wl, lane, T);
        }
    }
}


constexpr int A2_SLOT = 32768, A2_STG = 98304, A2_STG_W = 4608, A2_NROUNDS = 72 + 23;
struct RIter { int ph, p, k; };
__device__ __forceinline__ void ri_next(RIter& it) { it.k++; const int n = (it.ph == 0) ? 2 * it.p + 2 : ((it.p == 0) ? 2 : 3); if (it.k == n) { it.k = 0; it.p++; if (it.p == 8) { it.p = 0; it.ph++; } } }
__device__ __forceinline__ int ri_blk(const RIter& it) { return (it.ph == 0) ? it.k : ((it.p == 0) ? it.k : 2 * it.p - 1 + it.k); }

__device__ __forceinline__ void attn_phase2(const bf16* __restrict__ PROJ, bf16* __restrict__ MIX, const float* sinks,
                                            LAS unsigned char* lds, int vcu, int G, int wave, int lane, const int mode) {
    const int i = lane & 31, hh = lane >> 5, r = wave & 3, grp = wave >> 2;
    const float NINF = -__builtin_inff();
    unsigned offK[2], offV[2];
#pragma unroll
    for (int j = 0; j < 2; ++j) { const int n = 2 * wave + j, slot = 8 * n + (lane >> 3), cp = lane & 7;
        const int rk = slot ^ ((slot >> 4) & 3), ch = cp ^ ((slot >> 1) & 7); offK[j] = (unsigned)(rk * NPROJ + ch * 8);
        const int rv = slot ^ ((slot >> 2) & 3), dh = (cp >> 2) ^ ((slot >> 1) & 1); offV[j] = (unsigned)(rv * NPROJ + dh * 32 + (cp & 3) * 8); }
    int k1[4], ke[4], ko[4], v1[2], v2[4];
    { const int rho = 4 * i + r, slot = rho ^ ((rho >> 4) & 3), sw = (slot >> 1) & 7;
#pragma unroll
      for (int s = 0; s < 4; ++s) k1[s] = slot * 128 + (((2 * s + hh) ^ sw) * 16); }
    { const int xe = i ^ (i >> 4), xo = i ^ (2 | (i >> 4));
#pragma unroll
      for (int s = 0; s < 4; ++s) { ke[s] = xe * 128 + (((2 * s + hh) ^ ((xe >> 1) & 7)) * 16); ko[s] = xo * 128 + (((2 * s + hh) ^ ((xo >> 1) & 7)) * 16); } }
    { const int q4 = (lane & 15) >> 2, g = (lane >> 4) & 1, pp = lane & 3;
#pragma unroll
      for (int dh = 0; dh < 2; ++dh) { const int sl = 16 * hh + 4 * q4 + (r ^ q4); v1[dh] = 16384 + sl * 128 + ((dh ^ ((sl >> 1) & 1)) * 64) + g * 32 + pp * 8; }
#pragma unroll
      for (int x = 0; x < 4; ++x) { const int dh = x >> 1, e = x & 1, kk = 8 * e + 4 * hh + q4, sl = kk ^ ((kk >> 2) & 3); v2[x] = 16384 + sl * 128 + ((dh ^ ((sl >> 1) & 1)) * 64) + g * 32 + pp * 8; } }
    a_f32x16 c1F, c1R;
#pragma unroll
    for (int q = 0; q < 16; ++q) { const bool mt = ((q & 3) == (i & 3)); c1F[q] = mt ? 1.0f : 0.0f; c1R[q] = mt ? 0.0f : NINF; }
    LAS unsigned char* stg = lds + A2_STG + wave * A2_STG_W;
#define A2_WAIT_V(n) asm volatile("s_waitcnt vmcnt(" #n ")" ::: "memory")
#define A2_OFFQ(q) (((q) & 3) + 8 * ((q) >> 2))
#define A2_CHAIN(S, C, KA) do { a_bf16x8 kf0_ = *(LAS const a_bf16x8*)(lds + (KA)[0]), kf1_ = *(LAS const a_bf16x8*)(lds + (KA)[1]), kf2_ = *(LAS const a_bf16x8*)(lds + (KA)[2]), kf3_ = *(LAS const a_bf16x8*)(lds + (KA)[3]); \
        S = __builtin_amdgcn_mfma_f32_32x32x16_bf16(kf0_, qf[0], C, 0, 0, 0); S = __builtin_amdgcn_mfma_f32_32x32x16_bf16(kf1_, qf[1], S, 0, 0, 0); \
        S = __builtin_amdgcn_mfma_f32_32x32x16_bf16(kf2_, qf[2], S, 0, 0, 0); S = __builtin_amdgcn_mfma_f32_32x32x16_bf16(kf3_, qf[3], S, 0, 0, 0); } while (0)
#define A2_TAIL(S, VA) do { float p_[16]; _Pragma("unroll") for (int q = 0; q < 16; ++q) p_[q] = __builtin_amdgcn_exp2f(S[q]); \
        lsum += ((p_[0] + p_[1]) + (p_[2] + p_[3])) + ((p_[4] + p_[5]) + (p_[6] + p_[7])) + (((p_[8] + p_[9]) + (p_[10] + p_[11])) + ((p_[12] + p_[13]) + (p_[14] + p_[15]))); \
        a_bf16x8 pb0_, pb1_; { v4u w0_, w1_; w0_.x = a_cvtpk(p_[0], p_[1]); w0_.y = a_cvtpk(p_[2], p_[3]); w0_.z = a_cvtpk(p_[4], p_[5]); w0_.w = a_cvtpk(p_[6], p_[7]); \
          w1_.x = a_cvtpk(p_[8], p_[9]); w1_.y = a_cvtpk(p_[10], p_[11]); w1_.z = a_cvtpk(p_[12], p_[13]); w1_.w = a_cvtpk(p_[14], p_[15]); \
          pb0_ = __builtin_bit_cast(a_bf16x8, w0_); pb1_ = __builtin_bit_cast(a_bf16x8, w1_); } \
        a_s16x4 lo_, hi_; \
        lo_ = a_vtr(lds + VA(0, 0, 0)); hi_ = a_vtr(lds + VA(0, 0, 1)); o0 = __builtin_amdgcn_mfma_f32_32x32x16_bf16((a_bf16x8){lo_[0], lo_[1], lo_[2], lo_[3], hi_[0], hi_[1], hi_[2], hi_[3]}, pb0_, o0, 0, 0, 0); \
        lo_ = a_vtr(lds + VA(0, 1, 0)); hi_ = a_vtr(lds + VA(0, 1, 1)); o0 = __builtin_amdgcn_mfma_f32_32x32x16_bf16((a_bf16x8){lo_[0], lo_[1], lo_[2], lo_[3], hi_[0], hi_[1], hi_[2], hi_[3]}, pb1_, o0, 0, 0, 0); \
        lo_ = a_vtr(lds + VA(1, 0, 0)); hi_ = a_vtr(lds + VA(1, 0, 1)); o1 = __builtin_amdgcn_mfma_f32_32x32x16_bf16((a_bf16x8){lo_[0], lo_[1], lo_[2], lo_[3], hi_[0], hi_[1], hi_[2], hi_[3]}, pb0_, o1, 0, 0, 0); \
        lo_ = a_vtr(lds + VA(1, 1, 0)); hi_ = a_vtr(lds + VA(1, 1, 1)); o1 = __builtin_amdgcn_mfma_f32_32x32x16_bf16((a_bf16x8){lo_[0], lo_[1], lo_[2], lo_[3], hi_[0], hi_[1], hi_[2], hi_[3]}, pb1_, o1, 0, 0, 0); } while (0)
    for (int v = vcu; v < BATCH * 8; v += G) {
        const int b = v >> 3, h = v & 7, rowb = b * SEQ;
        const float sinkterm = __builtin_amdgcn_exp2f(sinks[h] * 1.4426950408889634f);
#define A2_ISSUE(it, sl) do { const int blk_ = ri_blk(it); const bf16* kb_ = PROJ + (size_t)(rowb + 128 * blk_) * NPROJ + ((it).ph == 0 ? COL_KB + h * 64 : COL_KA + (h >> 2) * 64); \
        const bf16* vb_ = PROJ + (size_t)(rowb + 128 * blk_) * NPROJ + ((it).ph == 0 ? COL_VB + h * 64 : COL_VA + (h >> 2) * 64); \
        _Pragma("unroll") for (int j_ = 0; j_ < 2; ++j_) { \
            __builtin_amdgcn_global_load_lds((const unsigned*)(kb_ + offK[j_]), (LAS unsigned*)(lds + (sl) * A2_SLOT + (2 * wave + j_) * 1024), 16, 0, 0); \
            __builtin_amdgcn_global_load_lds((const unsigned*)(vb_ + offV[j_]), (LAS unsigned*)(lds + (sl) * A2_SLOT + 16384 + (2 * wave + j_) * 1024), 16, 0, 0); } } while (0)
        RIter cons = {0, 0, 0}, iss = {0, 0, 0};
        if (mode != 2) A2_ISSUE(iss, 0); ri_next(iss); if (mode != 2) A2_ISSUE(iss, 1); ri_next(iss);
        int slot = 0, islot = 2;
        a_bf16x8 qf[4]; a_f32x16 o0 = {}, o1 = {}; float lsum = 0.f;
#pragma unroll
        for (int s = 0; s < 4; ++s) qf[s] = (a_bf16x8){0, 0, 0, 0, 0, 0, 0, 0};
        for (int round = 0; round < A2_NROUNDS; ++round) {
            if (round + 1 < A2_NROUNDS) A2_WAIT_V(4); else A2_WAIT_V(0);
            __builtin_amdgcn_s_barrier(); asm volatile("" ::: "memory");
            if (iss.ph < 2) { if (mode != 2) A2_ISSUE(iss, islot); ri_next(iss); }
            islot = (islot == 2) ? 0 : islot + 1;
            const bool isB = cons.ph == 0;
            const int cw = isB ? 2 * cons.p + grp : 8 * cons.p + wave;
            const int blk = ri_blk(cons);
            const int nr = isB ? 2 * cons.p + 2 : ((cons.p == 0) ? 2 : 3);
            const bool first = cons.k == 0, last = isB ? (blk == cw) : (cons.k == nr - 1);
            const int qrow0 = isB ? rowb + 128 * cw + r : rowb + 32 * cw, qrs = isB ? 4 : 1;
            if (first && mode != 1) {
                const bf16* qp = PROJ + (size_t)(qrow0 + i * qrs) * NPROJ + (isB ? COL_QB : COL_QA) + h * 64 + 8 * hh;
#pragma unroll
                for (int s = 0; s < 4; ++s) qf[s] = *(const a_bf16x8*)(qp + 16 * s);
#pragma unroll
                for (int s = 0; s < 4; ++s) asm volatile("" : "+v"(qf[s]));
                o0 = (a_f32x16){}; o1 = (a_f32x16){}; lsum = 0.f;
            }
            const int sbo = slot * A2_SLOT;
            if (mode != 1) {
            if (isB && blk <= cw) {
                const int d = cw - blk;
                int ka[4];
#pragma unroll
                for (int s = 0; s < 4; ++s) ka[s] = k1[s] + sbo;
                a_f32x16 S;
                if (d >= 5) { A2_CHAIN(S, c1R, ka); }
                else if (d >= 1 && d <= 3) { A2_CHAIN(S, c1F, ka); }
                else { const int Dt = 32 * d + i - 4 * hh; a_f32x16 C;
                    if (d == 0) {
#pragma unroll
                        for (int q = 0; q < 16; ++q) C[q] = (A2_OFFQ(q) <= Dt) ? c1F[q] : NINF;
                    } else {
#pragma unroll
                        for (int q = 0; q < 16; ++q) C[q] = (A2_OFFQ(q) >= Dt - 128) ? c1F[q] : c1R[q];
                    }
                    A2_CHAIN(S, C, ka); }
                const int vb0 = v1[0] + sbo, vb1 = v1[1] + sbo;
#define A2_VA1(dh, sp, e) (((dh) ? vb1 : vb0) + (sp) * 8192 + (e) * 4096)
                A2_TAIL(S, A2_VA1);
#undef A2_VA1
            }
            int t2lo, t2hi;
            if (isB) { t2lo = 0; t2hi = (blk == cw || blk == cw - 1) ? 4 : 0; }
            else { const int t0 = 4 * blk; t2lo = (cw - 4 - t0) > 0 ? (cw - 4 - t0) : 0; t2hi = (cw - t0 + 1) < 4 ? (cw - t0 + 1) : 4; }
            for (int t2 = t2lo; t2 < t2hi; ++t2) {
                const int tbo = sbo + t2 * 4096;
                int ka[4];
#pragma unroll
                for (int s = 0; s < 4; ++s) ka[s] = ((t2 & 1) ? ko[s] : ke[s]) + tbo;
                int D0, qst, maxd, kind;
                if (isB) { const int kt2 = ((blk == cw) ? 4 : 0) + t2; D0 = 128 + r - 32 * kt2; qst = 4; maxd = 128; kind = (kt2 < 4) ? 1 : 2; }
                else { D0 = 32 * (cw - (4 * blk + t2)); qst = 1; maxd = 127; kind = (D0 == 128) ? 1 : ((D0 == 0) ? 2 : 0); }
                const int Dt = D0 + qst * i - 4 * hh;
                a_f32x16 S;
                if (kind == 0) { a_f32x16 Z = {}; A2_CHAIN(S, Z, ka); }
                else { a_f32x16 C;
                    if (kind == 1) {
#pragma unroll
                        for (int q = 0; q < 16; ++q) C[q] = (A2_OFFQ(q) >= Dt - maxd) ? 0.0f : NINF;
                    } else {
#pragma unroll
                        for (int q = 0; q < 16; ++q) C[q] = (A2_OFFQ(q) <= Dt) ? 0.0f : NINF;
                    }
                    A2_CHAIN(S, C, ka); }
                const int vx0 = v2[0] + tbo, vx1 = v2[1] + tbo, vx2 = v2[2] + tbo, vx3 = v2[3] + tbo;
#define A2_VA2(dh, sp, e) (((dh) ? ((e) ? vx3 : vx2) : ((e) ? vx1 : vx0)) + (sp) * 2048)
                A2_TAIL(S, A2_VA2);
#undef A2_VA2
            }
            }
            if (last && mode != 1) {
                const float ltot = lsum + __shfl_xor(lsum, 32) + (isB ? 0.f : sinkterm);
                const float rl = 1.0f / ltot;
#pragma unroll
                for (int g = 0; g < 4; ++g) {
                    typedef unsigned u32x2_t __attribute__((ext_vector_type(2)));
                    u32x2_t a, b2;
                    a.x = a_cvtpk(o0[4 * g] * rl, o0[4 * g + 1] * rl); a.y = a_cvtpk(o0[4 * g + 2] * rl, o0[4 * g + 3] * rl);
                    b2.x = a_cvtpk(o1[4 * g] * rl, o1[4 * g + 1] * rl); b2.y = a_cvtpk(o1[4 * g + 2] * rl, o1[4 * g + 3] * rl);
                    *(LAS u32x2_t*)(stg + i * ATT_STG_PITCH + (8 * g + 4 * hh) * 2) = a;
                    *(LAS u32x2_t*)(stg + i * ATT_STG_PITCH + (32 + 8 * g + 4 * hh) * 2) = b2;
                }
                const int ocol = isB ? 512 + h * 64 : h * 64;
#pragma unroll
                for (int jj = 0; jj < 4; ++jj) { const int row = jj * 8 + (lane >> 3), ch = lane & 7;
                    const v4u vv = *(LAS const v4u*)(stg + row * ATT_STG_PITCH + ch * 16);
                    if (mode == 0) *(v4u*)(MIX + (size_t)(qrow0 + row * qrs) * D + ocol + ch * 8) = vv; else asm volatile("" :: "v"(vv)); }
            }
            slot = (slot == 2) ? 0 : slot + 1; ri_next(cons);
        }
        A2_WAIT_V(0); __builtin_amdgcn_s_barrier(); asm volatile("" ::: "memory");
#undef A2_ISSUE
    }
#undef A2_WAIT_V
#undef A2_OFFQ
#undef A2_CHAIN
#undef A2_TAIL
}

struct Args { const float* in[13]; float* out; unsigned char* ws; int ph_lo, ph_hi, li, pad; };
__global__ void __launch_bounds__(NWAVES * 64, 2) hymba_fwd(Args args) {
    extern __shared__ __attribute__((aligned(16))) unsigned char lds[];
    LAS unsigned char* L = (LAS unsigned char*)lds;
    volatile LAS unsigned* MISC = (volatile LAS unsigned*)(L + MISC_OFF);
    const int tid = threadIdx.x, lane = tid & 63, wave = __builtin_amdgcn_readfirstlane(tid >> 6);
    const int G = gridDim.x; const int bx = blockIdx.x; const int vcu = (G % 8 == 0) ? (bx % 8) * (G / 8) + bx / 8 : bx;
    unsigned char* ws = args.ws;
    gu32* ctl = (gu32*)(ws + WS_CTL);
    const float* x = args.in[0]; const int* positions = (const int*)args.in[1]; const float* g_attn = args.in[2]; const float* w_in = args.in[3];
    const float* gqa = args.in[4]; const float* gka = args.in[5]; const float* sinks = args.in[6]; const float* gqb = args.in[7]; const float* gkb = args.in[8];
    const float* w_out = args.in[9]; const float* g_mlp = args.in[10]; const float* w_up = args.in[11]; const float* w_dn = args.in[12];
    float* out = args.out;
    bf16* Win_t = (bf16*)(ws + WS_WIN); bf16* Wout_t = (bf16*)(ws + WS_WOUT); bf16* Wup_t = (bf16*)(ws + WS_WUP); bf16* Wdn_t = (bf16*)(ws + WS_WDN);
    float* rope = (float*)(ws + WS_ROPE); float* ssp = (float*)(ws + WS_SS);
    bf16* XN = (bf16*)(ws + WS_XN); bf16* PROJ = (bf16*)(ws + WS_PROJ); bf16* MIXB = (bf16*)(ws + WS_MIX); bf16* HID = (bf16*)(ws + WS_HID);
    for (int u = tid; u < (LDS_BYTES - LDSCTL_OFF) / 4; u += NWAVES * 64) ((LAS unsigned*)(L + LDSCTL_OFF))[u] = 0u;
    __syncthreads();
    const int bli = (N_LAUNCHES == PER_PHASE) ? 0 : args.li;
    XcdBarrier bar; bar.bar = (unsigned*)(ctl + CW_BAR) + bli * XCD_BAR_WORDS; bar.x = 0; bar.st = nullptr;
    if (N_LAUNCHES != PER_PHASE) bar = xcd_barrier_post((unsigned*)(ctl + CW_BAR) + bli * XCD_BAR_WORDS, MISC + 8);
#define GRID_BAR(seam) do { if (N_LAUNCHES == PER_PHASE) { if (tid == 0) __hip_atomic_store(ctl + CW_TMO, 0xBADBA0u | (unsigned)(seam), RLX_AGENT); } else { xcd_barrier(bar); } } while (0)
    const int lo = args.ph_lo, hi = args.ph_hi;
#define IN(k) (lo <= (k) && (k) < hi)
#define BOTH(k) (IN(k) && IN((k) + 1))

    if (IN(0)) { REP(0) {
        LAS float* scr = (LAS float*)(L + RING_OFF + wave * 16384);
        const int gw = vcu * NWAVES + wave, NGW = G * NWAVES;
        constexpr int I_IN = (D / 64) * (NPROJ / 32), I_OUT = (D / 64) * (D / 32), I_UP = (D / 64) * (FF / 32), I_DN = (FF / 64) * (D / 32);
        constexpr int NITEMS = I_IN + I_OUT + I_UP + I_DN;
        for (int it = gw; it < NITEMS; it += NGW) {
            int r = it;
            if (r < I_IN) { p0_transpose_item(w_in, D, NPROJ, Win_t, nullptr, scr, r, lane); continue; } r -= I_IN;
            if (r < I_OUT) { p0_transpose_item(w_out, D, D, Wout_t, nullptr, scr, r, lane); continue; } r -= I_OUT;
            if (r < I_UP) { p0_transpose_item(w_up, D, FF, Wup_t, g_mlp, scr, r, lane); continue; } r -= I_UP;
            p0_transpose_item(w_dn, FF, D, Wdn_t, nullptr, scr, r, lane);
        }
        for (int m = gw * 4; m < M; m += NGW * 4) rms_rows_to_bf16<4>(x + (size_t)m * D, g_attn, XN + (size_t)m * D, lane);
        for (int it = gw * 64 + lane; it < M * 8; it += NGW * 64) {
            const int m = it >> 3, i = it & 7;
            const float inv_freq = (i == 0) ? 1.0f : (i == 1) ? 0.193922743f : (i == 2) ? 0.0376060307f : (i == 3) ? 0.00729266461f : (i == 4) ? 0.00141421356f : (i == 5) ? 0.000274248188f : (i == 6) ? 5.3182961e-05f : 1.03133862e-05f;
            const float ang = (float)positions[m] * inv_freq;
            double rev = (double)ang * 0.15915494309189535; rev -= __builtin_floor(rev);
            const float rf = (float)rev;
            rope[(size_t)m * 16 + i] = __builtin_amdgcn_cosf(rf); rope[(size_t)m * 16 + 8 + i] = __builtin_amdgcn_sinf(rf);
        }
        }
        if (BOTH(0)) GRID_BAR(0);
    }
    if (IN(1)) {
        pg8::Gemm g{XN, Win_t, M, NPROJ, D}; pg8::StaticOrder S; S.init(M, NPROJ, G, (int)blockIdx.x);
        pg8::EpiQKV E{PROJ, NPROJ, gqa, gka, gqb, gkb, rope};
        REP(1) pg8::gemm_phase<pg8::EpiQKV, pg8::StaticOrder, true>(L + RING_OFF, g, S, E);
        if (BOTH(1)) GRID_BAR(1);
    }
    if (IN(2)) {
#if defined(NAIVE_ATTN)
        attn_naive(PROJ, MIXB, gqa, gka, gqb, gkb, sinks, vcu * (NWAVES * 64) + tid, G * NWAVES * 64);
#else
#if defined(ATTN_V1)
        REP(2) attn_phase(PROJ, MIXB, gqa, gka, gqb, gkb, sinks, L + RING_OFF, vcu, G, wave, lane);
#else
        REP(2) attn_phase2(PROJ, MIXB, sinks, L + RING_OFF, vcu, G, wave, lane, rep_ == 0 ? 0 : PROBE_MODE);
#endif
#endif
        if (BOTH(2)) GRID_BAR(2);
    }
    if (IN(3)) {
        pg8::Gemm g{MIXB, Wout_t, M, D, D}; pg8::StaticOrder S; S.init(M, D, G, (int)blockIdx.x);
        pg8::EpiOut E{x, XN, ssp, D};
        REP(3) pg8::gemm_phase<pg8::EpiOut, pg8::StaticOrder, true>(L + RING_OFF, g, S, E);
        if (BOTH(3)) GRID_BAR(3);
    }
    if (IN(4)) {
        pg8::Gemm g{XN, Wup_t, M, FF, D}; pg8::StaticOrder S; S.init(M, FF, G, (int)blockIdx.x);
        pg8::EpiUp E{ssp, HID, FF, 1.0f / D, RMS_EPS};
        REP(4) pg8::gemm_phase<pg8::EpiUp, pg8::StaticOrder, true>(L + RING_OFF, g, S, E);
        if (BOTH(4)) GRID_BAR(4);
    }
    if (IN(5)) {
        pg8::Gemm g{HID, Wdn_t, M, D, FF}; pg8::StaticOrder S; S.init(M, D, G, (int)blockIdx.x);
        pg8::EpiDown E{XN, out, D};
        pg8::gemm_phase<pg8::EpiDown, pg8::StaticOrder, true>(L + RING_OFF, g, S, E);
    }
#undef IN
#undef BOTH
}

extern "C" void kernel_launch(void* const* d_in, const int* in_sizes, int n_in, void* d_out, int out_size, void* d_ws, size_t ws_size, hipStream_t stream) {
    static int grid = 0;
    if (grid == 0) {
        if (n_in != 13 || in_sizes[0] != M * D || out_size != M * D || ws_size < WS_END) { fprintf(stderr, "kernel_launch: shape/workspace mismatch (n_in %d in0 %d out %d ws %zu); nothing launched\n", n_in, n_in > 0 ? in_sizes[0] : -1, out_size, ws_size); grid = -1; return; }
        int dev = 0, cus = 0, per_cu = 0;
        if (hipGetDevice(&dev) != hipSuccess || hipDeviceGetAttribute(&cus, hipDeviceAttributeMultiprocessorCount, dev) != hipSuccess) { fprintf(stderr, "kernel_launch: device query failed\n"); grid = -1; return; }
        if (hipFuncSetAttribute((const void*)hymba_fwd, hipFuncAttributeMaxDynamicSharedMemorySize, LDS_BYTES) != hipSuccess) { fprintf(stderr, "kernel_launch: hipFuncSetAttribute failed\n"); grid = -1; return; }
        if (hipOccupancyMaxActiveBlocksPerMultiprocessor(&per_cu, (const void*)hymba_fwd, NWAVES * 64, LDS_BYTES) != hipSuccess || per_cu < 1)
            fprintf(stderr, "kernel_launch: note: occupancy query reports %d workgroups per CU\n", per_cu);
        (void)hipGetLastError();
        grid = cus;
    }
    if (grid < 0) return;
    if (hipMemsetAsync((char*)d_ws + WS_CTL, 0, CTL_ZERO_BYTES, stream) != hipSuccess) { fprintf(stderr, "kernel_launch: hipMemsetAsync failed\n"); return; }
    Args a{};
    for (int i = 0; i < 13; ++i) a.in[i] = (const float*)d_in[i];
    a.out = (float*)d_out; a.ws = (unsigned char*)d_ws;
    static_assert(N_LAUNCHES == 1 || N_LAUNCHES == PER_PHASE, "MK_N_LAUNCHES must be 1 or 6");
    for (int li = 0; li < N_LAUNCHES; ++li) {
        a.ph_lo = (N_LAUNCHES == PER_PHASE) ? li : 0; a.ph_hi = (N_LAUNCHES == PER_PHASE) ? li + 1 : PER_PHASE; a.li = li;
        hipLaunchKernelGGL(hymba_fwd, dim3(grid), dim3(NWAVES * 64), LDS_BYTES, stream, a);
        const hipError_t le = hipPeekAtLastError();
        if (le != hipSuccess) { fprintf(stderr, "kernel_launch: launch %d failed: %s\n", li, hipGetErrorName(le)); break; }
    }
}
```

```cpp
#include <hip/hip_runtime.h>
#include <cstdio>
#include <cstdint>

#ifndef MK_N_LAUNCHES
#define MK_N_LAUNCHES 1
#endif
#ifndef REPEAT_MASK
#define REPEAT_MASK 0
#endif
#ifndef PROBE_MODE
#define PROBE_MODE 0
#endif
#define REP(k) for (int rep_ = 0; rep_ < 1 + ((REPEAT_MASK >> (k)) & 1); ++rep_)

namespace pg8 {
#define PG8_LAS __attribute__((address_space(3)))
typedef unsigned short bf16_t;
typedef short bf16x8 __attribute__((ext_vector_type(8)));
typedef float f32x4 __attribute__((ext_vector_type(4)));
typedef unsigned u32x4 __attribute__((ext_vector_type(4)));
constexpr int BM = 256, BK = 64, HALF = 128, HTB = HALF * BK * 2  , STAGE_BYTES = 8 * HTB, NXCD = 8, WGM = 8;

__host__ __device__ __forceinline__ int lds_byte(int r, int c) { const int st = (r >> 4) * 2 + (c >> 5), rr = r & 15, cc = c & 31, ob = rr * 64 + cc * 2; return st * 1024 + (ob ^ (((ob >> 9) & 1) << 5)); }
__host__ __device__ __forceinline__ void stage_rc(int b, int& R, int& C) { const int st = b / 1024, sb = b % 1024, swz = sb ^ (((sb >> 9) & 1) << 5); R = (st >> 1) * 16 + swz / 64; C = (st & 1) * 32 + (swz % 64) / 2; }
__host__ __device__ __forceinline__ int perm32(int rho) { const int n = rho >> 4, i = rho & 15; return 8 * (i >> 2) + 4 * n + (i & 3); }

struct Unit { int pm, pn; };
struct Gemm { const bf16_t* A; const bf16_t* Bt; int M, N, K; };

struct StaticOrder {
    int nM, nN, nwg, G, c;
    __host__ __device__ void init(int M, int N, int G_, int c_) { nM = M / BM; nN = N / BM; nwg = nM * nN; G = G_; c = c_; }
    __host__ __device__ bool next(int i, Unit& u) const {
        const long L = (long)i * G + c; if (L >= nwg) return false;
        int wgid = (int)L; { const int q = nwg / NXCD, r = nwg % NXCD, xcd = wgid % NXCD, off = wgid / NXCD; wgid = (xcd < r ? xcd * (q + 1) : r * (q + 1) + (xcd - r) * q) + off; }
        const int nig = WGM * nN, gid = wgid / nig, fm = gid * WGM, gsz = (nM - fm) < WGM ? (nM - fm) : WGM;
        u.pm = fm + ((wgid % nig) % gsz); u.pn = (wgid % nig) / gsz; return true;
    }
};

__device__ __forceinline__ unsigned cvt_pk_bf16(float lo, float hi) { unsigned r; asm volatile("v_cvt_pk_bf16_f32 %0, %1, %2" : "=v"(r) : "v"(lo), "v"(hi)); return r; }

constexpr float QK_EPS = 1e-6f;
constexpr float C2 = 0.125f * 1.4426950408889634f;

struct EpiQKV {
    bf16_t* O; int ldc; const float* gqa; const float* gka; const float* gqb; const float* gkb; const float* rope;
    __device__ __forceinline__ void operator()(const f32x4 (&acc)[2][2][4][2], const Unit& u, int wr, int wc, int fr, int fq) const {
        const int pn = u.pn; int mode = 0; const float* g = gqa;
        if (pn < 2) { mode = 1; g = gqa; } else if (pn == 2) { if (wc < 2) { mode = 2; g = gka; } } else if (pn < 5) { mode = 1; g = gqb; } else if (pn < 7) { mode = 2; g = gkb; }
        const int row0 = u.pm * BM + wr * 64 + fr, col0 = pn * BM + wc * 64 + 8 * fq;
        if (mode == 0) {
#pragma unroll
            for (int ai = 0; ai < 2; ++ai)
#pragma unroll
                for (int m = 0; m < 4; ++m) { bf16_t* rowp = O + (size_t)(row0 + ai * HALF + m * 16) * ldc + col0;
#pragma unroll
                    for (int bj = 0; bj < 2; ++bj) { const f32x4 v0 = acc[ai][bj][m][0], v1 = acc[ai][bj][m][1]; u32x4 w;
                        w.x = cvt_pk_bf16(v0[0], v0[1]); w.y = cvt_pk_bf16(v0[2], v0[3]); w.z = cvt_pk_bf16(v1[0], v1[1]); w.w = cvt_pk_bf16(v1[2], v1[3]);
                        *(u32x4*)(rowp + bj * 32) = w; } }
            return;
        }
        f32x4 gv[2][2];
#pragma unroll
        for (int bj = 0; bj < 2; ++bj)
#pragma unroll
            for (int n = 0; n < 2; ++n) gv[bj][n] = *(const f32x4*)(g + 32 * bj + 8 * fq + 4 * n);
        const float sc = (mode == 1) ? C2 : 1.0f;
        const float sgn = (fq == 0) ? -1.0f : 1.0f;
#pragma unroll
        for (int ai = 0; ai < 2; ++ai)
#pragma unroll
            for (int m = 0; m < 4; ++m) {
                const int row = row0 + ai * HALF + m * 16;
                float ss = 0.f;
#pragma unroll
                for (int bj = 0; bj < 2; ++bj)
#pragma unroll
                    for (int n = 0; n < 2; ++n) { const f32x4 x = acc[ai][bj][m][n]; ss += (x[0] * x[0] + x[1] * x[1]) + (x[2] * x[2] + x[3] * x[3]); }
                ss += __shfl_xor(ss, 16); ss += __shfl_xor(ss, 32);
                const float rs = __builtin_amdgcn_rsqf(ss * (1.0f / 64.0f) + QK_EPS);
                f32x4 y[2][2];
#pragma unroll
                for (int bj = 0; bj < 2; ++bj)
#pragma unroll
                    for (int n = 0; n < 2; ++n) y[bj][n] = acc[ai][bj][m][n] * rs * gv[bj][n];
                const f32x4 c0 = *(const f32x4*)(rope + (size_t)row * 16), c1 = *(const f32x4*)(rope + (size_t)row * 16 + 4);
                const f32x4 s0 = *(const f32x4*)(rope + (size_t)row * 16 + 8), s1 = *(const f32x4*)(rope + (size_t)row * 16 + 12);
                f32x4 p0, p1;
#pragma unroll
                for (int e = 0; e < 4; ++e) { p0[e] = __shfl_xor(y[0][0][e], 16); p1[e] = __shfl_xor(y[0][1][e], 16); }
                if (fq < 2) { y[0][0] = y[0][0] * c0 + p0 * s0 * sgn; y[0][1] = y[0][1] * c1 + p1 * s1 * sgn; }
                bf16_t* rowp = O + (size_t)row * ldc + col0;
#pragma unroll
                for (int bj = 0; bj < 2; ++bj) { const f32x4 v0 = y[bj][0] * sc, v1 = y[bj][1] * sc; u32x4 w;
                    w.x = cvt_pk_bf16(v0[0], v0[1]); w.y = cvt_pk_bf16(v0[2], v0[3]); w.z = cvt_pk_bf16(v1[0], v1[1]); w.w = cvt_pk_bf16(v1[2], v1[3]);
                    *(u32x4*)(rowp + bj * 32) = w; }
            }
    }
};

struct EpiOut {
    const float* x; bf16_t* hb; float* ssp; int ldc;
    __device__ __forceinline__ void operator()(const f32x4 (&acc)[2][2][4][2], const Unit& u, int wr, int wc, int fr, int fq) const {
        const int row0 = u.pm * BM + wr * 64 + fr, col0 = u.pn * BM + wc * 64 + 8 * fq;
#pragma unroll
        for (int ai = 0; ai < 2; ++ai)
#pragma unroll
            for (int m = 0; m < 4; ++m) {
                const int row = row0 + ai * HALF + m * 16; const size_t off = (size_t)row * ldc + col0; float ss = 0.f;
#pragma unroll
                for (int bj = 0; bj < 2; ++bj) {
                    const f32x4 x0 = *(const f32x4*)(x + off + bj * 32), x1 = *(const f32x4*)(x + off + bj * 32 + 4);
                    const f32x4 v0 = acc[ai][bj][m][0] + x0, v1 = acc[ai][bj][m][1] + x1;
                    u32x4 w; w.x = cvt_pk_bf16(v0[0], v0[1]); w.y = cvt_pk_bf16(v0[2], v0[3]); w.z = cvt_pk_bf16(v1[0], v1[1]); w.w = cvt_pk_bf16(v1[2], v1[3]);
                    *(u32x4*)(hb + off + bj * 32) = w;
                    ss += (v0[0] * v0[0] + v0[1] * v0[1]) + (v0[2] * v0[2] + v0[3] * v0[3]) + (v1[0] * v1[0] + v1[1] * v1[1]) + (v1[2] * v1[2] + v1[3] * v1[3]);
                }
                ss += __shfl_xor(ss, 16); ss += __shfl_xor(ss, 32);
                if (fq == 0) ssp[(size_t)row * 16 + u.pn * 4 + wc] = ss;
            }
    }
};

struct EpiUp {
    const float* ssp; bf16_t* hid; int ldc; float inv_n, eps;
    __device__ __forceinline__ void operator()(const f32x4 (&acc)[2][2][4][2], const Unit& u, int wr, int wc, int fr, int fq) const {
        const int row0 = u.pm * BM + wr * 64 + fr, col0 = u.pn * BM + wc * 64 + 8 * fq;
#pragma unroll
        for (int ai = 0; ai < 2; ++ai)
#pragma unroll
            for (int m = 0; m < 4; ++m) {
                const int row = row0 + ai * HALF + m * 16;
                const f32x4 a = *(const f32x4*)(ssp + (size_t)row * 16), b = *(const f32x4*)(ssp + (size_t)row * 16 + 4), c = *(const f32x4*)(ssp + (size_t)row * 16 + 8), d = *(const f32x4*)(ssp + (size_t)row * 16 + 12);
                const f32x4 t = (a + b) + (c + d); const float ss = (t[0] + t[1]) + (t[2] + t[3]);
                const float rs = __builtin_amdgcn_rsqf(ss * inv_n + eps);
                bf16_t* rowp = hid + (size_t)row * ldc + col0;
#pragma unroll
                for (int bj = 0; bj < 2; ++bj) { f32x4 v0 = acc[ai][bj][m][0] * rs, v1 = acc[ai][bj][m][1] * rs;
#pragma unroll
                    for (int e = 0; e < 4; ++e) { const float r0 = __builtin_fmaxf(v0[e], 0.f), r1 = __builtin_fmaxf(v1[e], 0.f); v0[e] = r0 * r0; v1[e] = r1 * r1; }
                    u32x4 w; w.x = cvt_pk_bf16(v0[0], v0[1]); w.y = cvt_pk_bf16(v0[2], v0[3]); w.z = cvt_pk_bf16(v1[0], v1[1]); w.w = cvt_pk_bf16(v1[2], v1[3]);
                    *(u32x4*)(rowp + bj * 32) = w; }
            }
    }
};

struct EpiDown {
    const bf16_t* hb; float* out; int ldc;
    __device__ __forceinline__ void operator()(const f32x4 (&acc)[2][2][4][2], const Unit& u, int wr, int wc, int fr, int fq) const {
        const int row0 = u.pm * BM + wr * 64 + fr, col0 = u.pn * BM + wc * 64 + 8 * fq;
#pragma unroll
        for (int ai = 0; ai < 2; ++ai)
#pragma unroll
            for (int m = 0; m < 4; ++m) {
                const size_t off = (size_t)(row0 + ai * HALF + m * 16) * ldc + col0;
#pragma unroll
                for (int bj = 0; bj < 2; ++bj) {
                    const u32x4 hw = *(const u32x4*)(hb + off + bj * 32);
                    const f32x4 h0 = {__uint_as_float(hw.x << 16), __uint_as_float(hw.x & 0xffff0000u), __uint_as_float(hw.y << 16), __uint_as_float(hw.y & 0xffff0000u)};
                    const f32x4 h1 = {__uint_as_float(hw.z << 16), __uint_as_float(hw.z & 0xffff0000u), __uint_as_float(hw.w << 16), __uint_as_float(hw.w & 0xffff0000u)};
                    *(f32x4*)(out + off + bj * 32) = h0 + acc[ai][bj][m][0]; *(f32x4*)(out + off + bj * 32 + 4) = h1 + acc[ai][bj][m][1];
                }
            }
    }
};

template <class Epi, class Sched, bool ALIGN_EPI>
__device__ __forceinline__ void gemm_phase(PG8_LAS unsigned char* lds, const Gemm g, const Sched& S, const Epi& E) {
    const int tid = threadIdx.x, wid = __builtin_amdgcn_readfirstlane(tid >> 6), lane = tid & 63, wr = wid >> 2, wc = wid & 3, fr = lane & 15, fq = lane >> 4;
    const int K = g.K, nt = K / BK;
    unsigned voffA[2], voffB[2];
#pragma unroll
    for (int i = 0; i < 2; ++i) { int R, C; stage_rc(tid * 16 + i * 8192, R, C); const int Rb = (R >> 5) * 64 + perm32(R & 31);
        voffA[i] = (unsigned)(R * K + C) * 2u; voffB[i] = (unsigned)(Rb * K + C) * 2u; }
    const size_t kstep = (size_t)(BK * 2);
    const size_t hstepA = (size_t)HALF * K * 2;
    const size_t hstepB = (size_t)32 * K * 2;
    const size_t tstep = (size_t)BM * K * 2;
    const unsigned ldsw = (unsigned)wid * 1024u;
    const int aoff = lds_byte(wr * 64 + fr, fq * 8), boff = lds_byte(wc * 32 + fr, fq * 8);
#define PG8_SA(b, h) (((b) * 2 + (h)) * HTB)
#define PG8_SB(b, h) ((4 + (b) * 2 + (h)) * HTB)
#define PG8_STAGE(bufoff, gbase, voff) do { _Pragma("unroll") for (int _i = 0; _i < 2; ++_i) \
        __builtin_amdgcn_global_load_lds((const unsigned*)((const char*)(gbase) + (voff)[_i]), (PG8_LAS unsigned*)(lds + (bufoff) + ldsw + _i * 8192), 16, 0, 0); } while (0)
#define PG8_LDA(dst, b, h) do { _Pragma("unroll") for (int m = 0; m < 4; ++m) _Pragma("unroll") for (int k = 0; k < 2; ++k) dst[m][k] = *(const PG8_LAS bf16x8*)(lds + PG8_SA(b, h) + aoff + m * 2048 + k * 1024); } while (0)
#define PG8_LDB(dst, b, h) do { _Pragma("unroll") for (int n = 0; n < 2; ++n) _Pragma("unroll") for (int k = 0; k < 2; ++k) dst[n][k] = *(const PG8_LAS bf16x8*)(lds + PG8_SB(b, h) + boff + n * 2048 + k * 1024); } while (0)
#define PG8_MMA(ai, bj, At, Bt) do { __builtin_amdgcn_s_setprio(1); _Pragma("unroll") for (int m = 0; m < 4; ++m) _Pragma("unroll") for (int n = 0; n < 2; ++n) _Pragma("unroll") for (int k = 0; k < 2; ++k) \
        acc[ai][bj][m][n] = __builtin_amdgcn_mfma_f32_16x16x32_bf16(Bt[n][k], At[m][k], acc[ai][bj][m][n], 0, 0, 0); __builtin_amdgcn_s_setprio(0); } while (0)
#define PG8_WAIT_V(n) asm volatile("s_waitcnt vmcnt(" #n ")" ::: "memory")
#define PG8_WAIT_L(n) asm volatile("s_waitcnt lgkmcnt(" #n ")" ::: "memory")
#define PG8_BAR __builtin_amdgcn_s_barrier()
#define PG8_SCHED __builtin_amdgcn_sched_barrier(0)
    Unit cur, nxt; int ui = 0;
    if (!S.next(0, cur)) return;
    f32x4 acc[2][2][4][2];
#pragma unroll
    for (int a = 0; a < 2; ++a)
#pragma unroll
        for (int b = 0; b < 2; ++b)
#pragma unroll
            for (int m = 0; m < 4; ++m)
#pragma unroll
                for (int n = 0; n < 2; ++n) acc[a][b][m][n] = (f32x4){0.f, 0.f, 0.f, 0.f};
    bf16x8 At[4][2], B0[2][2], B1[2][2];
    const char* cA = (const char*)g.A + (size_t)cur.pm * tstep; const char* cB = (const char*)g.Bt + (size_t)cur.pn * tstep;
    PG8_STAGE(PG8_SB(0, 0), cB, voffB); PG8_STAGE(PG8_SB(0, 1), cB + hstepB, voffB); PG8_STAGE(PG8_SA(0, 0), cA, voffA); PG8_STAGE(PG8_SA(0, 1), cA + hstepA, voffA);
    if (wr == 1) PG8_BAR;
    PG8_WAIT_V(2); PG8_BAR;
    PG8_STAGE(PG8_SB(1, 0), cB + kstep, voffB); PG8_STAGE(PG8_SA(1, 0), cA + kstep, voffA); PG8_STAGE(PG8_SB(1, 1), cB + hstepB + kstep, voffB);
    PG8_WAIT_V(6); PG8_BAR;
    for (;;) {
        const bool has_next = S.next(ui + 1, nxt);
        const char* nA = has_next ? (const char*)g.A + (size_t)nxt.pm * tstep : cA; const char* nB = has_next ? (const char*)g.Bt + (size_t)nxt.pn * tstep : cB;
        for (int t = 0; t < nt; t += 2) {
            const bool last = (t == nt - 2);
            const char* a1 = cA + (size_t)(t + 1) * kstep;
            const char* a2 = last ? nA : cA + (size_t)(t + 2) * kstep; const char* b2 = last ? nB : cB + (size_t)(t + 2) * kstep;
            const char* a3 = a2 + kstep; const char* b3 = b2 + kstep;
            PG8_LDB(B0, 0, 0); PG8_LDB(B1, 0, 1); PG8_SCHED; PG8_LDA(At, 0, 0); PG8_STAGE(PG8_SA(1, 1), a1 + hstepA, voffA);
            PG8_WAIT_V(8); PG8_WAIT_L(0); PG8_BAR; PG8_MMA(0, 0, At, B0); PG8_MMA(0, 1, At, B1); PG8_BAR; PG8_SCHED;
            PG8_LDA(At, 0, 1); PG8_STAGE(PG8_SB(0, 0), b2, voffB); PG8_STAGE(PG8_SB(0, 1), b2 + hstepB, voffB); PG8_STAGE(PG8_SA(0, 0), a2, voffA);
            PG8_WAIT_V(8); PG8_WAIT_L(0); PG8_BAR; PG8_MMA(1, 0, At, B0); PG8_MMA(1, 1, At, B1); PG8_BAR; PG8_SCHED;
            PG8_LDB(B0, 1, 0); PG8_LDB(B1, 1, 1); PG8_SCHED; PG8_LDA(At, 1, 0); PG8_STAGE(PG8_SA(0, 1), a2 + hstepA, voffA);
            PG8_WAIT_V(8); PG8_WAIT_L(0); PG8_BAR; PG8_MMA(0, 0, At, B0); PG8_MMA(0, 1, At, B1); PG8_BAR; PG8_SCHED;
            PG8_LDA(At, 1, 1); PG8_STAGE(PG8_SB(1, 0), b3, voffB); PG8_STAGE(PG8_SB(1, 1), b3 + hstepB, voffB); PG8_STAGE(PG8_SA(1, 0), a3, voffA);
            PG8_WAIT_V(8); PG8_WAIT_L(0); PG8_BAR; PG8_MMA(1, 0, At, B0); PG8_MMA(1, 1, At, B1); PG8_BAR; PG8_SCHED;
        }
        if constexpr (ALIGN_EPI) { if (wr == 0) PG8_BAR; }
        E(acc, cur, wr, wc, fr, fq);
        if (!has_next) break;
#pragma unroll
        for (int a = 0; a < 2; ++a)
#pragma unroll
            for (int b = 0; b < 2; ++b)
#pragma unroll
                for (int m = 0; m < 4; ++m)
#pragma unroll
                    for (int n = 0; n < 2; ++n) acc[a][b][m][n] = (f32x4){0.f, 0.f, 0.f, 0.f};
        cur = nxt; cA = nA; cB = nB; ++ui;
        if constexpr (ALIGN_EPI) { if (wr == 1) PG8_BAR; }
    }
    PG8_WAIT_V(0);
    if constexpr (!ALIGN_EPI) { if (wr == 0) PG8_BAR; }
    PG8_BAR;
#undef PG8_SA
#undef PG8_SB
#undef PG8_STAGE
#undef PG8_LDA
#undef PG8_LDB
#undef PG8_MMA
#undef PG8_WAIT_V
#undef PG8_WAIT_L
#undef PG8_BAR
#undef PG8_SCHED
}
}

constexpr int NWAVES = 8;
constexpr int BATCH = 32, SEQ = 2048, D = 1024, FF = 4096, HD = 64;
constexpr int M = BATCH * SEQ;
constexpr int NPROJ = 2304;
constexpr int COL_QA = 0, COL_KA = 512, COL_VA = 640, COL_QB = 768, COL_KB = 1280, COL_VB = 1792;
constexpr float RMS_EPS = 1e-6f;
constexpr int N_LAUNCHES = MK_N_LAUNCHES, PER_PHASE = 6;
constexpr int N_BAR_REGIONS = (MK_N_LAUNCHES == PER_PHASE) ? 1 : MK_N_LAUNCHES;

constexpr size_t MiB = 1u << 20;
constexpr size_t WS_CTL = 0, CTL_ZERO_BYTES = 1 * MiB;
constexpr size_t WS_WIN = 2 * MiB, WS_WOUT = 8 * MiB, WS_WUP = 10 * MiB, WS_WDN = 18 * MiB;
constexpr size_t WS_ROPE = 26 * MiB;
constexpr size_t WS_SS = 30 * MiB;
constexpr size_t WS_XN = 64 * MiB;
constexpr size_t WS_PROJ = 192 * MiB;
constexpr size_t WS_MIX = 480 * MiB;
constexpr size_t WS_HID = 192 * MiB;
constexpr size_t WS_END = 704 * MiB;
static_assert(WS_WIN + (size_t)NPROJ * D * 2 <= WS_WOUT && WS_WDN + (size_t)D * FF * 2 <= WS_ROPE && WS_SS + (size_t)M * 64 <= WS_XN, "d_ws map");
static_assert(WS_XN + (size_t)M * D * 2 <= WS_PROJ && WS_PROJ + (size_t)M * NPROJ * 2 <= WS_MIX && WS_MIX + (size_t)M * D * 2 <= WS_END && WS_HID + (size_t)M * FF * 2 <= WS_END, "d_ws map");
constexpr int CW_TMO = 0, CW_CODE = 1;
constexpr int CW_BAR = 4096;

constexpr int RING_OFF = 0, RING_BYTES = 131072;
constexpr int LDSCTL_OFF = 139264, MISC_OFF = LDSCTL_OFF + 320;
constexpr int LDS_BYTES = 147456;

#define GAS __attribute__((address_space(1)))
#define LAS __attribute__((address_space(3)))
typedef unsigned short bf16;
typedef unsigned v4u __attribute__((ext_vector_type(4)));
typedef float f32x4 __attribute__((ext_vector_type(4)));
typedef GAS unsigned gu32;
#define RLX_AGENT __ATOMIC_RELAXED, __HIP_MEMORY_SCOPE_AGENT
#define LDS_WAIT() asm volatile("s_waitcnt lgkmcnt(0)" ::: "memory")
#define VM_WAIT() asm volatile("s_waitcnt vmcnt(0)" ::: "memory")
__device__ __forceinline__ unsigned f2bf(float f) { unsigned u = __builtin_bit_cast(unsigned, f); return (u + 0x7fffu + ((u >> 16) & 1u)) >> 16; }
__device__ __forceinline__ unsigned pk2(float lo, float hi) { return f2bf(lo) | (f2bf(hi) << 16); }
__device__ __forceinline__ float bf_lo(unsigned u) { return __uint_as_float(u << 16); }
__device__ __forceinline__ float bf_hi(unsigned u) { return __uint_as_float(u & 0xffff0000u); }

#define XB_TMO      128
#define XB_XCNT(j)  (256  + 64 * (j))
#define XB_XSUB(j)  (1280 + 64 * (j))
#define XB_XGEN(j)  (2304 + 64 * (j))
#define XB_TOP      3328
#define XB_TOPGEN   3392
#define XCD_BAR_WORDS 3456
#define XB_SPIN_CAP (1u << 18)

__device__ __forceinline__ unsigned xb_ld(unsigned* p)              { return __hip_atomic_load(p, __ATOMIC_RELAXED, __HIP_MEMORY_SCOPE_AGENT); }
__device__ __forceinline__ unsigned xb_add(unsigned* p, unsigned v) { return __hip_atomic_fetch_add(p, v, __ATOMIC_RELAXED, __HIP_MEMORY_SCOPE_AGENT); }
__device__ __forceinline__ unsigned xb_xcc_id() { return (unsigned)__builtin_amdgcn_s_getreg((3 << 11) | 20) & 0xFu; }
#define XB_SPIN(cond, bar) do { unsigned _sp = 0; while (cond) { __builtin_amdgcn_s_sleep(1); \
    if ((++_sp & 255u) == 0u) { if (xb_ld(&(bar)[XB_TMO])) break; if (_sp > XB_SPIN_CAP) { atomicAdd(&(bar)[XB_TMO], 1u); break; } } } } while (0)

struct XcdBarrier { unsigned* bar; unsigned x; volatile LAS unsigned* st; };

__device__ __forceinline__ XcdBarrier xcd_barrier_post(unsigned* bar, volatile LAS unsigned* st) {
    XcdBarrier b; b.bar = bar; b.x = xb_xcc_id(); b.st = st;
    if (threadIdx.x == 0) (void)xb_add(&bar[XB_XCNT(b.x)], 1u);
    return b;
}
__device__ __forceinline__ void xcd_barrier_complete(unsigned* bar, unsigned x, unsigned& nloc, unsigned& nx) {
    const unsigned G = gridDim.x * gridDim.y * gridDim.z;
    unsigned sum, cnt, mine, sp = 0u;
    for (;;) {
        sum = 0u; cnt = 0u; mine = 0u;
#pragma unroll
        for (unsigned j = 0; j < 16; ++j) { const unsigned c = xb_ld(&bar[XB_XCNT(j)]); sum += c; cnt += (c > 0u) ? 1u : 0u; mine = (j == x) ? c : mine; }
        if (sum == G) break;
        __builtin_amdgcn_s_sleep(1);
        if ((++sp & 255u) == 0u) { if (xb_ld(&bar[XB_TMO])) break; if (sp > XB_SPIN_CAP) { atomicAdd(&bar[XB_TMO], 1u); break; } }
    }
    nloc = mine > 0u ? mine : 1u; nx = cnt > 0u ? cnt : 1u;
}
__device__ __forceinline__ void xcd_barrier(const XcdBarrier& b) {
    asm volatile("s_waitcnt vmcnt(0)" ::: "memory");
    __syncthreads();
    if (threadIdx.x == 0) {
        unsigned* bar = b.bar;
        __builtin_amdgcn_s_waitcnt(0);
        unsigned nloc = b.st[0], nx = b.st[1];
        if (nloc == 0u) { xcd_barrier_complete(bar, b.x, nloc, nx); b.st[0] = nloc; b.st[1] = nx; }
        const unsigned old = xb_add(&bar[XB_XSUB(b.x)], 1u);
        const unsigned gen = old / nloc;
        if (old + 1u == (gen + 1u) * nloc) {
            __builtin_amdgcn_fence(__ATOMIC_RELEASE, "agent");
            asm volatile("s_waitcnt vmcnt(0)" ::: "memory");
            const unsigned og = xb_add(&bar[XB_TOP], 1u);
            const unsigned tg = og / nx;
            if (og + 1u == (tg + 1u) * nx) xb_add(&bar[XB_TOPGEN], 1u);
            else XB_SPIN(xb_ld(&bar[XB_TOPGEN]) == tg, bar);
            __builtin_amdgcn_fence(__ATOMIC_ACQUIRE, "agent");
            xb_add(&bar[XB_XGEN(b.x)], 1u);
            asm volatile("s_waitcnt vmcnt(0)" ::: "memory");
        } else {
            XB_SPIN(xb_ld(&bar[XB_XGEN(b.x)]) == gen, bar);
            __builtin_amdgcn_fence(__ATOMIC_ACQUIRE, "agent");
            asm volatile("s_waitcnt vmcnt(0)" ::: "memory");
        }
    }
    __syncthreads();
}

__device__ __forceinline__ float wave_sum(float v) {
#pragma unroll
    for (int o = 1; o < 64; o <<= 1) v += __shfl_xor(v, o);
    return v;
}
__device__ __forceinline__ float wave_max(float v) {
#pragma unroll
    for (int o = 1; o < 64; o <<= 1) v = __builtin_fmaxf(v, __shfl_xor(v, o));
    return v;
}
__device__ __forceinline__ void p0_transpose_item(const float* W, int K, int N, bf16* WT, const float* gk, LAS float* scr, int item, int lane) {
    const int nblk = N / 32, kb = item / nblk, nb = item % nblk, k0 = 64 * kb, n0 = 32 * nb;
    float wv[32];
#pragma unroll
    for (int i = 0; i < 32; ++i) wv[i] = W[(size_t)(k0 + 2 * i + (lane >> 5)) * N + n0 + (lane & 31)];
    if (gk) {
#pragma unroll
        for (int i = 0; i < 32; ++i) wv[i] *= gk[k0 + 2 * i + (lane >> 5)]; }
#pragma unroll
    for (int i = 0; i < 32; ++i) scr[(2 * i + (lane >> 5)) * 33 + (lane & 31)] = wv[i];
    LDS_WAIT(); asm volatile("" ::: "memory");
    const int c = lane & 7;
#pragma unroll
    for (int j = 0; j < 4; ++j) { const int n = (lane >> 3) + 8 * j; const LAS float* s = scr + (8 * c) * 33 + n;
        v4u o; o.x = pk2(s[0 * 33], s[1 * 33]); o.y = pk2(s[2 * 33], s[3 * 33]); o.z = pk2(s[4 * 33], s[5 * 33]); o.w = pk2(s[6 * 33], s[7 * 33]);
        *(GAS v4u*)(WT + (size_t)(n0 + n) * K + k0 + 8 * c) = o; }
    LDS_WAIT(); asm volatile("" ::: "memory");
}
template <int NR>
__device__ __forceinline__ void rms_rows_to_bf16(const float* xrow, const float* gain, bf16* orow, int lane) {
    f32x4 v[NR][4]; float s[NR];
#pragma unroll
    for (int r = 0; r < NR; ++r) { const GAS f32x4* xr = (const GAS f32x4*)(xrow + (size_t)r * D) + lane;
#pragma unroll
        for (int j = 0; j < 4; ++j) v[r][j] = __builtin_nontemporal_load(xr + 64 * j); }
    const GAS f32x4* gr = (const GAS f32x4*)gain + lane;
    f32x4 gg[4];
#pragma unroll
    for (int j = 0; j < 4; ++j) gg[j] = gr[64 * j];
#pragma unroll
    for (int r = 0; r < NR; ++r) { s[r] = 0.f;
#pragma unroll
        for (int j = 0; j < 4; ++j) s[r] += (v[r][j].x * v[r][j].x + v[r][j].y * v[r][j].y) + (v[r][j].z * v[r][j].z + v[r][j].w * v[r][j].w); }
#pragma unroll
    for (int o = 1; o < 64; o <<= 1) {
#pragma unroll
        for (int r = 0; r < NR; ++r) s[r] += __shfl_xor(s[r], o); }
#pragma unroll
    for (int r = 0; r < NR; ++r) { const float rstd = __builtin_amdgcn_rsqf(s[r] * (1.f / D) + RMS_EPS);
        GAS unsigned long long* o8 = (GAS unsigned long long*)(orow + (size_t)r * D) + lane;
#pragma unroll
        for (int j = 0; j < 4; ++j) { const f32x4 y = v[r][j] * rstd * gg[j];
            o8[64 * j] = (unsigned long long)pk2(y.x, y.y) | ((unsigned long long)pk2(y.z, y.w) << 32); } }
}

__device__ __forceinline__ void attn_naive(const bf16* PROJ, bf16* MIX, const float* gqa, const float* gka, const float* gqb, const float* gkb, const float* sinks, int gtid, int nthr) {
    float mqa = 0.f, mka = 0.f, mqb = 0.f, mkb = 0.f;
    for (int d = 0; d < HD; ++d) { mqa = __builtin_fmaxf(mqa, __builtin_fabsf(gqa[d])); mka = __builtin_fmaxf(mka, __builtin_fabsf(gka[d])); mqb = __builtin_fmaxf(mqb, __builtin_fabsf(gqb[d])); mkb = __builtin_fmaxf(mkb, __builtin_fabsf(gkb[d])); }
    const float shiftA = pg8::C2 * 64.f * mqa * mka, shiftB = pg8::C2 * 64.f * mqb * mkb;
    for (long item = gtid; item < (long)M * 16; item += nthr) {
        const int hh = (int)(item / M), m = (int)(item % M), t = m & (SEQ - 1), rowbase = m - t;
        const bool isA = hh < 8; const int h = hh & 7;
        const int qcol = isA ? COL_QA + h * 64 : COL_QB + h * 64, kcol = isA ? COL_KA + (h >> 2) * 64 : COL_KB + h * 64, vcol = isA ? COL_VA + (h >> 2) * 64 : COL_VB + h * 64;
        const float shift = isA ? shiftA : shiftB;
        float q[64], o[64]; float l = 0.f;
        { const v4u* qp = (const v4u*)(PROJ + (size_t)m * NPROJ + qcol);
#pragma unroll
          for (int c = 0; c < 8; ++c) { const v4u u = qp[c]; q[8 * c + 0] = bf_lo(u.x); q[8 * c + 1] = bf_hi(u.x); q[8 * c + 2] = bf_lo(u.y); q[8 * c + 3] = bf_hi(u.y); q[8 * c + 4] = bf_lo(u.z); q[8 * c + 5] = bf_hi(u.z); q[8 * c + 6] = bf_lo(u.w); q[8 * c + 7] = bf_hi(u.w); } }
#pragma unroll
        for (int d = 0; d < 64; ++d) o[d] = 0.f;
#define KEY(srow, wgt) do { const v4u* kp = (const v4u*)(PROJ + (size_t)(rowbase + (srow)) * NPROJ + kcol); float sc = 0.f; \
        _Pragma("unroll") for (int c = 0; c < 8; ++c) { const v4u u = kp[c]; sc += q[8 * c + 0] * bf_lo(u.x) + q[8 * c + 1] * bf_hi(u.x) + q[8 * c + 2] * bf_lo(u.y) + q[8 * c + 3] * bf_hi(u.y) + q[8 * c + 4] * bf_lo(u.z) + q[8 * c + 5] * bf_hi(u.z) + q[8 * c + 6] * bf_lo(u.w) + q[8 * c + 7] * bf_hi(u.w); } \
        const float p = (wgt) * __builtin_amdgcn_exp2f(sc - shift); l += p; const v4u* vp = (const v4u*)(PROJ + (size_t)(rowbase + (srow)) * NPROJ + vcol); \
        _Pragma("unroll") for (int c = 0; c < 8; ++c) { const v4u u = vp[c]; o[8 * c + 0] += p * bf_lo(u.x); o[8 * c + 1] += p * bf_hi(u.x); o[8 * c + 2] += p * bf_lo(u.y); o[8 * c + 3] += p * bf_hi(u.y); o[8 * c + 4] += p * bf_lo(u.z); o[8 * c + 5] += p * bf_hi(u.z); o[8 * c + 6] += p * bf_lo(u.w); o[8 * c + 7] += p * bf_hi(u.w); } } while (0)
        if (isA) {
            for (int dist = 0; dist <= 127 && dist <= t; ++dist) KEY(t - dist, 1.0f);
            l += __builtin_amdgcn_exp2f(sinks[h] * 1.4426950408889634f - shift);
        } else {
            for (int dist = 0; dist <= 128 && dist <= t; ++dist) { const float w = 1.0f + (((dist & 3) == 0) ? 1.0f : 0.0f) + (((dist & 15) == 0) ? 1.0f : 0.0f); KEY(t - dist, w); }
            for (int dist = 132; dist <= 512 && dist <= t; dist += 4) { const float w = 1.0f + (((dist & 15) == 0) ? 1.0f : 0.0f); KEY(t - dist, w); }
            for (int dist = 528; dist <= t; dist += 16) KEY(t - dist, 1.0f);
        }
#undef KEY
        const float rl = 1.0f / l;
        v4u* op = (v4u*)(MIX + (size_t)m * D + hh * 64);
#pragma unroll
        for (int c = 0; c < 8; ++c) { v4u u; u.x = pk2(o[8 * c + 0] * rl, o[8 * c + 1] * rl); u.y = pk2(o[8 * c + 2] * rl, o[8 * c + 3] * rl); u.z = pk2(o[8 * c + 4] * rl, o[8 * c + 5] * rl); u.w = pk2(o[8 * c + 6] * rl, o[8 * c + 7] * rl); op[c] = u; }
    }
}


typedef short a_bf16x8 __attribute__((ext_vector_type(8)));
typedef short a_s16x4 __attribute__((ext_vector_type(4)));
typedef float a_f32x16 __attribute__((ext_vector_type(16)));
typedef float a_f32x2 __attribute__((ext_vector_type(2)));
typedef __bf16 a_bf16x2 __attribute__((ext_vector_type(2)));
__device__ __forceinline__ unsigned a_cvtpk(float lo, float hi) { a_f32x2 v = {lo, hi}; a_bf16x2 b = __builtin_convertvector(v, a_bf16x2); return __builtin_bit_cast(unsigned, b); }
__device__ __forceinline__ a_s16x4 a_vtr(LAS const unsigned char* p) { return __builtin_bit_cast(a_s16x4, __builtin_amdgcn_ds_read_tr16_b64_v4i16((LAS a_s16x4*)p)); }
constexpr int ATT_WLDS = 16384;
constexpr int ATT_STG = 8192, ATT_STG_PITCH = 144;

struct AttnTask { int qrow0, qrs, qcol, kcol, vcol, n1, row1, D01, kt2lo, kt2hi, row2, D02, qstep2, maxd2, orow0, ors, ocol; float shift, sinkterm; };

__device__ __forceinline__ void attn_task(const bf16* __restrict__ PROJ, bf16* __restrict__ MIX, LAS unsigned char* wl, const int lane, const AttnTask& T) {
    const int i = lane & 31, hh = lane >> 5;
    a_bf16x8 qf[4];
    { const bf16* qp = PROJ + (size_t)(T.qrow0 + i * T.qrs) * NPROJ + T.qcol + 8 * hh;
#pragma unroll
      for (int s = 0; s < 4; ++s) qf[s] = *(const a_bf16x8*)(qp + 16 * s); }
    a_f32x16 o0 = {}, o1 = {}; float lsum = 0.f;
    const int Dl1 = T.D01 + i - 4 * hh, Dl2 = T.D02 + T.qstep2 * i - 4 * hh;
    float wg[4];
#pragma unroll
    for (int c = 0; c < 4; ++c) wg[c] = ((Dl1 & 3) == c) ? 1.0f : 0.0f;
    const int nt = T.n1 + (T.kt2hi - T.kt2lo);
    const int klane = i * NPROJ + 8 * hh, vlane = (lane >> 3) * NPROJ + (lane & 7) * 8;
    LAS unsigned char* vw = wl + ((lane & 7) >> 2) * 2048 + (lane >> 3) * 64 + (lane & 3) * 16;
    LAS const unsigned char* tra = wl + (4 * hh + ((lane & 15) >> 2)) * 64 + ((lane >> 4) & 1) * 32 + (lane & 3) * 8;
    a_f32x16 negs;
#pragma unroll
    for (int r = 0; r < 16; ++r) negs[r] = -T.shift;
    v4u kn[4]; v4u vn[4];
#define ATT_LOAD(j) do { const int seg1_ = (j) < T.n1; const int kt_ = seg1_ ? (j) : T.kt2lo + ((j) - T.n1); const int row_ = seg1_ ? T.row1 + 128 * kt_ : T.row2 + 32 * kt_; const int rs_ = seg1_ ? 4 : 1; \
        const bf16* kb_ = PROJ + (size_t)row_ * NPROJ + T.kcol + (size_t)(vlane - (lane & 7) * 8) * rs_ + (lane & 7) * 8; const bf16* vb_ = PROJ + (size_t)row_ * NPROJ + T.vcol + (size_t)(vlane - (lane & 7) * 8) * rs_ + (lane & 7) * 8; \
        _Pragma("unroll") for (int jj = 0; jj < 4; ++jj) kn[jj] = *(const v4u*)(kb_ + (size_t)(8 * jj * rs_) * NPROJ); \
        _Pragma("unroll") for (int jj = 0; jj < 4; ++jj) vn[jj] = *(const v4u*)(vb_ + (size_t)(8 * jj * rs_) * NPROJ); } while (0)
    ATT_LOAD(0);
    for (int j = 0; j < nt; ++j) {
        v4u kr[4]; v4u vr[4];
#pragma unroll
        for (int s = 0; s < 4; ++s) { kr[s] = kn[s]; vr[s] = vn[s]; }
        if (j + 1 < nt) ATT_LOAD(j + 1);
        const bool seg1 = j < T.n1; const int kt = seg1 ? j : T.kt2lo + (j - T.n1);
        const int Dt = (seg1 ? Dl1 : Dl2) - 32 * kt;
        const int D0 = (seg1 ? T.D01 : T.D02) - 32 * kt, qst = seg1 ? 1 : T.qstep2, maxd = seg1 ? 128 : T.maxd2;
        const int dpmin = D0 - 31, dpmax = D0 + 31 * qst;
        const int cls = (dpmin >= 0 && dpmax <= maxd) ? 1 : (dpmin > maxd ? 2 : 0);
#pragma unroll
        for (int jj = 0; jj < 4; ++jj) *(LAS v4u*)(vw + 512 * jj) = vr[jj];
#pragma unroll
        for (int jj = 0; jj < 4; ++jj) *(LAS v4u*)(wl + 4096 + (lane & 7) * 512 + (((8 * jj + (lane >> 3)) ^ (lane & 7)) * 16)) = kr[jj];
        a_bf16x8 kf[4];
#pragma unroll
        for (int s = 0; s < 4; ++s) kf[s] = *(LAS const a_bf16x8*)(wl + 4096 + (2 * s + hh) * 512 + ((i ^ (2 * s + hh)) * 16));
        a_f32x16 S = negs;
#pragma unroll
        for (int s = 0; s < 4; ++s) S = __builtin_amdgcn_mfma_f32_32x32x16_bf16(kf[s], qf[s], S, 0, 0, 0);
        float p[16];
        float wm[4];
#pragma unroll
        for (int c = 0; c < 4; ++c) wm[c] = seg1 ? wg[c] : 0.0f;
        if (cls == 1) {
#pragma unroll
            for (int r = 0; r < 16; ++r) p[r] = (1.0f + wm[r & 3]) * __builtin_amdgcn_exp2f(S[r]);
        } else if (cls == 2) {
#pragma unroll
            for (int r = 0; r < 16; ++r) p[r] = wm[r & 3] * __builtin_amdgcn_exp2f(S[r]);
        } else {
#pragma unroll
            for (int r = 0; r < 16; ++r) { const int dp = Dt - ((r & 3) + 8 * (r >> 2));
                const float w = (((unsigned)dp <= (unsigned)maxd) ? 1.0f : 0.0f) + ((dp >= 0) ? wm[r & 3] : 0.0f);
                p[r] = w * __builtin_amdgcn_exp2f(S[r]); }
        }
        float ls = 0.f;
#pragma unroll
        for (int r = 0; r < 16; ++r) ls += p[r];
        lsum += ls;
        a_bf16x8 pb0, pb1;
        { v4u w0, w1; w0.x = a_cvtpk(p[0], p[1]); w0.y = a_cvtpk(p[2], p[3]); w0.z = a_cvtpk(p[4], p[5]); w0.w = a_cvtpk(p[6], p[7]);
          w1.x = a_cvtpk(p[8], p[9]); w1.y = a_cvtpk(p[10], p[11]); w1.z = a_cvtpk(p[12], p[13]); w1.w = a_cvtpk(p[14], p[15]);
          pb0 = __builtin_bit_cast(a_bf16x8, w0); pb1 = __builtin_bit_cast(a_bf16x8, w1); }
        {
            a_s16x4 lo, hi;
#define ATT_VF (a_bf16x8){lo[0], lo[1], lo[2], lo[3], hi[0], hi[1], hi[2], hi[3]}
            lo = a_vtr(tra);               hi = a_vtr(tra + 512);               o0 = __builtin_amdgcn_mfma_f32_32x32x16_bf16(ATT_VF, pb0, o0, 0, 0, 0);
            lo = a_vtr(tra + 1024);        hi = a_vtr(tra + 1024 + 512);        o0 = __builtin_amdgcn_mfma_f32_32x32x16_bf16(ATT_VF, pb1, o0, 0, 0, 0);
            lo = a_vtr(tra + 2048);        hi = a_vtr(tra + 2048 + 512);        o1 = __builtin_amdgcn_mfma_f32_32x32x16_bf16(ATT_VF, pb0, o1, 0, 0, 0);
            lo = a_vtr(tra + 2048 + 1024); hi = a_vtr(tra + 2048 + 1024 + 512); o1 = __builtin_amdgcn_mfma_f32_32x32x16_bf16(ATT_VF, pb1, o1, 0, 0, 0);
#undef ATT_VF
        }
    }
#undef ATT_LOAD
    const float ltot = lsum + __shfl_xor(lsum, 32) + T.sinkterm;
    const float rl = 1.0f / ltot;
    LAS unsigned char* stg = wl + ATT_STG;
#pragma unroll
    for (int g = 0; g < 4; ++g) {
        typedef unsigned u32x2_t __attribute__((ext_vector_type(2)));
        u32x2_t a, b2;
        a.x = a_cvtpk(o0[4 * g] * rl, o0[4 * g + 1] * rl); a.y = a_cvtpk(o0[4 * g + 2] * rl, o0[4 * g + 3] * rl);
        b2.x = a_cvtpk(o1[4 * g] * rl, o1[4 * g + 1] * rl); b2.y = a_cvtpk(o1[4 * g + 2] * rl, o1[4 * g + 3] * rl);
        *(LAS u32x2_t*)(stg + i * ATT_STG_PITCH + (8 * g + 4 * hh) * 2) = a;
        *(LAS u32x2_t*)(stg + i * ATT_STG_PITCH + (32 + 8 * g + 4 * hh) * 2) = b2;
    }
#pragma unroll
    for (int jj = 0; jj < 4; ++jj) { const int row = jj * 8 + (lane >> 3), ch = lane & 7;
        const v4u v = *(LAS const v4u*)(stg + row * ATT_STG_PITCH + ch * 16);
        *(v4u*)(MIX + (size_t)(T.orow0 + row * T.ors) * D + T.ocol + ch * 8) = v; }
}

__device__ __forceinline__ void attn_phase(const bf16* PROJ, bf16* MIX, const float* gqa, const float* gka, const float* gqb, const float* gkb, const float* sinks, LAS unsigned char* lds, int vcu, int G, int wave, int lane) {
    const float mqa = wave_max(__builtin_fabsf(gqa[lane])), mka = wave_max(__builtin_fabsf(gka[lane])), mqb = wave_max(__builtin_fabsf(gqb[lane])), mkb = wave_max(__builtin_fabsf(gkb[lane]));
    const float shiftA = pg8::C2 * 64.f * mqa * mka, shiftB = pg8::C2 * 64.f * mqb * mkb;
    LAS unsigned char* wl = lds + wave * ATT_WLDS;
    for (int v = vcu; v < BATCH * 8; v += G) {
        const int b = v >> 3, h = v & 7, rowb = b * SEQ;
        for (int k = 0; k < 16; ++k) {
            AttnTask T;
            if (k < 8) {
                const int r = wave & 3, half = wave >> 2, pr = 2 * (k >> 1) + half, c = (k & 1) ? 15 - pr : pr;
                T.qrow0 = rowb + 128 * c + r; T.qrs = 4; T.qcol = COL_QB + h * 64; T.kcol = COL_KB + h * 64; T.vcol = COL_VB + h * 64;
                T.n1 = c + 1; T.row1 = rowb + r; T.D01 = 32 * c;
                T.kt2lo = (c == 0) ? 4 : 0; T.kt2hi = 8; T.row2 = rowb + 128 * c - 128; T.D02 = 128 + r; T.qstep2 = 4; T.maxd2 = 128;
                T.orow0 = T.qrow0; T.ors = 4; T.ocol = 512 + h * 64; T.shift = shiftB; T.sinkterm = 0.f;
            } else {
                const int c = wave + 8 * (k - 8);
                T.qrow0 = rowb + 32 * c; T.qrs = 1; T.qcol = COL_QA + h * 64; T.kcol = COL_KA + (h >> 2) * 64; T.vcol = COL_VA + (h >> 2) * 64;
                T.n1 = 0; T.row1 = rowb; T.D01 = 0;
                T.kt2lo = (c < 4) ? 4 - c : 0; T.kt2hi = 5; T.row2 = rowb + 32 * c - 128; T.D02 = 128; T.qstep2 = 1; T.maxd2 = 127;
                T.orow0 = T.qrow0; T.ors = 1; T.ocol = h * 64; T.shift = shiftA; T.sinkterm = __builtin_amdgcn_exp2f(sinks[h] * 1.4426950408889634f - shiftA);
            }
            attn_task(PROJ, MIX, wl, lane, T);
        }
    }
}


constexpr int A2_SLOT = 32768, A2_STG = 98304, A2_STG_W = 4608, A2_NROUNDS = 72 + 23;
struct RIter { int ph, p, k; };
__device__ __forceinline__ void ri_next(RIter& it) { it.k++; const int n = (it.ph == 0) ? 2 * it.p + 2 : ((it.p == 0) ? 2 : 3); if (it.k == n) { it.k = 0; it.p++; if (it.p == 8) { it.p = 0; it.ph++; } } }
__device__ __forceinline__ int ri_blk(const RIter& it) { return (it.ph == 0) ? it.k : ((it.p == 0) ? it.k : 2 * it.p - 1 + it.k); }

__device__ __forceinline__ void attn_phase2(const bf16* __restrict__ PROJ, bf16* __restrict__ MIX, const float* sinks,
                                            LAS unsigned char* lds, int vcu, int G, int wave, int lane, const int mode) {
    const int i = lane & 31, hh = lane >> 5, r = wave & 3, grp = wave >> 2;
    const float NINF = -__builtin_inff();
    unsigned offK[2], offV[2];
#pragma unroll
    for (int j = 0; j < 2; ++j) { const int n = 2 * wave + j, slot = 8 * n + (lane >> 3), cp = lane & 7;
        const int rk = slot ^ ((slot >> 4) & 3), ch = cp ^ ((slot >> 1) & 7); offK[j] = (unsigned)(rk * NPROJ + ch * 8);
        const int rv = slot ^ ((slot >> 2) & 3), dh = (cp >> 2) ^ ((slot >> 1) & 1); offV[j] = (unsigned)(rv * NPROJ + dh * 32 + (cp & 3) * 8); }
    int k1[4], ke[4], ko[4], v1[2], v2[4];
    { const int rho = 4 * i + r, slot = rho ^ ((rho >> 4) & 3), sw = (slot >> 1) & 7;
#pragma unroll
      for (int s = 0; s < 4; ++s) k1[s] = slot * 128 + (((2 * s + hh) ^ sw) * 16); }
    { const int xe = i ^ (i >> 4), xo = i ^ (2 | (i >> 4));
#pragma unroll
      for (int s = 0; s < 4; ++s) { ke[s] = xe * 128 + (((2 * s + hh) ^ ((xe >> 1) & 7)) * 16); ko[s] = xo * 128 + (((2 * s + hh) ^ ((xo >> 1) & 7)) * 16); } }
    { const int q4 = (lane & 15) >> 2, g = (lane >> 4) & 1, pp = lane & 3;
#pragma unroll
      for (int dh = 0; dh < 2; ++dh) { const int sl = 16 * hh + 4 * q4 + (r ^ q4); v1[dh] = 16384 + sl * 128 + ((dh ^ ((sl >> 1) & 1)) * 64) + g * 32 + pp * 8; }
#pragma unroll
      for (int x = 0; x < 4; ++x) { const int dh = x >> 1, e = x & 1, kk = 8 * e + 4 * hh + q4, sl = kk ^ ((kk >> 2) & 3); v2[x] = 16384 + sl * 128 + ((dh ^ ((sl >> 1) & 1)) * 64) + g * 32 + pp * 8; } }
    a_f32x16 c1F, c1R;
#pragma unroll
    for (int q = 0; q < 16; ++q) { const bool mt = ((q & 3) == (i & 3)); c1F[q] = mt ? 1.0f : 0.0f; c1R[q] = mt ? 0.0f : NINF; }
    LAS unsigned char* stg = lds + A2_STG + wave * A2_STG_W;
#define A2_WAIT_V(n) asm volatile("s_waitcnt vmcnt(" #n ")" ::: "memory")
#define A2_OFFQ(q) (((q) & 3) + 8 * ((q) >> 2))
#define A2_CHAIN(S, C, KA) do { a_bf16x8 kf0_ = *(LAS const a_bf16x8*)(lds + (KA)[0]), kf1_ = *(LAS const a_bf16x8*)(lds + (KA)[1]), kf2_ = *(LAS const a_bf16x8*)(lds + (KA)[2]), kf3_ = *(LAS const a_bf16x8*)(lds + (KA)[3]); \
        S = __builtin_amdgcn_mfma_f32_32x32x16_bf16(kf0_, qf[0], C, 0, 0, 0); S = __builtin_amdgcn_mfma_f32_32x32x16_bf16(kf1_, qf[1], S, 0, 0, 0); \
        S = __builtin_amdgcn_mfma_f32_32x32x16_bf16(kf2_, qf[2], S, 0, 0, 0); S = __builtin_amdgcn_mfma_f32_32x32x16_bf16(kf3_, qf[3], S, 0, 0, 0); } while (0)
#define A2_TAIL(S, VA) do { float p_[16]; _Pragma("unroll") for (int q = 0; q < 16; ++q) p_[q] = __builtin_amdgcn_exp2f(S[q]); \
        lsum += ((p_[0] + p_[1]) + (p_[2] + p_[3])) + ((p_[4] + p_[5]) + (p_[6] + p_[7])) + (((p_[8] + p_[9]) + (p_[10] + p_[11])) + ((p_[12] + p_[13]) + (p_[14] + p_[15]))); \
        a_bf16x8 pb0_, pb1_; { v4u w0_, w1_; w0_.x = a_cvtpk(p_[0], p_[1]); w0_.y = a_cvtpk(p_[2], p_[3]); w0_.z = a_cvtpk(p_[4], p_[5]); w0_.w = a_cvtpk(p_[6], p_[7]); \
          w1_.x = a_cvtpk(p_[8], p_[9]); w1_.y = a_cvtpk(p_[10], p_[11]); w1_.z = a_cvtpk(p_[12], p_[13]); w1_.w = a_cvtpk(p_[14], p_[15]); \
          pb0_ = __builtin_bit_cast(a_bf16x8, w0_); pb1_ = __builtin_bit_cast(a_bf16x8, w1_); } \
        a_s16x4 lo_, hi_; \
        lo_ = a_vtr(lds + VA(0, 0, 0)); hi_ = a_vtr(lds + VA(0, 0, 1)); o0 = __builtin_amdgcn_mfma_f32_32x32x16_bf16((a_bf16x8){lo_[0], lo_[1], lo_[2], lo_[3], hi_[0], hi_[1], hi_[2], hi_[3]}, pb0_, o0, 0, 0, 0); \
        lo_ = a_vtr(lds + VA(0, 1, 0)); hi_ = a_vtr(lds + VA(0, 1, 1)); o0 = __builtin_amdgcn_mfma_f32_32x32x16_bf16((a_bf16x8){lo_[0], lo_[1], lo_[2], lo_[3], hi_[0], hi_[1], hi_[2], hi_[3]}, pb1_, o0, 0, 0, 0); \
        lo_ = a_vtr(lds + VA(1, 0, 0)); hi_ = a_vtr(lds + VA(1, 0, 1)); o1 = __builtin_amdgcn_mfma_f32_32x32x16_bf16((a_bf16x8){lo_[0], lo_[1], lo_[2], lo_[3], hi_[0], hi_[1], hi_[2], hi_[3]}, pb0_, o1, 0, 0, 0); \
        lo_ = a_vtr(lds + VA(1, 1, 0)); hi_ = a_vtr(lds + VA(1, 1, 1)); o1 = __builtin_amdgcn_mfma_f32_32x32x16_bf16((a_bf16x8){lo_[0], lo_[1], lo_[2], lo_[3], hi_[0], hi_[1], hi_[2], hi_[3]}, pb1_, o1, 0, 0, 0); } while (0)
    for (int v = vcu; v < BATCH * 8; v += G) {
        const int b = v >> 3, h = v & 7, rowb = b * SEQ;
        const float sinkterm = __builtin_amdgcn_exp2f(sinks[h] * 1.4426950408889634f);
#define A2_ISSUE(it, sl) do { const int blk_ = ri_blk(it); const bf16* kb_ = PROJ + (size_t)(rowb + 128 * blk_) * NPROJ + ((it).ph == 0 ? COL_KB + h * 64 : COL_KA + (h >> 2) * 64); \
        const bf16* vb_ = PROJ + (size_t)(rowb + 128 * blk_) * NPROJ + ((it).ph == 0 ? COL_VB + h * 64 : COL_VA + (h >> 2) * 64); \
        _Pragma("unroll") for (int j_ = 0; j_ < 2; ++j_) { \
            __builtin_amdgcn_global_load_lds((const unsigned*)(kb_ + offK[j_]), (LAS unsigned*)(lds + (sl) * A2_SLOT + (2 * wave + j_) * 1024), 16, 0, 0); \
            __builtin_amdgcn_global_load_lds((const unsigned*)(vb_ + offV[j_]), (LAS unsigned*)(lds + (sl) * A2_SLOT + 16384 + (2 * wave + j_) * 1024), 16, 0, 0); } } while (0)
        RIter cons = {0, 0, 0}, iss = {0, 0, 0};
        if (mode != 2) A2_ISSUE(iss, 0); ri_next(iss); if (mode != 2) A2_ISSUE(iss, 1); ri_next(iss);
        int slot = 0, islot = 2;
        a_bf16x8 qf[4]; a_f32x16 o0 = {}, o1 = {}; float lsum = 0.f;
#pragma unroll
        for (int s = 0; s < 4; ++s) qf[s] = (a_bf16x8){0, 0, 0, 0, 0, 0, 0, 0};
        for (int round = 0; round < A2_NROUNDS; ++round) {
            if (round + 1 < A2_NROUNDS) A2_WAIT_V(4); else A2_WAIT_V(0);
            __builtin_amdgcn_s_barrier(); asm volatile("" ::: "memory");
            if (iss.ph < 2) { if (mode != 2) A2_ISSUE(iss, islot); ri_next(iss); }
            islot = (islot == 2) ? 0 : islot + 1;
            const bool isB = cons.ph == 0;
            const int cw = isB ? 2 * cons.p + grp : 8 * cons.p + wave;
            const int blk = ri_blk(cons);
            const int nr = isB ? 2 * cons.p + 2 : ((cons.p == 0) ? 2 : 3);
            const bool first = cons.k == 0, last = isB ? (blk == cw) : (cons.k == nr - 1);
            const int qrow0 = isB ? rowb + 128 * cw + r : rowb + 32 * cw, qrs = isB ? 4 : 1;
            if (first && mode != 1) {
                const bf16* qp = PROJ + (size_t)(qrow0 + i * qrs) * NPROJ + (isB ? COL_QB : COL_QA) + h * 64 + 8 * hh;
#pragma unroll
                for (int s = 0; s < 4; ++s) qf[s] = *(const a_bf16x8*)(qp + 16 * s);
#pragma unroll
                for (int s = 0; s < 4; ++s) asm volatile("" : "+v"(qf[s]));
                o0 = (a_f32x16){}; o1 = (a_f32x16){}; lsum = 0.f;
            }
            const int sbo = slot * A2_SLOT;
            if (mode != 1) {
            if (isB && blk <= cw) {
                const int d = cw - blk;
                int ka[4];
#pragma unroll
                for (int s = 0; s < 4; ++s) ka[s] = k1[s] + sbo;
                a_f32x16 S;
                if (d >= 5) { A2_CHAIN(S, c1R, ka); }
                else if (d >= 1 && d <= 3) { A2_CHAIN(S, c1F, ka); }
                else { const int Dt = 32 * d + i - 4 * hh; a_f32x16 C;
                    if (d == 0) {
#pragma unroll
                        for (int q = 0; q < 16; ++q) C[q] = (A2_OFFQ(q) <= Dt) ? c1F[q] : NINF;
                    } else {
#pragma unroll
                        for (int q = 0; q < 16; ++q) C[q] = (A2_OFFQ(q) >= Dt - 128) ? c1F[q] : c1R[q];
                    }
                    A2_CHAIN(S, C, ka); }
                const int vb0 = v1[0] + sbo, vb1 = v1[1] + sbo;
#define A2_VA1(dh, sp, e) (((dh) ? vb1 : vb0) + (sp) * 8192 + (e) * 4096)
                A2_TAIL(S, A2_VA1);
#undef A2_VA1
            }
            int t2lo, t2hi, lo0, maxd;
            if (isB) { t2lo = 0; t2hi = (blk == cw || blk == cw - 1) ? 4 : 0; maxd = 128; lo0 = r - ((blk == cw) ? 128 : 0) + 4 * i - 4 * hh; }
            else { const int t0 = 4 * blk; t2lo = (cw - 4 - t0) > 0 ? (cw - 4 - t0) : 0; t2hi = (cw - t0 + 1) < 4 ? (cw - t0 + 1) : 4; maxd = 127; lo0 = 32 * (cw - t0) + i - 4 * hh - 127; }
#define A2_MASKC(C, LO) do { _Pragma("unroll") for (int q = 0; q < 16; ++q) C[q] = ((unsigned)(A2_OFFQ(q) - (LO)) <= (unsigned)maxd) ? 0.0f : NINF; } while (0)
            int t2 = t2lo;
            for (; t2 + 1 < t2hi; t2 += 2) {
                const int tba = sbo + t2 * 4096, tbb = tba + 4096;
                int kaa[4], kab[4];
#pragma unroll
                for (int s = 0; s < 4; ++s) { kaa[s] = ((t2 & 1) ? ko[s] : ke[s]) + tba; kab[s] = ((t2 & 1) ? ke[s] : ko[s]) + tbb; }
                a_f32x16 Ca, Cb, Sa, Sb;
                A2_MASKC(Ca, lo0 - 32 * t2); A2_MASKC(Cb, lo0 - 32 * t2 - 32);
                { a_bf16x8 fa0 = *(LAS const a_bf16x8*)(lds + kaa[0]), fb0 = *(LAS const a_bf16x8*)(lds + kab[0]), fa1 = *(LAS const a_bf16x8*)(lds + kaa[1]), fb1 = *(LAS const a_bf16x8*)(lds + kab[1]);
                  a_bf16x8 fa2 = *(LAS const a_bf16x8*)(lds + kaa[2]), fb2 = *(LAS const a_bf16x8*)(lds + kab[2]), fa3 = *(LAS const a_bf16x8*)(lds + kaa[3]), fb3 = *(LAS const a_bf16x8*)(lds + kab[3]);
                  Sa = __builtin_amdgcn_mfma_f32_32x32x16_bf16(fa0, qf[0], Ca, 0, 0, 0); Sb = __builtin_amdgcn_mfma_f32_32x32x16_bf16(fb0, qf[0], Cb, 0, 0, 0);
                  Sa = __builtin_amdgcn_mfma_f32_32x32x16_bf16(fa1, qf[1], Sa, 0, 0, 0); Sb = __builtin_amdgcn_mfma_f32_32x32x16_bf16(fb1, qf[1], Sb, 0, 0, 0);
                  Sa = __builtin_amdgcn_mfma_f32_32x32x16_bf16(fa2, qf[2], Sa, 0, 0, 0); Sb = __builtin_amdgcn_mfma_f32_32x32x16_bf16(fb2, qf[2], Sb, 0, 0, 0);
                  Sa = __builtin_amdgcn_mfma_f32_32x32x16_bf16(fa3, qf[3], Sa, 0, 0, 0); Sb = __builtin_amdgcn_mfma_f32_32x32x16_bf16(fb3, qf[3], Sb, 0, 0, 0); }
                const int vx0 = v2[0] + tba, vx1 = v2[1] + tba, vx2 = v2[2] + tba, vx3 = v2[3] + tba;
#define A2_VA2(dh, sp, e) (((dh) ? ((e) ? vx3 : vx2) : ((e) ? vx1 : vx0)) + (sp) * 2048)
#define A2_VA2B(dh, sp, e) (((dh) ? ((e) ? vx3 : vx2) : ((e) ? vx1 : vx0)) + (sp) * 2048 + 4096)
                A2_TAIL(Sa, A2_VA2);
                A2_TAIL(Sb, A2_VA2B);
#undef A2_VA2B
#undef A2_VA2
            }
            if (t2 < t2hi) {
                const int tbo = sbo + t2 * 4096;
                int ka[4];
#pragma unroll
                for (int s = 0; s < 4; ++s) ka[s] = ((t2 & 1) ? ko[s] : ke[s]) + tbo;
                a_f32x16 C, S;
                A2_MASKC(C, lo0 - 32 * t2);
                A2_CHAIN(S, C, ka);
                const int vx0 = v2[0] + tbo, vx1 = v2[1] + tbo, vx2 = v2[2] + tbo, vx3 = v2[3] + tbo;
#define A2_VA2(dh, sp, e) (((dh) ? ((e) ? vx3 : vx2) : ((e) ? vx1 : vx0)) + (sp) * 2048)
                A2_TAIL(S, A2_VA2);
#undef A2_VA2
            }
#undef A2_MASKC
            }
            if (last && mode != 1) {
                const float ltot = lsum + __shfl_xor(lsum, 32) + (isB ? 0.f : sinkterm);
                const float rl = 1.0f / ltot;
#pragma unroll
                for (int g = 0; g < 4; ++g) {
                    typedef unsigned u32x2_t __attribute__((ext_vector_type(2)));
                    u32x2_t a, b2;
                    a.x = a_cvtpk(o0[4 * g] * rl, o0[4 * g + 1] * rl); a.y = a_cvtpk(o0[4 * g + 2] * rl, o0[4 * g + 3] * rl);
                    b2.x = a_cvtpk(o1[4 * g] * rl, o1[4 * g + 1] * rl); b2.y = a_cvtpk(o1[4 * g + 2] * rl, o1[4 * g + 3] * rl);
                    *(LAS u32x2_t*)(stg + i * ATT_STG_PITCH + (8 * g + 4 * hh) * 2) = a;
                    *(LAS u32x2_t*)(stg + i * ATT_STG_PITCH + (32 + 8 * g + 4 * hh) * 2) = b2;
                }
                const int ocol = isB ? 512 + h * 64 : h * 64;
#pragma unroll
                for (int jj = 0; jj < 4; ++jj) { const int row = jj * 8 + (lane >> 3), ch = lane & 7;
                    const v4u vv = *(LAS const v4u*)(stg + row * ATT_STG_PITCH + ch * 16);
                    if (mode == 0) *(v4u*)(MIX + (size_t)(qrow0 + row * qrs) * D + ocol + ch * 8) = vv; else asm volatile("" :: "v"(vv)); }
            }
            slot = (slot == 2) ? 0 : slot + 1; ri_next(cons);
        }
        A2_WAIT_V(0); __builtin_amdgcn_s_barrier(); asm volatile("" ::: "memory");
#undef A2_ISSUE
    }
#undef A2_WAIT_V
#undef A2_OFFQ
#undef A2_CHAIN
#undef A2_TAIL
}

struct Args { const float* in[13]; float* out; unsigned char* ws; int ph_lo, ph_hi, li, pad; };
__global__ void __launch_bounds__(NWAVES * 64, 2) hymba_fwd(Args args) {
    extern __shared__ __attribute__((aligned(16))) unsigned char lds[];
    LAS unsigned char* L = (LAS unsigned char*)lds;
    volatile LAS unsigned* MISC = (volatile LAS unsigned*)(L + MISC_OFF);
    const int tid = threadIdx.x, lane = tid & 63, wave = __builtin_amdgcn_readfirstlane(tid >> 6);
    const int G = gridDim.x; const int bx = blockIdx.x; const int vcu = (G % 8 == 0) ? (bx % 8) * (G / 8) + bx / 8 : bx;
    unsigned char* ws = args.ws;
    gu32* ctl = (gu32*)(ws + WS_CTL);
    const float* x = args.in[0]; const int* positions = (const int*)args.in[1]; const float* g_attn = args.in[2]; const float* w_in = args.in[3];
    const float* gqa = args.in[4]; const float* gka = args.in[5]; const float* sinks = args.in[6]; const float* gqb = args.in[7]; const float* gkb = args.in[8];
    const float* w_out = args.in[9]; const float* g_mlp = args.in[10]; const float* w_up = args.in[11]; const float* w_dn = args.in[12];
    float* out = args.out;
    bf16* Win_t = (bf16*)(ws + WS_WIN); bf16* Wout_t = (bf16*)(ws + WS_WOUT); bf16* Wup_t = (bf16*)(ws + WS_WUP); bf16* Wdn_t = (bf16*)(ws + WS_WDN);
    float* rope = (float*)(ws + WS_ROPE); float* ssp = (float*)(ws + WS_SS);
    bf16* XN = (bf16*)(ws + WS_XN); bf16* PROJ = (bf16*)(ws + WS_PROJ); bf16* MIXB = (bf16*)(ws + WS_MIX); bf16* HID = (bf16*)(ws + WS_HID);
    for (int u = tid; u < (LDS_BYTES - LDSCTL_OFF) / 4; u += NWAVES * 64) ((LAS unsigned*)(L + LDSCTL_OFF))[u] = 0u;
    __syncthreads();
    const int bli = (N_LAUNCHES == PER_PHASE) ? 0 : args.li;
    XcdBarrier bar; bar.bar = (unsigned*)(ctl + CW_BAR) + bli * XCD_BAR_WORDS; bar.x = 0; bar.st = nullptr;
    if (N_LAUNCHES != PER_PHASE) bar = xcd_barrier_post((unsigned*)(ctl + CW_BAR) + bli * XCD_BAR_WORDS, MISC + 8);
#define GRID_BAR(seam) do { if (N_LAUNCHES == PER_PHASE) { if (tid == 0) __hip_atomic_store(ctl + CW_TMO, 0xBADBA0u | (unsigned)(seam), RLX_AGENT); } else { xcd_barrier(bar); } } while (0)
    const int lo = args.ph_lo, hi = args.ph_hi;
#define IN(k) (lo <= (k) && (k) < hi)
#define BOTH(k) (IN(k) && IN((k) + 1))

    if (IN(0)) { REP(0) {
        LAS float* scr = (LAS float*)(L + RING_OFF + wave * 16384);
        const int gw = vcu * NWAVES + wave, NGW = G * NWAVES;
        constexpr int I_IN = (D / 64) * (NPROJ / 32), I_OUT = (D / 64) * (D / 32), I_UP = (D / 64) * (FF / 32), I_DN = (FF / 64) * (D / 32);
        constexpr int NITEMS = I_IN + I_OUT + I_UP + I_DN;
        for (int it = gw; it < NITEMS; it += NGW) {
            int r = it;
            if (r < I_IN) { p0_transpose_item(w_in, D, NPROJ, Win_t, nullptr, scr, r, lane); continue; } r -= I_IN;
            if (r < I_OUT) { p0_transpose_item(w_out, D, D, Wout_t, nullptr, scr, r, lane); continue; } r -= I_OUT;
            if (r < I_UP) { p0_transpose_item(w_up, D, FF, Wup_t, g_mlp, scr, r, lane); continue; } r -= I_UP;
            p0_transpose_item(w_dn, FF, D, Wdn_t, nullptr, scr, r, lane);
        }
        for (int m = gw * 4; m < M; m += NGW * 4) rms_rows_to_bf16<4>(x + (size_t)m * D, g_attn, XN + (size_t)m * D, lane);
        for (int it = gw * 64 + lane; it < M * 8; it += NGW * 64) {
            const int m = it >> 3, i = it & 7;
            const float inv_freq = (i == 0) ? 1.0f : (i == 1) ? 0.193922743f : (i == 2) ? 0.0376060307f : (i == 3) ? 0.00729266461f : (i == 4) ? 0.00141421356f : (i == 5) ? 0.000274248188f : (i == 6) ? 5.3182961e-05f : 1.03133862e-05f;
            const float ang = (float)positions[m] * inv_freq;
            double rev = (double)ang * 0.15915494309189535; rev -= __builtin_floor(rev);
            const float rf = (float)rev;
            rope[(size_t)m * 16 + i] = __builtin_amdgcn_cosf(rf); rope[(size_t)m * 16 + 8 + i] = __builtin_amdgcn_sinf(rf);
        }
        }
        if (BOTH(0)) GRID_BAR(0);
    }
    if (IN(1)) {
        pg8::Gemm g{XN, Win_t, M, NPROJ, D}; pg8::StaticOrder S; S.init(M, NPROJ, G, (int)blockIdx.x);
        pg8::EpiQKV E{PROJ, NPROJ, gqa, gka, gqb, gkb, rope};
        REP(1) pg8::gemm_phase<pg8::EpiQKV, pg8::StaticOrder, true>(L + RING_OFF, g, S, E);
        if (BOTH(1)) GRID_BAR(1);
    }
    if (IN(2)) {
#if defined(NAIVE_ATTN)
        attn_naive(PROJ, MIXB, gqa, gka, gqb, gkb, sinks, vcu * (NWAVES * 64) + tid, G * NWAVES * 64);
#else
#if defined(ATTN_V1)
        REP(2) attn_phase(PROJ, MIXB, gqa, gka, gqb, gkb, sinks, L + RING_OFF, vcu, G, wave, lane);
#else
        REP(2) attn_phase2(PROJ, MIXB, sinks, L + RING_OFF, vcu, G, wave, lane, rep_ == 0 ? 0 : PROBE_MODE);
#endif
#endif
        if (BOTH(2)) GRID_BAR(2);
    }
    if (IN(3)) {
        pg8::Gemm g{MIXB, Wout_t, M, D, D}; pg8::StaticOrder S; S.init(M, D, G, (int)blockIdx.x);
        pg8::EpiOut E{x, XN, ssp, D};
        REP(3) pg8::gemm_phase<pg8::EpiOut, pg8::StaticOrder, true>(L + RING_OFF, g, S, E);
        if (BOTH(3)) GRID_BAR(3);
    }
    if (IN(4)) {
        pg8::Gemm g{XN, Wup_t, M, FF, D}; pg8::StaticOrder S; S.init(M, FF, G, (int)blockIdx.x);
        pg8::EpiUp E{ssp, HID, FF, 1.0f / D, RMS_EPS};
        REP(4) pg8::gemm_phase<pg8::EpiUp, pg8::StaticOrder, true>(L + RING_OFF, g, S, E);
        if (BOTH(4)) GRID_BAR(4);
    }
    if (IN(5)) {
        pg8::Gemm g{HID, Wdn_t, M, D, FF}; pg8::StaticOrder S; S.init(M, D, G, (int)blockIdx.x);
        pg8::EpiDown E{XN, out, D};
        pg8::gemm_phase<pg8::EpiDown, pg8::StaticOrder, true>(L + RING_OFF, g, S, E);
    }
#undef IN
#undef BOTH
}

extern "C" void kernel_launch(void* const* d_in, const int* in_sizes, int n_in, void* d_out, int out_size, void* d_ws, size_t ws_size, hipStream_t stream) {
    static int grid = 0;
    if (grid == 0) {
        if (n_in != 13 || in_sizes[0] != M * D || out_size != M * D || ws_size < WS_END) { fprintf(stderr, "kernel_launch: shape/workspace mismatch (n_in %d in0 %d out %d ws %zu); nothing launched\n", n_in, n_in > 0 ? in_sizes[0] : -1, out_size, ws_size); grid = -1; return; }
        int dev = 0, cus = 0, per_cu = 0;
        if (hipGetDevice(&dev) != hipSuccess || hipDeviceGetAttribute(&cus, hipDeviceAttributeMultiprocessorCount, dev) != hipSuccess) { fprintf(stderr, "kernel_launch: device query failed\n"); grid = -1; return; }
        if (hipFuncSetAttribute((const void*)hymba_fwd, hipFuncAttributeMaxDynamicSharedMemorySize, LDS_BYTES) != hipSuccess) { fprintf(stderr, "kernel_launch: hipFuncSetAttribute failed\n"); grid = -1; return; }
        if (hipOccupancyMaxActiveBlocksPerMultiprocessor(&per_cu, (const void*)hymba_fwd, NWAVES * 64, LDS_BYTES) != hipSuccess || per_cu < 1)
            fprintf(stderr, "kernel_launch: note: occupancy query reports %d workgroups per CU\n", per_cu);
        (void)hipGetLastError();
        grid = cus;
    }
    if (grid < 0) return;
    if (hipMemsetAsync((char*)d_ws + WS_CTL, 0, CTL_ZERO_BYTES, stream) != hipSuccess) { fprintf(stderr, "kernel_launch: hipMemsetAsync failed\n"); return; }
    Args a{};
    for (int i = 0; i < 13; ++i) a.in[i] = (const float*)d_in[i];
    a.out = (float*)d_out; a.ws = (unsigned char*)d_ws;
    static_assert(N_LAUNCHES == 1 || N_LAUNCHES == PER_PHASE, "MK_N_LAUNCHES must be 1 or 6");
    for (int li = 0; li < N_LAUNCHES; ++li) {
        a.ph_lo = (N_LAUNCHES == PER_PHASE) ? li : 0; a.ph_hi = (N_LAUNCHES == PER_PHASE) ? li + 1 : PER_PHASE; a.li = li;
        hipLaunchKernelGGL(hymba_fwd, dim3(grid), dim3(NWAVES * 64), LDS_BYTES, stream, a);
        const hipError_t le = hipPeekAtLastError();
        if (le != hipSuccess) { fprintf(stderr, "kernel_launch: launch %d failed: %s\n", li, hipGetErrorName(le)); break; }
    }
}
```

```cpp
#include <hip/hip_runtime.h>
#include <cstdio>
#include <cstdint>

#ifndef MK_N_LAUNCHES
#define MK_N_LAUNCHES 1
#endif
#ifndef REPEAT_MASK
#define REPEAT_MASK 0
#endif
#ifndef PROBE_MODE
#define PROBE_MODE 0
#endif
#define REP(k) for (int rep_ = 0; rep_ < 1 + ((REPEAT_MASK >> (k)) & 1); ++rep_)

namespace pg8 {
#define PG8_LAS __attribute__((address_space(3)))
typedef unsigned short bf16_t;
typedef short bf16x8 __attribute__((ext_vector_type(8)));
typedef float f32x4 __attribute__((ext_vector_type(4)));
typedef unsigned u32x4 __attribute__((ext_vector_type(4)));
constexpr int BM = 256, BK = 64, HALF = 128, HTB = HALF * BK * 2  , STAGE_BYTES = 8 * HTB, NXCD = 8, WGM = 8;

__host__ __device__ __forceinline__ int lds_byte(int r, int c) { const int st = (r >> 4) * 2 + (c >> 5), rr = r & 15, cc = c & 31, ob = rr * 64 + cc * 2; return st * 1024 + (ob ^ (((ob >> 9) & 1) << 5)); }
__host__ __device__ __forceinline__ void stage_rc(int b, int& R, int& C) { const int st = b / 1024, sb = b % 1024, swz = sb ^ (((sb >> 9) & 1) << 5); R = (st >> 1) * 16 + swz / 64; C = (st & 1) * 32 + (swz % 64) / 2; }
__host__ __device__ __forceinline__ int perm32(int rho) { const int n = rho >> 4, i = rho & 15; return 8 * (i >> 2) + 4 * n + (i & 3); }

struct Unit { int pm, pn; };
struct Gemm { const bf16_t* A; const bf16_t* Bt; int M, N, K; };

struct StaticOrder {
    int nM, nN, nwg, G, c;
    __host__ __device__ void init(int M, int N, int G_, int c_) { nM = M / BM; nN = N / BM; nwg = nM * nN; G = G_; c = c_; }
    __host__ __device__ bool next(int i, Unit& u) const {
        const long L = (long)i * G + c; if (L >= nwg) return false;
        int wgid = (int)L; { const int q = nwg / NXCD, r = nwg % NXCD, xcd = wgid % NXCD, off = wgid / NXCD; wgid = (xcd < r ? xcd * (q + 1) : r * (q + 1) + (xcd - r) * q) + off; }
        const int nig = WGM * nN, gid = wgid / nig, fm = gid * WGM, gsz = (nM - fm) < WGM ? (nM - fm) : WGM;
        u.pm = fm + ((wgid % nig) % gsz); u.pn = (wgid % nig) / gsz; return true;
    }
};

__device__ __forceinline__ unsigned cvt_pk_bf16(float lo, float hi) { unsigned r; asm volatile("v_cvt_pk_bf16_f32 %0, %1, %2" : "=v"(r) : "v"(lo), "v"(hi)); return r; }

constexpr float QK_EPS = 1e-6f;
constexpr float C2 = 0.125f * 1.4426950408889634f;

struct EpiQKV {
    bf16_t* O; int ldc; const float* gqa; const float* gka; const float* gqb; const float* gkb; const float* rope;
    __device__ __forceinline__ void operator()(const f32x4 (&acc)[2][2][4][2], const Unit& u, int wr, int wc, int fr, int fq) const {
        const int pn = u.pn; int mode = 0; const float* g = gqa;
        if (pn < 2) { mode = 1; g = gqa; } else if (pn == 2) { if (wc < 2) { mode = 2; g = gka; } } else if (pn < 5) { mode = 1; g = gqb; } else if (pn < 7) { mode = 2; g = gkb; }
        const int row0 = u.pm * BM + wr * 64 + fr, col0 = pn * BM + wc * 64 + 8 * fq;
        if (mode == 0) {
#pragma unroll
            for (int ai = 0; ai < 2; ++ai)
#pragma unroll
                for (int m = 0; m < 4; ++m) { bf16_t* rowp = O + (size_t)(row0 + ai * HALF + m * 16) * ldc + col0;
#pragma unroll
                    for (int bj = 0; bj < 2; ++bj) { const f32x4 v0 = acc[ai][bj][m][0], v1 = acc[ai][bj][m][1]; u32x4 w;
                        w.x = cvt_pk_bf16(v0[0], v0[1]); w.y = cvt_pk_bf16(v0[2], v0[3]); w.z = cvt_pk_bf16(v1[0], v1[1]); w.w = cvt_pk_bf16(v1[2], v1[3]);
                        *(u32x4*)(rowp + bj * 32) = w; } }
            return;
        }
        f32x4 gv[2][2];
#pragma unroll
        for (int bj = 0; bj < 2; ++bj)
#pragma unroll
            for (int n = 0; n < 2; ++n) gv[bj][n] = *(const f32x4*)(g + 32 * bj + 8 * fq + 4 * n);
        const float sc = (mode == 1) ? C2 : 1.0f;
        const float sgn = (fq == 0) ? -1.0f : 1.0f;
#pragma unroll
        for (int ai = 0; ai < 2; ++ai)
#pragma unroll
            for (int m = 0; m < 4; ++m) {
                const int row = row0 + ai * HALF + m * 16;
                float ss = 0.f;
#pragma unroll
                for (int bj = 0; bj < 2; ++bj)
#pragma unroll
                    for (int n = 0; n < 2; ++n) { const f32x4 x = acc[ai][bj][m][n]; ss += (x[0] * x[0] + x[1] * x[1]) + (x[2] * x[2] + x[3] * x[3]); }
                ss += __shfl_xor(ss, 16); ss += __shfl_xor(ss, 32);
                const float rs = __builtin_amdgcn_rsqf(ss * (1.0f / 64.0f) + QK_EPS);
                f32x4 y[2][2];
#pragma unroll
                for (int bj = 0; bj < 2; ++bj)
#pragma unroll
                    for (int n = 0; n < 2; ++n) y[bj][n] = acc[ai][bj][m][n] * rs * gv[bj][n];
                const f32x4 c0 = *(const f32x4*)(rope + (size_t)row * 16), c1 = *(const f32x4*)(rope + (size_t)row * 16 + 4);
                const f32x4 s0 = *(const f32x4*)(rope + (size_t)row * 16 + 8), s1 = *(const f32x4*)(rope + (size_t)row * 16 + 12);
                f32x4 p0, p1;
#pragma unroll
                for (int e = 0; e < 4; ++e) { p0[e] = __shfl_xor(y[0][0][e], 16); p1[e] = __shfl_xor(y[0][1][e], 16); }
                if (fq < 2) { y[0][0] = y[0][0] * c0 + p0 * s0 * sgn; y[0][1] = y[0][1] * c1 + p1 * s1 * sgn; }
                bf16_t* rowp = O + (size_t)row * ldc + col0;
#pragma unroll
                for (int bj = 0; bj < 2; ++bj) { const f32x4 v0 = y[bj][0] * sc, v1 = y[bj][1] * sc; u32x4 w;
                    w.x = cvt_pk_bf16(v0[0], v0[1]); w.y = cvt_pk_bf16(v0[2], v0[3]); w.z = cvt_pk_bf16(v1[0], v1[1]); w.w = cvt_pk_bf16(v1[2], v1[3]);
                    *(u32x4*)(rowp + bj * 32) = w; }
            }
    }
};

struct EpiOut {
    const float* x; bf16_t* hb; float* ssp; int ldc;
    __device__ __forceinline__ void operator()(const f32x4 (&acc)[2][2][4][2], const Unit& u, int wr, int wc, int fr, int fq) const {
        const int row0 = u.pm * BM + wr * 64 + fr, col0 = u.pn * BM + wc * 64 + 8 * fq;
#pragma unroll
        for (int ai = 0; ai < 2; ++ai)
#pragma unroll
            for (int m = 0; m < 4; ++m) {
                const int row = row0 + ai * HALF + m * 16; const size_t off = (size_t)row * ldc + col0; float ss = 0.f;
#pragma unroll
                for (int bj = 0; bj < 2; ++bj) {
                    const f32x4 x0 = *(const f32x4*)(x + off + bj * 32), x1 = *(const f32x4*)(x + off + bj * 32 + 4);
                    const f32x4 v0 = acc[ai][bj][m][0] + x0, v1 = acc[ai][bj][m][1] + x1;
                    u32x4 w; w.x = cvt_pk_bf16(v0[0], v0[1]); w.y = cvt_pk_bf16(v0[2], v0[3]); w.z = cvt_pk_bf16(v1[0], v1[1]); w.w = cvt_pk_bf16(v1[2], v1[3]);
                    *(u32x4*)(hb + off + bj * 32) = w;
                    ss += (v0[0] * v0[0] + v0[1] * v0[1]) + (v0[2] * v0[2] + v0[3] * v0[3]) + (v1[0] * v1[0] + v1[1] * v1[1]) + (v1[2] * v1[2] + v1[3] * v1[3]);
                }
                ss += __shfl_xor(ss, 16); ss += __shfl_xor(ss, 32);
                if (fq == 0) ssp[(size_t)row * 16 + u.pn * 4 + wc] = ss;
            }
    }
};

struct EpiUp {
    const float* ssp; bf16_t* hid; int ldc; float inv_n, eps;
    __device__ __forceinline__ void operator()(const f32x4 (&acc)[2][2][4][2], const Unit& u, int wr, int wc, int fr, int fq) const {
        const int row0 = u.pm * BM + wr * 64 + fr, col0 = u.pn * BM + wc * 64 + 8 * fq;
#pragma unroll
        for (int ai = 0; ai < 2; ++ai)
#pragma unroll
            for (int m = 0; m < 4; ++m) {
                const int row = row0 + ai * HALF + m * 16;
                const f32x4 a = *(const f32x4*)(ssp + (size_t)row * 16), b = *(const f32x4*)(ssp + (size_t)row * 16 + 4), c = *(const f32x4*)(ssp + (size_t)row * 16 + 8), d = *(const f32x4*)(ssp + (size_t)row * 16 + 12);
                const f32x4 t = (a + b) + (c + d); const float ss = (t[0] + t[1]) + (t[2] + t[3]);
                const float rs = __builtin_amdgcn_rsqf(ss * inv_n + eps);
                bf16_t* rowp = hid + (size_t)row * ldc + col0;
#pragma unroll
                for (int bj = 0; bj < 2; ++bj) { f32x4 v0 = acc[ai][bj][m][0] * rs, v1 = acc[ai][bj][m][1] * rs;
#pragma unroll
                    for (int e = 0; e < 4; ++e) { const float r0 = __builtin_fmaxf(v0[e], 0.f), r1 = __builtin_fmaxf(v1[e], 0.f); v0[e] = r0 * r0; v1[e] = r1 * r1; }
                    u32x4 w; w.x = cvt_pk_bf16(v0[0], v0[1]); w.y = cvt_pk_bf16(v0[2], v0[3]); w.z = cvt_pk_bf16(v1[0], v1[1]); w.w = cvt_pk_bf16(v1[2], v1[3]);
                    *(u32x4*)(rowp + bj * 32) = w; }
            }
    }
};

struct EpiDown {
    const bf16_t* hb; float* out; int ldc;
    __device__ __forceinline__ void operator()(const f32x4 (&acc)[2][2][4][2], const Unit& u, int wr, int wc, int fr, int fq) const {
        const int row0 = u.pm * BM + wr * 64 + fr, col0 = u.pn * BM + wc * 64 + 8 * fq;
#pragma unroll
        for (int ai = 0; ai < 2; ++ai)
#pragma unroll
            for (int m = 0; m < 4; ++m) {
                const size_t off = (size_t)(row0 + ai * HALF + m * 16) * ldc + col0;
#pragma unroll
                for (int bj = 0; bj < 2; ++bj) {
                    const u32x4 hw = *(const u32x4*)(hb + off + bj * 32);
                    const f32x4 h0 = {__uint_as_float(hw.x << 16), __uint_as_float(hw.x & 0xffff0000u), __uint_as_float(hw.y << 16), __uint_as_float(hw.y & 0xffff0000u)};
                    const f32x4 h1 = {__uint_as_float(hw.z << 16), __uint_as_float(hw.z & 0xffff0000u), __uint_as_float(hw.w << 16), __uint_as_float(hw.w & 0xffff0000u)};
                    *(f32x4*)(out + off + bj * 32) = h0 + acc[ai][bj][m][0]; *(f32x4*)(out + off + bj * 32 + 4) = h1 + acc[ai][bj][m][1];
                }
            }
    }
};

template <class Epi, class Sched, bool ALIGN_EPI>
__device__ __forceinline__ void gemm_phase(PG8_LAS unsigned char* lds, const Gemm g, const Sched& S, const Epi& E) {
    const int tid = threadIdx.x, wid = __builtin_amdgcn_readfirstlane(tid >> 6), lane = tid & 63, wr = wid >> 2, wc = wid & 3, fr = lane & 15, fq = lane >> 4;
    const int K = g.K, nt = K / BK;
    unsigned voffA[2], voffB[2];
#pragma unroll
    for (int i = 0; i < 2; ++i) { int R, C; stage_rc(tid * 16 + i * 8192, R, C); const int Rb = (R >> 5) * 64 + perm32(R & 31);
        voffA[i] = (unsigned)(R * K + C) * 2u; voffB[i] = (unsigned)(Rb * K + C) * 2u; }
    const size_t kstep = (size_t)(BK * 2);
    const size_t hstepA = (size_t)HALF * K * 2;
    const size_t hstepB = (size_t)32 * K * 2;
    const size_t tstep = (size_t)BM * K * 2;
    const unsigned ldsw = (unsigned)wid * 1024u;
    const int aoff = lds_byte(wr * 64 + fr, fq * 8), boff = lds_byte(wc * 32 + fr, fq * 8);
#define PG8_SA(b, h) (((b) * 2 + (h)) * HTB)
#define PG8_SB(b, h) ((4 + (b) * 2 + (h)) * HTB)
#define PG8_STAGE(bufoff, gbase, voff) do { _Pragma("unroll") for (int _i = 0; _i < 2; ++_i) \
        __builtin_amdgcn_global_load_lds((const unsigned*)((const char*)(gbase) + (voff)[_i]), (PG8_LAS unsigned*)(lds + (bufoff) + ldsw + _i * 8192), 16, 0, 0); } while (0)
#define PG8_LDA(dst, b, h) do { _Pragma("unroll") for (int m = 0; m < 4; ++m) _Pragma("unroll") for (int k = 0; k < 2; ++k) dst[m][k] = *(const PG8_LAS bf16x8*)(lds + PG8_SA(b, h) + aoff + m * 2048 + k * 1024); } while (0)
#define PG8_LDB(dst, b, h) do { _Pragma("unroll") for (int n = 0; n < 2; ++n) _Pragma("unroll") for (int k = 0; k < 2; ++k) dst[n][k] = *(const PG8_LAS bf16x8*)(lds + PG8_SB(b, h) + boff + n * 2048 + k * 1024); } while (0)
#define PG8_MMA(ai, bj, At, Bt) do { __builtin_amdgcn_s_setprio(1); _Pragma("unroll") for (int m = 0; m < 4; ++m) _Pragma("unroll") for (int n = 0; n < 2; ++n) _Pragma("unroll") for (int k = 0; k < 2; ++k) \
        acc[ai][bj][m][n] = __builtin_amdgcn_mfma_f32_16x16x32_bf16(Bt[n][k], At[m][k], acc[ai][bj][m][n], 0, 0, 0); __builtin_amdgcn_s_setprio(0); } while (0)
#define PG8_WAIT_V(n) asm volatile("s_waitcnt vmcnt(" #n ")" ::: "memory")
#define PG8_WAIT_L(n) asm volatile("s_waitcnt lgkmcnt(" #n ")" ::: "memory")
#define PG8_BAR __builtin_amdgcn_s_barrier()
#define PG8_SCHED __builtin_amdgcn_sched_barrier(0)
    Unit cur, nxt; int ui = 0;
    if (!S.next(0, cur)) return;
    f32x4 acc[2][2][4][2];
#pragma unroll
    for (int a = 0; a < 2; ++a)
#pragma unroll
        for (int b = 0; b < 2; ++b)
#pragma unroll
            for (int m = 0; m < 4; ++m)
#pragma unroll
                for (int n = 0; n < 2; ++n) acc[a][b][m][n] = (f32x4){0.f, 0.f, 0.f, 0.f};
    bf16x8 At[4][2], B0[2][2], B1[2][2];
    const char* cA = (const char*)g.A + (size_t)cur.pm * tstep; const char* cB = (const char*)g.Bt + (size_t)cur.pn * tstep;
    PG8_STAGE(PG8_SB(0, 0), cB, voffB); PG8_STAGE(PG8_SB(0, 1), cB + hstepB, voffB); PG8_STAGE(PG8_SA(0, 0), cA, voffA); PG8_STAGE(PG8_SA(0, 1), cA + hstepA, voffA);
    if (wr == 1) PG8_BAR;
    PG8_WAIT_V(2); PG8_BAR;
    PG8_STAGE(PG8_SB(1, 0), cB + kstep, voffB); PG8_STAGE(PG8_SA(1, 0), cA + kstep, voffA); PG8_STAGE(PG8_SB(1, 1), cB + hstepB + kstep, voffB);
    PG8_WAIT_V(6); PG8_BAR;
    for (;;) {
        const bool has_next = S.next(ui + 1, nxt);
        const char* nA = has_next ? (const char*)g.A + (size_t)nxt.pm * tstep : cA; const char* nB = has_next ? (const char*)g.Bt + (size_t)nxt.pn * tstep : cB;
        for (int t = 0; t < nt; t += 2) {
            const bool last = (t == nt - 2);
            const char* a1 = cA + (size_t)(t + 1) * kstep;
            const char* a2 = last ? nA : cA + (size_t)(t + 2) * kstep; const char* b2 = last ? nB : cB + (size_t)(t + 2) * kstep;
            const char* a3 = a2 + kstep; const char* b3 = b2 + kstep;
            PG8_LDB(B0, 0, 0); PG8_LDB(B1, 0, 1); PG8_SCHED; PG8_LDA(At, 0, 0); PG8_STAGE(PG8_SA(1, 1), a1 + hstepA, voffA);
            PG8_WAIT_V(8); PG8_WAIT_L(0); PG8_BAR; PG8_MMA(0, 0, At, B0); PG8_MMA(0, 1, At, B1); PG8_BAR; PG8_SCHED;
            PG8_LDA(At, 0, 1); PG8_STAGE(PG8_SB(0, 0), b2, voffB); PG8_STAGE(PG8_SB(0, 1), b2 + hstepB, voffB); PG8_STAGE(PG8_SA(0, 0), a2, voffA);
            PG8_WAIT_V(8); PG8_WAIT_L(0); PG8_BAR; PG8_MMA(1, 0, At, B0); PG8_MMA(1, 1, At, B1); PG8_BAR; PG8_SCHED;
            PG8_LDB(B0, 1, 0); PG8_LDB(B1, 1, 1); PG8_SCHED; PG8_LDA(At, 1, 0); PG8_STAGE(PG8_SA(0, 1), a2 + hstepA, voffA);
            PG8_WAIT_V(8); PG8_WAIT_L(0); PG8_BAR; PG8_MMA(0, 0, At, B0); PG8_MMA(0, 1, At, B1); PG8_BAR; PG8_SCHED;
            PG8_LDA(At, 1, 1); PG8_STAGE(PG8_SB(1, 0), b3, voffB); PG8_STAGE(PG8_SB(1, 1), b3 + hstepB, voffB); PG8_STAGE(PG8_SA(1, 0), a3, voffA);
            PG8_WAIT_V(8); PG8_WAIT_L(0); PG8_BAR; PG8_MMA(1, 0, At, B0); PG8_MMA(1, 1, At, B1); PG8_BAR; PG8_SCHED;
        }
        if constexpr (ALIGN_EPI) { if (wr == 0) PG8_BAR; }
        E(acc, cur, wr, wc, fr, fq);
        if (!has_next) break;
#pragma unroll
        for (int a = 0; a < 2; ++a)
#pragma unroll
            for (int b = 0; b < 2; ++b)
#pragma unroll
                for (int m = 0; m < 4; ++m)
#pragma unroll
                    for (int n = 0; n < 2; ++n) acc[a][b][m][n] = (f32x4){0.f, 0.f, 0.f, 0.f};
        cur = nxt; cA = nA; cB = nB; ++ui;
        if constexpr (ALIGN_EPI) { if (wr == 1) PG8_BAR; }
    }
    PG8_WAIT_V(0);
    if constexpr (!ALIGN_EPI) { if (wr == 0) PG8_BAR; }
    PG8_BAR;
#undef PG8_SA
#undef PG8_SB
#undef PG8_STAGE
#undef PG8_LDA
#undef PG8_LDB
#undef PG8_MMA
#undef PG8_WAIT_V
#undef PG8_WAIT_L
#undef PG8_BAR
#undef PG8_SCHED
}
}

constexpr int NWAVES = 8;
constexpr int BATCH = 32, SEQ = 2048, D = 1024, FF = 4096, HD = 64;
constexpr int M = BATCH * SEQ;
constexpr int NPROJ = 2304;
constexpr int COL_QA = 0, COL_KA = 512, COL_VA = 640, COL_QB = 768, COL_KB = 1280, COL_VB = 1792;
constexpr float RMS_EPS = 1e-6f;
constexpr int N_LAUNCHES = MK_N_LAUNCHES, PER_PHASE = 6;
constexpr int N_BAR_REGIONS = (MK_N_LAUNCHES == PER_PHASE) ? 1 : MK_N_LAUNCHES;

constexpr size_t MiB = 1u << 20;
constexpr size_t WS_CTL = 0, CTL_ZERO_BYTES = 1 * MiB;
constexpr size_t WS_WIN = 2 * MiB, WS_WOUT = 8 * MiB, WS_WUP = 10 * MiB, WS_WDN = 18 * MiB;
constexpr size_t WS_ROPE = 26 * MiB;
constexpr size_t WS_SS = 30 * MiB;
constexpr size_t WS_XN = 64 * MiB;
constexpr size_t WS_PROJ = 192 * MiB;
constexpr size_t WS_MIX = 480 * MiB;
constexpr size_t WS_HID = 192 * MiB;
constexpr size_t WS_END = 704 * MiB;
static_assert(WS_WIN + (size_t)NPROJ * D * 2 <= WS_WOUT && WS_WDN + (size_t)D * FF * 2 <= WS_ROPE && WS_SS + (size_t)M * 64 <= WS_XN, "d_ws map");
static_assert(WS_XN + (size_t)M * D * 2 <= WS_PROJ && WS_PROJ + (size_t)M * NPROJ * 2 <= WS_MIX && WS_MIX + (size_t)M * D * 2 <= WS_END && WS_HID + (size_t)M * FF * 2 <= WS_END, "d_ws map");
constexpr int CW_TMO = 0, CW_CODE = 1;
constexpr int CW_BAR = 4096;

constexpr int RING_OFF = 0, RING_BYTES = 131072;
constexpr int LDSCTL_OFF = 139264, MISC_OFF = LDSCTL_OFF + 320;
constexpr int LDS_BYTES = 147456;

#define GAS __attribute__((address_space(1)))
#define LAS __attribute__((address_space(3)))
typedef unsigned short bf16;
typedef unsigned v4u __attribute__((ext_vector_type(4)));
typedef float f32x4 __attribute__((ext_vector_type(4)));
typedef GAS unsigned gu32;
#define RLX_AGENT __ATOMIC_RELAXED, __HIP_MEMORY_SCOPE_AGENT
#define LDS_WAIT() asm volatile("s_waitcnt lgkmcnt(0)" ::: "memory")
#define VM_WAIT() asm volatile("s_waitcnt vmcnt(0)" ::: "memory")
__device__ __forceinline__ unsigned f2bf(float f) { unsigned u = __builtin_bit_cast(unsigned, f); return (u + 0x7fffu + ((u >> 16) & 1u)) >> 16; }
__device__ __forceinline__ unsigned pk2(float lo, float hi) { return f2bf(lo) | (f2bf(hi) << 16); }
__device__ __forceinline__ float bf_lo(unsigned u) { return __uint_as_float(u << 16); }
__device__ __forceinline__ float bf_hi(unsigned u) { return __uint_as_float(u & 0xffff0000u); }

#define XB_TMO      128
#define XB_XCNT(j)  (256  + 64 * (j))
#define XB_XSUB(j)  (1280 + 64 * (j))
#define XB_XGEN(j)  (2304 + 64 * (j))
#define XB_TOP      3328
#define XB_TOPGEN   3392
#define XCD_BAR_WORDS 3456
#define XB_SPIN_CAP (1u << 18)

__device__ __forceinline__ unsigned xb_ld(unsigned* p)              { return __hip_atomic_load(p, __ATOMIC_RELAXED, __HIP_MEMORY_SCOPE_AGENT); }
__device__ __forceinline__ unsigned xb_add(unsigned* p, unsigned v) { return __hip_atomic_fetch_add(p, v, __ATOMIC_RELAXED, __HIP_MEMORY_SCOPE_AGENT); }
__device__ __forceinline__ unsigned xb_xcc_id() { return (unsigned)__builtin_amdgcn_s_getreg((3 << 11) | 20) & 0xFu; }
#define XB_SPIN(cond, bar) do { unsigned _sp = 0; while (cond) { __builtin_amdgcn_s_sleep(1); \
    if ((++_sp & 255u) == 0u) { if (xb_ld(&(bar)[XB_TMO])) break; if (_sp > XB_SPIN_CAP) { atomicAdd(&(bar)[XB_TMO], 1u); break; } } } } while (0)

struct XcdBarrier { unsigned* bar; unsigned x; volatile LAS unsigned* st; };

__device__ __forceinline__ XcdBarrier xcd_barrier_post(unsigned* bar, volatile LAS unsigned* st) {
    XcdBarrier b; b.bar = bar; b.x = xb_xcc_id(); b.st = st;
    if (threadIdx.x == 0) (void)xb_add(&bar[XB_XCNT(b.x)], 1u);
    return b;
}
__device__ __forceinline__ void xcd_barrier_complete(unsigned* bar, unsigned x, unsigned& nloc, unsigned& nx) {
    const unsigned G = gridDim.x * gridDim.y * gridDim.z;
    unsigned sum, cnt, mine, sp = 0u;
    for (;;) {
        sum = 0u; cnt = 0u; mine = 0u;
#pragma unroll
        for (unsigned j = 0; j < 16; ++j) { const unsigned c = xb_ld(&bar[XB_XCNT(j)]); sum += c; cnt += (c > 0u) ? 1u : 0u; mine = (j == x) ? c : mine; }
        if (sum == G) break;
        __builtin_amdgcn_s_sleep(1);
        if ((++sp & 255u) == 0u) { if (xb_ld(&bar[XB_TMO])) break; if (sp > XB_SPIN_CAP) { atomicAdd(&bar[XB_TMO], 1u); break; } }
    }
    nloc = mine > 0u ? mine : 1u; nx = cnt > 0u ? cnt : 1u;
}
__device__ __forceinline__ void xcd_barrier(const XcdBarrier& b) {
    asm volatile("s_waitcnt vmcnt(0)" ::: "memory");
    __syncthreads();
    if (threadIdx.x == 0) {
        unsigned* bar = b.bar;
        __builtin_amdgcn_s_waitcnt(0);
        unsigned nloc = b.st[0], nx = b.st[1];
        if (nloc == 0u) { xcd_barrier_complete(bar, b.x, nloc, nx); b.st[0] = nloc; b.st[1] = nx; }
        const unsigned old = xb_add(&bar[XB_XSUB(b.x)], 1u);
        const unsigned gen = old / nloc;
        if (old + 1u == (gen + 1u) * nloc) {
            __builtin_amdgcn_fence(__ATOMIC_RELEASE, "agent");
            asm volatile("s_waitcnt vmcnt(0)" ::: "memory");
            const unsigned og = xb_add(&bar[XB_TOP], 1u);
            const unsigned tg = og / nx;
            if (og + 1u == (tg + 1u) * nx) xb_add(&bar[XB_TOPGEN], 1u);
            else XB_SPIN(xb_ld(&bar[XB_TOPGEN]) == tg, bar);
            __builtin_amdgcn_fence(__ATOMIC_ACQUIRE, "agent");
            xb_add(&bar[XB_XGEN(b.x)], 1u);
            asm volatile("s_waitcnt vmcnt(0)" ::: "memory");
        } else {
            XB_SPIN(xb_ld(&bar[XB_XGEN(b.x)]) == gen, bar);
            __builtin_amdgcn_fence(__ATOMIC_ACQUIRE, "agent");
            asm volatile("s_waitcnt vmcnt(0)" ::: "memory");
        }
    }
    __syncthreads();
}

__device__ __forceinline__ float wave_sum(float v) {
#pragma unroll
    for (int o = 1; o < 64; o <<= 1) v += __shfl_xor(v, o);
    return v;
}
__device__ __forceinline__ float wave_max(float v) {
#pragma unroll
    for (int o = 1; o < 64; o <<= 1) v = __builtin_fmaxf(v, __shfl_xor(v, o));
    return v;
}
__device__ __forceinline__ void p0_transpose_item(const float* W, int K, int N, bf16* WT, const float* gk, LAS float* scr, int item, int lane) {
    const int nblk = N / 32, kb = item / nblk, nb = item % nblk, k0 = 64 * kb, n0 = 32 * nb;
    float wv[32];
#pragma unroll
    for (int i = 0; i < 32; ++i) wv[i] = W[(size_t)(k0 + 2 * i + (lane >> 5)) * N + n0 + (lane & 31)];
    if (gk) {
#pragma unroll
        for (int i = 0; i < 32; ++i) wv[i] *= gk[k0 + 2 * i + (lane >> 5)]; }
#pragma unroll
    for (int i = 0; i < 32; ++i) scr[(2 * i + (lane >> 5)) * 33 + (lane & 31)] = wv[i];
    LDS_WAIT(); asm volatile("" ::: "memory");
    const int c = lane & 7;
#pragma unroll
    for (int j = 0; j < 4; ++j) { const int n = (lane >> 3) + 8 * j; const LAS float* s = scr + (8 * c) * 33 + n;
        v4u o; o.x = pk2(s[0 * 33], s[1 * 33]); o.y = pk2(s[2 * 33], s[3 * 33]); o.z = pk2(s[4 * 33], s[5 * 33]); o.w = pk2(s[6 * 33], s[7 * 33]);
        *(GAS v4u*)(WT + (size_t)(n0 + n) * K + k0 + 8 * c) = o; }
    LDS_WAIT(); asm volatile("" ::: "memory");
}
template <int NR>
__device__ __forceinline__ void rms_rows_to_bf16(const float* xrow, const float* gain, bf16* orow, int lane) {
    f32x4 v[NR][4]; float s[NR];
#pragma unroll
    for (int r = 0; r < NR; ++r) { const GAS f32x4* xr = (const GAS f32x4*)(xrow + (size_t)r * D) + lane;
#pragma unroll
        for (int j = 0; j < 4; ++j) v[r][j] = __builtin_nontemporal_load(xr + 64 * j); }
    const GAS f32x4* gr = (const GAS f32x4*)gain + lane;
    f32x4 gg[4];
#pragma unroll
    for (int j = 0; j < 4; ++j) gg[j] = gr[64 * j];
#pragma unroll
    for (int r = 0; r < NR; ++r) { s[r] = 0.f;
#pragma unroll
        for (int j = 0; j < 4; ++j) s[r] += (v[r][j].x * v[r][j].x + v[r][j].y * v[r][j].y) + (v[r][j].z * v[r][j].z + v[r][j].w * v[r][j].w); }
#pragma unroll
    for (int o = 1; o < 64; o <<= 1) {
#pragma unroll
        for (int r = 0; r < NR; ++r) s[r] += __shfl_xor(s[r], o); }
#pragma unroll
    for (int r = 0; r < NR; ++r) { const float rstd = __builtin_amdgcn_rsqf(s[r] * (1.f / D) + RMS_EPS);
        GAS unsigned long long* o8 = (GAS unsigned long long*)(orow + (size_t)r * D) + lane;
#pragma unroll
        for (int j = 0; j < 4; ++j) { const f32x4 y = v[r][j] * rstd * gg[j];
            o8[64 * j] = (unsigned long long)pk2(y.x, y.y) | ((unsigned long long)pk2(y.z, y.w) << 32); } }
}

__device__ __forceinline__ void attn_naive(const bf16* PROJ, bf16* MIX, const float* gqa, const float* gka, const float* gqb, const float* gkb, const float* sinks, int gtid, int nthr) {
    float mqa = 0.f, mka = 0.f, mqb = 0.f, mkb = 0.f;
    for (int d = 0; d < HD; ++d) { mqa = __builtin_fmaxf(mqa, __builtin_fabsf(gqa[d])); mka = __builtin_fmaxf(mka, __builtin_fabsf(gka[d])); mqb = __builtin_fmaxf(mqb, __builtin_fabsf(gqb[d])); mkb = __builtin_fmaxf(mkb, __builtin_fabsf(gkb[d])); }
    const float shiftA = pg8::C2 * 64.f * mqa * mka, shiftB = pg8::C2 * 64.f * mqb * mkb;
    for (long item = gtid; item < (long)M * 16; item += nthr) {
        const int hh = (int)(item / M), m = (int)(item % M), t = m & (SEQ - 1), rowbase = m - t;
        const bool isA = hh < 8; const int h = hh & 7;
        const int qcol = isA ? COL_QA + h * 64 : COL_QB + h * 64, kcol = isA ? COL_KA + (h >> 2) * 64 : COL_KB + h * 64, vcol = isA ? COL_VA + (h >> 2) * 64 : COL_VB + h * 64;
        const float shift = isA ? shiftA : shiftB;
        float q[64], o[64]; float l = 0.f;
        { const v4u* qp = (const v4u*)(PROJ + (size_t)m * NPROJ + qcol);
#pragma unroll
          for (int c = 0; c < 8; ++c) { const v4u u = qp[c]; q[8 * c + 0] = bf_lo(u.x); q[8 * c + 1] = bf_hi(u.x); q[8 * c + 2] = bf_lo(u.y); q[8 * c + 3] = bf_hi(u.y); q[8 * c + 4] = bf_lo(u.z); q[8 * c + 5] = bf_hi(u.z); q[8 * c + 6] = bf_lo(u.w); q[8 * c + 7] = bf_hi(u.w); } }
#pragma unroll
        for (int d = 0; d < 64; ++d) o[d] = 0.f;
#define KEY(srow, wgt) do { const v4u* kp = (const v4u*)(PROJ + (size_t)(rowbase + (srow)) * NPROJ + kcol); float sc = 0.f; \
        _Pragma("unroll") for (int c = 0; c < 8; ++c) { const v4u u = kp[c]; sc += q[8 * c + 0] * bf_lo(u.x) + q[8 * c + 1] * bf_hi(u.x) + q[8 * c + 2] * bf_lo(u.y) + q[8 * c + 3] * bf_hi(u.y) + q[8 * c + 4] * bf_lo(u.z) + q[8 * c + 5] * bf_hi(u.z) + q[8 * c + 6] * bf_lo(u.w) + q[8 * c + 7] * bf_hi(u.w); } \
        const float p = (wgt) * __builtin_amdgcn_exp2f(sc - shift); l += p; const v4u* vp = (const v4u*)(PROJ + (size_t)(rowbase + (srow)) * NPROJ + vcol); \
        _Pragma("unroll") for (int c = 0; c < 8; ++c) { const v4u u = vp[c]; o[8 * c + 0] += p * bf_lo(u.x); o[8 * c + 1] += p * bf_hi(u.x); o[8 * c + 2] += p * bf_lo(u.y); o[8 * c + 3] += p * bf_hi(u.y); o[8 * c + 4] += p * bf_lo(u.z); o[8 * c + 5] += p * bf_hi(u.z); o[8 * c + 6] += p * bf_lo(u.w); o[8 * c + 7] += p * bf_hi(u.w); } } while (0)
        if (isA) {
            for (int dist = 0; dist <= 127 && dist <= t; ++dist) KEY(t - dist, 1.0f);
            l += __builtin_amdgcn_exp2f(sinks[h] * 1.4426950408889634f - shift);
        } else {
            for (int dist = 0; dist <= 128 && dist <= t; ++dist) { const float w = 1.0f + (((dist & 3) == 0) ? 1.0f : 0.0f) + (((dist & 15) == 0) ? 1.0f : 0.0f); KEY(t - dist, w); }
            for (int dist = 132; dist <= 512 && dist <= t; dist += 4) { const float w = 1.0f + (((dist & 15) == 0) ? 1.0f : 0.0f); KEY(t - dist, w); }
            for (int dist = 528; dist <= t; dist += 16) KEY(t - dist, 1.0f);
        }
#undef KEY
        const float rl = 1.0f / l;
        v4u* op = (v4u*)(MIX + (size_t)m * D + hh * 64);
#pragma unroll
        for (int c = 0; c < 8; ++c) { v4u u; u.x = pk2(o[8 * c + 0] * rl, o[8 * c + 1] * rl); u.y = pk2(o[8 * c + 2] * rl, o[8 * c + 3] * rl); u.z = pk2(o[8 * c + 4] * rl, o[8 * c + 5] * rl); u.w = pk2(o[8 * c + 6] * rl, o[8 * c + 7] * rl); op[c] = u; }
    }
}


typedef short a_bf16x8 __attribute__((ext_vector_type(8)));
typedef short a_s16x4 __attribute__((ext_vector_type(4)));
typedef float a_f32x16 __attribute__((ext_vector_type(16)));
typedef float a_f32x2 __attribute__((ext_vector_type(2)));
typedef __bf16 a_bf16x2 __attribute__((ext_vector_type(2)));
__device__ __forceinline__ unsigned a_cvtpk(float lo, float hi) { a_f32x2 v = {lo, hi}; a_bf16x2 b = __builtin_convertvector(v, a_bf16x2); return __builtin_bit_cast(unsigned, b); }
__device__ __forceinline__ a_s16x4 a_vtr(LAS const unsigned char* p) { return __builtin_bit_cast(a_s16x4, __builtin_amdgcn_ds_read_tr16_b64_v4i16((LAS a_s16x4*)p)); }
constexpr int ATT_WLDS = 16384;
constexpr int ATT_STG = 8192, ATT_STG_PITCH = 144;

struct AttnTask { int qrow0, qrs, qcol, kcol, vcol, n1, row1, D01, kt2lo, kt2hi, row2, D02, qstep2, maxd2, orow0, ors, ocol; float shift, sinkterm; };

__device__ __forceinline__ void attn_task(const bf16* __restrict__ PROJ, bf16* __restrict__ MIX, LAS unsigned char* wl, const int lane, const AttnTask& T) {
    const int i = lane & 31, hh = lane >> 5;
    a_bf16x8 qf[4];
    { const bf16* qp = PROJ + (size_t)(T.qrow0 + i * T.qrs) * NPROJ + T.qcol + 8 * hh;
#pragma unroll
      for (int s = 0; s < 4; ++s) qf[s] = *(const a_bf16x8*)(qp + 16 * s); }
    a_f32x16 o0 = {}, o1 = {}; float lsum = 0.f;
    const int Dl1 = T.D01 + i - 4 * hh, Dl2 = T.D02 + T.qstep2 * i - 4 * hh;
    float wg[4];
#pragma unroll
    for (int c = 0; c < 4; ++c) wg[c] = ((Dl1 & 3) == c) ? 1.0f : 0.0f;
    const int nt = T.n1 + (T.kt2hi - T.kt2lo);
    const int klane = i * NPROJ + 8 * hh, vlane = (lane >> 3) * NPROJ + (lane & 7) * 8;
    LAS unsigned char* vw = wl + ((lane & 7) >> 2) * 2048 + (lane >> 3) * 64 + (lane & 3) * 16;
    LAS const unsigned char* tra = wl + (4 * hh + ((lane & 15) >> 2)) * 64 + ((lane >> 4) & 1) * 32 + (lane & 3) * 8;
    a_f32x16 negs;
#pragma unroll
    for (int r = 0; r < 16; ++r) negs[r] = -T.shift;
    v4u kn[4]; v4u vn[4];
#define ATT_LOAD(j) do { const int seg1_ = (j) < T.n1; const int kt_ = seg1_ ? (j) : T.kt2lo + ((j) - T.n1); const int row_ = seg1_ ? T.row1 + 128 * kt_ : T.row2 + 32 * kt_; const int rs_ = seg1_ ? 4 : 1; \
        const bf16* kb_ = PROJ + (size_t)row_ * NPROJ + T.kcol + (size_t)(vlane - (lane & 7) * 8) * rs_ + (lane & 7) * 8; const bf16* vb_ = PROJ + (size_t)row_ * NPROJ + T.vcol + (size_t)(vlane - (lane & 7) * 8) * rs_ + (lane & 7) * 8; \
        _Pragma("unroll") for (int jj = 0; jj < 4; ++jj) kn[jj] = *(const v4u*)(kb_ + (size_t)(8 * jj * rs_) * NPROJ); \
        _Pragma("unroll") for (int jj = 0; jj < 4; ++jj) vn[jj] = *(const v4u*)(vb_ + (size_t)(8 * jj * rs_) * NPROJ); } while (0)
    ATT_LOAD(0);
    for (int j = 0; j < nt; ++j) {
        v4u kr[4]; v4u vr[4];
#pragma unroll
        for (int s = 0; s < 4; ++s) { kr[s] = kn[s]; vr[s] = vn[s]; }
        if (j + 1 < nt) ATT_LOAD(j + 1);
        const bool seg1 = j < T.n1; const int kt = seg1 ? j : T.kt2lo + (j - T.n1);
        const int Dt = (seg1 ? Dl1 : Dl2) - 32 * kt;
        const int D0 = (seg1 ? T.D01 : T.D02) - 32 * kt, qst = seg1 ? 1 : T.qstep2, maxd = seg1 ? 128 : T.maxd2;
        const int dpmin = D0 - 31, dpmax = D0 + 31 * qst;
        const int cls = (dpmin >= 0 && dpmax <= maxd) ? 1 : (dpmin > maxd ? 2 : 0);
#pragma unroll
        for (int jj = 0; jj < 4; ++jj) *(LAS v4u*)(vw + 512 * jj) = vr[jj];
#pragma unroll
        for (int jj = 0; jj < 4; ++jj) *(LAS v4u*)(wl + 4096 + (lane & 7) * 512 + (((8 * jj + (lane >> 3)) ^ (lane & 7)) * 16)) = kr[jj];
        a_bf16x8 kf[4];
#pragma unroll
        for (int s = 0; s < 4; ++s) kf[s] = *(LAS const a_bf16x8*)(wl + 4096 + (2 * s + hh) * 512 + ((i ^ (2 * s + hh)) * 16));
        a_f32x16 S = negs;
#pragma unroll
        for (int s = 0; s < 4; ++s) S = __builtin_amdgcn_mfma_f32_32x32x16_bf16(kf[s], qf[s], S, 0, 0, 0);
        float p[16];
        float wm[4];
#pragma unroll
        for (int c = 0; c < 4; ++c) wm[c] = seg1 ? wg[c] : 0.0f;
        if (cls == 1) {
#pragma unroll
            for (int r = 0; r < 16; ++r) p[r] = (1.0f + wm[r & 3]) * __builtin_amdgcn_exp2f(S[r]);
        } else if (cls == 2) {
#pragma unroll
            for (int r = 0; r < 16; ++r) p[r] = wm[r & 3] * __builtin_amdgcn_exp2f(S[r]);
        } else {
#pragma unroll
            for (int r = 0; r < 16; ++r) { const int dp = Dt - ((r & 3) + 8 * (r >> 2));
                const float w = (((unsigned)dp <= (unsigned)maxd) ? 1.0f : 0.0f) + ((dp >= 0) ? wm[r & 3] : 0.0f);
                p[r] = w * __builtin_amdgcn_exp2f(S[r]); }
        }
        float ls = 0.f;
#pragma unroll
        for (int r = 0; r < 16; ++r) ls += p[r];
        lsum += ls;
        a_bf16x8 pb0, pb1;
        { v4u w0, w1; w0.x = a_cvtpk(p[0], p[1]); w0.y = a_cvtpk(p[2], p[3]); w0.z = a_cvtpk(p[4], p[5]); w0.w = a_cvtpk(p[6], p[7]);
          w1.x = a_cvtpk(p[8], p[9]); w1.y = a_cvtpk(p[10], p[11]); w1.z = a_cvtpk(p[12], p[13]); w1.w = a_cvtpk(p[14], p[15]);
          pb0 = __builtin_bit_cast(a_bf16x8, w0); pb1 = __builtin_bit_cast(a_bf16x8, w1); }
        {
            a_s16x4 lo, hi;
#define ATT_VF (a_bf16x8){lo[0], lo[1], lo[2], lo[3], hi[0], hi[1], hi[2], hi[3]}
            lo = a_vtr(tra);               hi = a_vtr(tra + 512);               o0 = __builtin_amdgcn_mfma_f32_32x32x16_bf16(ATT_VF, pb0, o0, 0, 0, 0);
            lo = a_vtr(tra + 1024);        hi = a_vtr(tra + 1024 + 512);        o0 = __builtin_amdgcn_mfma_f32_32x32x16_bf16(ATT_VF, pb1, o0, 0, 0, 0);
            lo = a_vtr(tra + 2048);        hi = a_vtr(tra + 2048 + 512);        o1 = __builtin_amdgcn_mfma_f32_32x32x16_bf16(ATT_VF, pb0, o1, 0, 0, 0);
            lo = a_vtr(tra + 2048 + 1024); hi = a_vtr(tra + 2048 + 1024 + 512); o1 = __builtin_amdgcn_mfma_f32_32x32x16_bf16(ATT_VF, pb1, o1, 0, 0, 0);
#undef ATT_VF
        }
    }
#undef ATT_LOAD
    const float ltot = lsum + __shfl_xor(lsum, 32) + T.sinkterm;
    const float rl = 1.0f / ltot;
    LAS unsigned char* stg = wl + ATT_STG;
#pragma unroll
    for (int g = 0; g < 4; ++g) {
        typedef unsigned u32x2_t __attribute__((ext_vector_type(2)));
        u32x2_t a, b2;
        a.x = a_cvtpk(o0[4 * g] * rl, o0[4 * g + 1] * rl); a.y = a_cvtpk(o0[4 * g + 2] * rl, o0[4 * g + 3] * rl);
        b2.x = a_cvtpk(o1[4 * g] * rl, o1[4 * g + 1] * rl); b2.y = a_cvtpk(o1[4 * g + 2] * rl, o1[4 * g + 3] * rl);
        *(LAS u32x2_t*)(stg + i * ATT_STG_PITCH + (8 * g + 4 * hh) * 2) = a;
        *(LAS u32x2_t*)(stg + i * ATT_STG_PITCH + (32 + 8 * g + 4 * hh) * 2) = b2;
    }
#pragma unroll
    for (int jj = 0; jj < 4; ++jj) { const int row = jj * 8 + (lane >> 3), ch = lane & 7;
        const v4u v = *(LAS const v4u*)(stg + row * ATT_STG_PITCH + ch * 16);
        *(v4u*)(MIX + (size_t)(T.orow0 + row * T.ors) * D + T.ocol + ch * 8) = v; }
}

__device__ __forceinline__ void attn_phase(const bf16* PROJ, bf16* MIX, const float* gqa, const float* gka, const float* gqb, const float* gkb, const float* sinks, LAS unsigned char* lds, int vcu, int G, int wave, int lane) {
    const float mqa = wave_max(__builtin_fabsf(gqa[lane])), mka = wave_max(__builtin_fabsf(gka[lane])), mqb = wave_max(__builtin_fabsf(gqb[lane])), mkb = wave_max(__builtin_fabsf(gkb[lane]));
    const float shiftA = pg8::C2 * 64.f * mqa * mka, shiftB = pg8::C2 * 64.f * mqb * mkb;
    LAS unsigned char* wl = lds + wave * ATT_WLDS;
    for (int v = vcu; v < BATCH * 8; v += G) {
        const int b = v >> 3, h = v & 7, rowb = b * SEQ;
        for (int k = 0; k < 16; ++k) {
            AttnTask T;
            if (k < 8) {
                const int r = wave & 3, half = wave >> 2, pr = 2 * (k >> 1) + half, c = (k & 1) ? 15 - pr : pr;
                T.qrow0 = rowb + 128 * c + r; T.qrs = 4; T.qcol = COL_QB + h * 64; T.kcol = COL_KB + h * 64; T.vcol = COL_VB + h * 64;
                T.n1 = c + 1; T.row1 = rowb + r; T.D01 = 32 * c;
                T.kt2lo = (c == 0) ? 4 : 0; T.kt2hi = 8; T.row2 = rowb + 128 * c - 128; T.D02 = 128 + r; T.qstep2 = 4; T.maxd2 = 128;
                T.orow0 = T.qrow0; T.ors = 4; T.ocol = 512 + h * 64; T.shift = shiftB; T.sinkterm = 0.f;
            } else {
                const int c = wave + 8 * (k - 8);
                T.qrow0 = rowb + 32 * c; T.qrs = 1; T.qcol = COL_QA + h * 64; T.kcol = COL_KA + (h >> 2) * 64; T.vcol = COL_VA + (h >> 2) * 64;
                T.n1 = 0; T.row1 = rowb; T.D01 = 0;
                T.kt2lo = (c < 4) ? 4 - c : 0; T.kt2hi = 5; T.row2 = rowb + 32 * c - 128; T.D02 = 128; T.qstep2 = 1; T.maxd2 = 127;
                T.orow0 = T.qrow0; T.ors = 1; T.ocol = h * 64; T.shift = shiftA; T.sinkterm = __builtin_amdgcn_exp2f(sinks[h] * 1.4426950408889634f - shiftA);
            }
            attn_task(PROJ, MIX, wl, lane, T);
        }
    }
}


constexpr int A2_SLOT = 32768, A2_STG = 98304, A2_STG_W = 4608, A2_NROUNDS = 72 + 16;
struct RIter { int ph, p, k; };
__device__ __forceinline__ void ri_next(RIter& it) { it.k++; if (it.ph == 0) { if (it.k == 2 * it.p + 2) { it.k = 0; it.p++; if (it.p == 8) { it.p = 0; it.ph = 1; } } } else if (it.k == 16) { it.k = 0; it.ph++; } }
__device__ __forceinline__ int ri_blk(const RIter& it) { return it.k; }
struct WTask { int cw; bool isB, first, last, live; };
__device__ __forceinline__ WTask wt_of(const RIter& it, int wave) {
    WTask t; t.isB = it.ph == 0; const int blk = it.k;
    if (t.isB) { t.cw = 2 * it.p + (wave >> 2); t.first = blk == 0; t.last = blk == t.cw; t.live = blk <= t.cw; }
    else if (wave < 4) { t.cw = 8 * ((blk + 1) >> 1) + wave; t.first = (blk & 1) || blk == 0; t.last = !(blk & 1); t.live = t.cw < 64; }
    else { t.cw = 8 * (blk >> 1) + wave; t.first = !(blk & 1); t.last = (blk & 1); t.live = true; }
    if (it.ph >= 2) { t.live = false; t.first = false; t.last = false; }
    return t;
}

__device__ __forceinline__ void attn_phase2(const bf16* __restrict__ PROJ, bf16* __restrict__ MIX, const float* sinks,
                                            LAS unsigned char* lds, int vcu, int G, int wave, int lane, const int mode) {
    const int i = lane & 31, hh = lane >> 5, r = wave & 3, grp = wave >> 2;
    const float NINF = -__builtin_inff();
    unsigned offK[2], offV[2];
#pragma unroll
    for (int j = 0; j < 2; ++j) { const int n = 2 * wave + j, slot = 8 * n + (lane >> 3), cp = lane & 7;
        const int rk = slot ^ ((slot >> 4) & 3), ch = cp ^ ((slot >> 1) & 7); offK[j] = (unsigned)(rk * NPROJ + ch * 8);
        const int rv = slot ^ ((slot >> 2) & 3), dh = (cp >> 2) ^ ((slot >> 1) & 1); offV[j] = (unsigned)(rv * NPROJ + dh * 32 + (cp & 3) * 8); }
    int k1[4], ke[4], ko[4], v1[2], v2[4];
    { const int rho = 4 * i + r, slot = rho ^ ((rho >> 4) & 3), sw = (slot >> 1) & 7;
#pragma unroll
      for (int s = 0; s < 4; ++s) k1[s] = slot * 128 + (((2 * s + hh) ^ sw) * 16); }
    { const int xe = i ^ (i >> 4), xo = i ^ (2 | (i >> 4));
#pragma unroll
      for (int s = 0; s < 4; ++s) { ke[s] = xe * 128 + (((2 * s + hh) ^ ((xe >> 1) & 7)) * 16); ko[s] = xo * 128 + (((2 * s + hh) ^ ((xo >> 1) & 7)) * 16); } }
    { const int q4 = (lane & 15) >> 2, g = (lane >> 4) & 1, pp = lane & 3;
#pragma unroll
      for (int dh = 0; dh < 2; ++dh) { const int sl = 16 * hh + 4 * q4 + (r ^ q4); v1[dh] = 16384 + sl * 128 + ((dh ^ ((sl >> 1) & 1)) * 64) + g * 32 + pp * 8; }
#pragma unroll
      for (int x = 0; x < 4; ++x) { const int dh = x >> 1, e = x & 1, kk = 8 * e + 4 * hh + q4, sl = kk ^ ((kk >> 2) & 3); v2[x] = 16384 + sl * 128 + ((dh ^ ((sl >> 1) & 1)) * 64) + g * 32 + pp * 8; } }
    a_f32x16 c1F, c1R;
#pragma unroll
    for (int q = 0; q < 16; ++q) { const bool mt = ((q & 3) == (i & 3)); c1F[q] = mt ? 1.0f : 0.0f; c1R[q] = mt ? 0.0f : NINF; }
    LAS unsigned char* stg = lds + A2_STG + wave * A2_STG_W;
#define A2_WAIT_V(n) asm volatile("s_waitcnt vmcnt(" #n ")" ::: "memory")
#define A2_OFFQ(q) (((q) & 3) + 8 * ((q) >> 2))
#define A2_CHAIN(S, C, KA) do { a_bf16x8 kf0_ = *(LAS const a_bf16x8*)(lds + (KA)[0]), kf1_ = *(LAS const a_bf16x8*)(lds + (KA)[1]), kf2_ = *(LAS const a_bf16x8*)(lds + (KA)[2]), kf3_ = *(LAS const a_bf16x8*)(lds + (KA)[3]); \
        S = __builtin_amdgcn_mfma_f32_32x32x16_bf16(kf0_, qf[0], C, 0, 0, 0); S = __builtin_amdgcn_mfma_f32_32x32x16_bf16(kf1_, qf[1], S, 0, 0, 0); \
        S = __builtin_amdgcn_mfma_f32_32x32x16_bf16(kf2_, qf[2], S, 0, 0, 0); S = __builtin_amdgcn_mfma_f32_32x32x16_bf16(kf3_, qf[3], S, 0, 0, 0); } while (0)
#define A2_TAIL(S, VA) do { float p_[16]; _Pragma("unroll") for (int q = 0; q < 16; ++q) p_[q] = __builtin_amdgcn_exp2f(S[q]); \
        lsum += ((p_[0] + p_[1]) + (p_[2] + p_[3])) + ((p_[4] + p_[5]) + (p_[6] + p_[7])) + (((p_[8] + p_[9]) + (p_[10] + p_[11])) + ((p_[12] + p_[13]) + (p_[14] + p_[15]))); \
        a_bf16x8 pb0_, pb1_; { v4u w0_, w1_; w0_.x = a_cvtpk(p_[0], p_[1]); w0_.y = a_cvtpk(p_[2], p_[3]); w0_.z = a_cvtpk(p_[4], p_[5]); w0_.w = a_cvtpk(p_[6], p_[7]); \
          w1_.x = a_cvtpk(p_[8], p_[9]); w1_.y = a_cvtpk(p_[10], p_[11]); w1_.z = a_cvtpk(p_[12], p_[13]); w1_.w = a_cvtpk(p_[14], p_[15]); \
          pb0_ = __builtin_bit_cast(a_bf16x8, w0_); pb1_ = __builtin_bit_cast(a_bf16x8, w1_); } \
        a_s16x4 lo_, hi_; \
        lo_ = a_vtr(lds + VA(0, 0, 0)); hi_ = a_vtr(lds + VA(0, 0, 1)); o0 = __builtin_amdgcn_mfma_f32_32x32x16_bf16((a_bf16x8){lo_[0], lo_[1], lo_[2], lo_[3], hi_[0], hi_[1], hi_[2], hi_[3]}, pb0_, o0, 0, 0, 0); \
        lo_ = a_vtr(lds + VA(0, 1, 0)); hi_ = a_vtr(lds + VA(0, 1, 1)); o0 = __builtin_amdgcn_mfma_f32_32x32x16_bf16((a_bf16x8){lo_[0], lo_[1], lo_[2], lo_[3], hi_[0], hi_[1], hi_[2], hi_[3]}, pb1_, o0, 0, 0, 0); \
        lo_ = a_vtr(lds + VA(1, 0, 0)); hi_ = a_vtr(lds + VA(1, 0, 1)); o1 = __builtin_amdgcn_mfma_f32_32x32x16_bf16((a_bf16x8){lo_[0], lo_[1], lo_[2], lo_[3], hi_[0], hi_[1], hi_[2], hi_[3]}, pb0_, o1, 0, 0, 0); \
        lo_ = a_vtr(lds + VA(1, 1, 0)); hi_ = a_vtr(lds + VA(1, 1, 1)); o1 = __builtin_amdgcn_mfma_f32_32x32x16_bf16((a_bf16x8){lo_[0], lo_[1], lo_[2], lo_[3], hi_[0], hi_[1], hi_[2], hi_[3]}, pb1_, o1, 0, 0, 0); } while (0)
    for (int v = vcu; v < BATCH * 8; v += G) {
        const int b = v >> 3, h = v & 7, rowb = b * SEQ;
        const float sinkterm = __builtin_amdgcn_exp2f(sinks[h] * 1.4426950408889634f);
#define A2_ISSUE(it, sl) do { const int blk_ = ri_blk(it); const bf16* kb_ = PROJ + (size_t)(rowb + 128 * blk_) * NPROJ + ((it).ph == 0 ? COL_KB + h * 64 : COL_KA + (h >> 2) * 64); \
        const bf16* vb_ = PROJ + (size_t)(rowb + 128 * blk_) * NPROJ + ((it).ph == 0 ? COL_VB + h * 64 : COL_VA + (h >> 2) * 64); \
        _Pragma("unroll") for (int j_ = 0; j_ < 2; ++j_) { \
            __builtin_amdgcn_global_load_lds((const unsigned*)(kb_ + offK[j_]), (LAS unsigned*)(lds + (sl) * A2_SLOT + (2 * wave + j_) * 1024), 16, 0, 0); \
            __builtin_amdgcn_global_load_lds((const unsigned*)(vb_ + offV[j_]), (LAS unsigned*)(lds + (sl) * A2_SLOT + 16384 + (2 * wave + j_) * 1024), 16, 0, 0); } } while (0)
        RIter cons = {0, 0, 0}, iss = {0, 0, 0};
        if (mode != 2) A2_ISSUE(iss, 0); ri_next(iss); if (mode != 2) A2_ISSUE(iss, 1); ri_next(iss);
        int slot = 0, islot = 2;
        a_bf16x8 qf[4], qn[4]; a_f32x16 o0 = {}, o1 = {}; float lsum = 0.f;
        { const WTask w0 = wt_of(cons, wave); const int nrow0 = rowb + 128 * w0.cw + r;
          const bf16* qp = PROJ + (size_t)(nrow0 + i * 4) * NPROJ + COL_QB + h * 64 + 8 * hh;
#pragma unroll
          for (int s = 0; s < 4; ++s) { qn[s] = *(const a_bf16x8*)(qp + 16 * s); qf[s] = qn[s]; } }
        for (int round = 0; round < A2_NROUNDS; ++round) {
            if (round + 1 < A2_NROUNDS) A2_WAIT_V(4); else A2_WAIT_V(0);
            __builtin_amdgcn_s_barrier(); asm volatile("" ::: "memory");
            if (iss.ph < 2) { if (mode != 2) A2_ISSUE(iss, islot); ri_next(iss); }
            islot = (islot == 2) ? 0 : islot + 1;
            const WTask wt = wt_of(cons, wave);
            const bool isB = wt.isB, first = wt.first && wt.live, last = wt.last && wt.live;
            const int cw = wt.cw, blk = ri_blk(cons);
            const int qrow0 = isB ? rowb + 128 * cw + r : rowb + 32 * cw, qrs = isB ? 4 : 1;
            if (first && mode != 1) {
#pragma unroll
                for (int s = 0; s < 4; ++s) qf[s] = qn[s];
                o0 = (a_f32x16){}; o1 = (a_f32x16){}; lsum = 0.f;
            }
            RIter nxr = cons; ri_next(nxr); const WTask wn = wt_of(nxr, wave);
            const bool prefetch_q = wn.first && wn.live && mode != 1;
            if (prefetch_q) {
                const int nrow0 = wn.isB ? rowb + 128 * wn.cw + r : rowb + 32 * wn.cw, nrs = wn.isB ? 4 : 1;
                const bf16* qp = PROJ + (size_t)(nrow0 + i * nrs) * NPROJ + (wn.isB ? COL_QB : COL_QA) + h * 64 + 8 * hh;
#pragma unroll
                for (int s = 0; s < 4; ++s) qn[s] = *(const a_bf16x8*)(qp + 16 * s);
            }
            const int sbo = slot * A2_SLOT;
            if (mode != 1) {
            if (isB && blk <= cw) {
                const int d = cw - blk;
                int ka[4];
#pragma unroll
                for (int s = 0; s < 4; ++s) ka[s] = k1[s] + sbo;
                a_f32x16 S;
                if (d >= 5) { A2_CHAIN(S, c1R, ka); }
                else if (d >= 1 && d <= 3) { A2_CHAIN(S, c1F, ka); }
                else { const int Dt = 32 * d + i - 4 * hh; a_f32x16 C;
                    if (d == 0) {
#pragma unroll
                        for (int q = 0; q < 16; ++q) C[q] = (A2_OFFQ(q) <= Dt) ? c1F[q] : NINF;
                    } else {
#pragma unroll
                        for (int q = 0; q < 16; ++q) C[q] = (A2_OFFQ(q) >= Dt - 128) ? c1F[q] : c1R[q];
                    }
                    A2_CHAIN(S, C, ka); }
                const int vb0 = v1[0] + sbo, vb1 = v1[1] + sbo;
#define A2_VA1(dh, sp, e) (((dh) ? vb1 : vb0) + (sp) * 8192 + (e) * 4096)
                A2_TAIL(S, A2_VA1);
#undef A2_VA1
            }
            int t2lo, t2hi, lo0, maxd;
            if (isB) { t2lo = 0; t2hi = (blk == cw || blk == cw - 1) ? 4 : 0; maxd = 128; lo0 = r - ((blk == cw) ? 128 : 0) + 4 * i - 4 * hh; }
            else { const int t0 = 4 * blk; t2lo = (cw - 4 - t0) > 0 ? (cw - 4 - t0) : 0; t2hi = (cw - t0 + 1) < 4 ? (cw - t0 + 1) : 4; maxd = 127; lo0 = 32 * (cw - t0) + i - 4 * hh - 127; if (!wt.live) t2hi = t2lo; }
#define A2_MASKC(C, LO) do { _Pragma("unroll") for (int q = 0; q < 16; ++q) C[q] = ((unsigned)(A2_OFFQ(q) - (LO)) <= (unsigned)maxd) ? 0.0f : NINF; } while (0)
            int t2 = t2lo;
            for (; t2 + 1 < t2hi; t2 += 2) {
                const int tba = sbo + t2 * 4096, tbb = tba + 4096;
                int kaa[4], kab[4];
#pragma unroll
                for (int s = 0; s < 4; ++s) { kaa[s] = ((t2 & 1) ? ko[s] : ke[s]) + tba; kab[s] = ((t2 & 1) ? ke[s] : ko[s]) + tbb; }
                a_f32x16 Ca, Cb, Sa, Sb;
                A2_MASKC(Ca, lo0 - 32 * t2); A2_MASKC(Cb, lo0 - 32 * t2 - 32);
                { a_bf16x8 fa0 = *(LAS const a_bf16x8*)(lds + kaa[0]), fb0 = *(LAS const a_bf16x8*)(lds + kab[0]), fa1 = *(LAS const a_bf16x8*)(lds + kaa[1]), fb1 = *(LAS const a_bf16x8*)(lds + kab[1]);
                  a_bf16x8 fa2 = *(LAS const a_bf16x8*)(lds + kaa[2]), fb2 = *(LAS const a_bf16x8*)(lds + kab[2]), fa3 = *(LAS const a_bf16x8*)(lds + kaa[3]), fb3 = *(LAS const a_bf16x8*)(lds + kab[3]);
                  Sa = __builtin_amdgcn_mfma_f32_32x32x16_bf16(fa0, qf[0], Ca, 0, 0, 0); Sb = __builtin_amdgcn_mfma_f32_32x32x16_bf16(fb0, qf[0], Cb, 0, 0, 0);
                  Sa = __builtin_amdgcn_mfma_f32_32x32x16_bf16(fa1, qf[1], Sa, 0, 0, 0); Sb = __builtin_amdgcn_mfma_f32_32x32x16_bf16(fb1, qf[1], Sb, 0, 0, 0);
                  Sa = __builtin_amdgcn_mfma_f32_32x32x16_bf16(fa2, qf[2], Sa, 0, 0, 0); Sb = __builtin_amdgcn_mfma_f32_32x32x16_bf16(fb2, qf[2], Sb, 0, 0, 0);
                  Sa = __builtin_amdgcn_mfma_f32_32x32x16_bf16(fa3, qf[3], Sa, 0, 0, 0); Sb = __builtin_amdgcn_mfma_f32_32x32x16_bf16(fb3, qf[3], Sb, 0, 0, 0); }
                const int vx0 = v2[0] + tba, vx1 = v2[1] + tba, vx2 = v2[2] + tba, vx3 = v2[3] + tba;
#define A2_VA2(dh, sp, e) (((dh) ? ((e) ? vx3 : vx2) : ((e) ? vx1 : vx0)) + (sp) * 2048)
#define A2_VA2B(dh, sp, e) (((dh) ? ((e) ? vx3 : vx2) : ((e) ? vx1 : vx0)) + (sp) * 2048 + 4096)
                A2_TAIL(Sa, A2_VA2);
                A2_TAIL(Sb, A2_VA2B);
#undef A2_VA2B
#undef A2_VA2
            }
            if (t2 < t2hi) {
                const int tbo = sbo + t2 * 4096;
                int ka[4];
#pragma unroll
                for (int s = 0; s < 4; ++s) ka[s] = ((t2 & 1) ? ko[s] : ke[s]) + tbo;
                a_f32x16 C, S;
                A2_MASKC(C, lo0 - 32 * t2);
                A2_CHAIN(S, C, ka);
                const int vx0 = v2[0] + tbo, vx1 = v2[1] + tbo, vx2 = v2[2] + tbo, vx3 = v2[3] + tbo;
#define A2_VA2(dh, sp, e) (((dh) ? ((e) ? vx3 : vx2) : ((e) ? vx1 : vx0)) + (sp) * 2048)
                A2_TAIL(S, A2_VA2);
#undef A2_VA2
            }
#undef A2_MASKC
            }
            if (last && mode != 1) {
                const float ltot = lsum + __shfl_xor(lsum, 32) + (isB ? 0.f : sinkterm);
                const float rl = 1.0f / ltot;
#pragma unroll
                for (int g = 0; g < 4; ++g) {
                    typedef unsigned u32x2_t __attribute__((ext_vector_type(2)));
                    u32x2_t a, b2;
                    a.x = a_cvtpk(o0[4 * g] * rl, o0[4 * g + 1] * rl); a.y = a_cvtpk(o0[4 * g + 2] * rl, o0[4 * g + 3] * rl);
                    b2.x = a_cvtpk(o1[4 * g] * rl, o1[4 * g + 1] * rl); b2.y = a_cvtpk(o1[4 * g + 2] * rl, o1[4 * g + 3] * rl);
                    *(LAS u32x2_t*)(stg + i * ATT_STG_PITCH + (8 * g + 4 * hh) * 2) = a;
                    *(LAS u32x2_t*)(stg + i * ATT_STG_PITCH + (32 + 8 * g + 4 * hh) * 2) = b2;
                }
                const int ocol = isB ? 512 + h * 64 : h * 64;
#pragma unroll
                for (int jj = 0; jj < 4; ++jj) { const int row = jj * 8 + (lane >> 3), ch = lane & 7;
                    const v4u vv = *(LAS const v4u*)(stg + row * ATT_STG_PITCH + ch * 16);
                    if (mode == 0) *(v4u*)(MIX + (size_t)(qrow0 + row * qrs) * D + ocol + ch * 8) = vv; else asm volatile("" :: "v"(vv)); }
            }
            if (prefetch_q) {
#pragma unroll
                for (int s = 0; s < 4; ++s) asm volatile("" : "+v"(qn[s]));
            }
            slot = (slot == 2) ? 0 : slot + 1; ri_next(cons);
        }
        A2_WAIT_V(0); __builtin_amdgcn_s_barrier(); asm volatile("" ::: "memory");
#undef A2_ISSUE
    }
#undef A2_WAIT_V
#undef A2_OFFQ
#undef A2_CHAIN
#undef A2_TAIL
}

struct Args { const float* in[13]; float* out; unsigned char* ws; int ph_lo, ph_hi, li, pad; };
__global__ void __launch_bounds__(NWAVES * 64, 2) hymba_fwd(Args args) {
    extern __shared__ __attribute__((aligned(16))) unsigned char lds[];
    LAS unsigned char* L = (LAS unsigned char*)lds;
    volatile LAS unsigned* MISC = (volatile LAS unsigned*)(L + MISC_OFF);
    const int tid = threadIdx.x, lane = tid & 63, wave = __builtin_amdgcn_readfirstlane(tid >> 6);
    const int G = gridDim.x; const int bx = blockIdx.x; const int vcu = (G % 8 == 0) ? (bx % 8) * (G / 8) + bx / 8 : bx;
    unsigned char* ws = args.ws;
    gu32* ctl = (gu32*)(ws + WS_CTL);
    const float* x = args.in[0]; const int* positions = (const int*)args.in[1]; const float* g_attn = args.in[2]; const float* w_in = args.in[3];
    const float* gqa = args.in[4]; const float* gka = args.in[5]; const float* sinks = args.in[6]; const float* gqb = args.in[7]; const float* gkb = args.in[8];
    const float* w_out = args.in[9]; const float* g_mlp = args.in[10]; const float* w_up = args.in[11]; const float* w_dn = args.in[12];
    float* out = args.out;
    bf16* Win_t = (bf16*)(ws + WS_WIN); bf16* Wout_t = (bf16*)(ws + WS_WOUT); bf16* Wup_t = (bf16*)(ws + WS_WUP); bf16* Wdn_t = (bf16*)(ws + WS_WDN);
    float* rope = (float*)(ws + WS_ROPE); float* ssp = (float*)(ws + WS_SS);
    bf16* XN = (bf16*)(ws + WS_XN); bf16* PROJ = (bf16*)(ws + WS_PROJ); bf16* MIXB = (bf16*)(ws + WS_MIX); bf16* HID = (bf16*)(ws + WS_HID);
    for (int u = tid; u < (LDS_BYTES - LDSCTL_OFF) / 4; u += NWAVES * 64) ((LAS unsigned*)(L + LDSCTL_OFF))[u] = 0u;
    __syncthreads();
    const int bli = (N_LAUNCHES == PER_PHASE) ? 0 : args.li;
    XcdBarrier bar; bar.bar = (unsigned*)(ctl + CW_BAR) + bli * XCD_BAR_WORDS; bar.x = 0; bar.st = nullptr;
    if (N_LAUNCHES != PER_PHASE) bar = xcd_barrier_post((unsigned*)(ctl + CW_BAR) + bli * XCD_BAR_WORDS, MISC + 8);
#define GRID_BAR(seam) do { if (N_LAUNCHES == PER_PHASE) { if (tid == 0) __hip_atomic_store(ctl + CW_TMO, 0xBADBA0u | (unsigned)(seam), RLX_AGENT); } else { xcd_barrier(bar); } } while (0)
    const int lo = args.ph_lo, hi = args.ph_hi;
#define IN(k) (lo <= (k) && (k) < hi)
#define BOTH(k) (IN(k) && IN((k) + 1))

    if (IN(0)) { REP(0) {
        LAS float* scr = (LAS float*)(L + RING_OFF + wave * 16384);
        const int gw = vcu * NWAVES + wave, NGW = G * NWAVES;
        constexpr int I_IN = (D / 64) * (NPROJ / 32), I_OUT = (D / 64) * (D / 32), I_UP = (D / 64) * (FF / 32), I_DN = (FF / 64) * (D / 32);
        constexpr int NITEMS = I_IN + I_OUT + I_UP + I_DN;
        for (int it = gw; it < NITEMS; it += NGW) {
            int r = it;
            if (r < I_IN) { p0_transpose_item(w_in, D, NPROJ, Win_t, nullptr, scr, r, lane); continue; } r -= I_IN;
            if (r < I_OUT) { p0_transpose_item(w_out, D, D, Wout_t, nullptr, scr, r, lane); continue; } r -= I_OUT;
            if (r < I_UP) { p0_transpose_item(w_up, D, FF, Wup_t, g_mlp, scr, r, lane); continue; } r -= I_UP;
            p0_transpose_item(w_dn, FF, D, Wdn_t, nullptr, scr, r, lane);
        }
        for (int m = gw * 4; m < M; m += NGW * 4) rms_rows_to_bf16<4>(x + (size_t)m * D, g_attn, XN + (size_t)m * D, lane);
        for (int it = gw * 64 + lane; it < M * 8; it += NGW * 64) {
            const int m = it >> 3, i = it & 7;
            const float inv_freq = (i == 0) ? 1.0f : (i == 1) ? 0.193922743f : (i == 2) ? 0.0376060307f : (i == 3) ? 0.00729266461f : (i == 4) ? 0.00141421356f : (i == 5) ? 0.000274248188f : (i == 6) ? 5.3182961e-05f : 1.03133862e-05f;
            const float ang = (float)positions[m] * inv_freq;
            double rev = (double)ang * 0.15915494309189535; rev -= __builtin_floor(rev);
            const float rf = (float)rev;
            rope[(size_t)m * 16 + i] = __builtin_amdgcn_cosf(rf); rope[(size_t)m * 16 + 8 + i] = __builtin_amdgcn_sinf(rf);
        }
        }
        if (BOTH(0)) GRID_BAR(0);
    }
    if (IN(1)) {
        pg8::Gemm g{XN, Win_t, M, NPROJ, D}; pg8::StaticOrder S; S.init(M, NPROJ, G, (int)blockIdx.x);
        pg8::EpiQKV E{PROJ, NPROJ, gqa, gka, gqb, gkb, rope};
        REP(1) pg8::gemm_phase<pg8::EpiQKV, pg8::StaticOrder, true>(L + RING_OFF, g, S, E);
        if (BOTH(1)) GRID_BAR(1);
    }
    if (IN(2)) {
#if defined(NAIVE_ATTN)
        attn_naive(PROJ, MIXB, gqa, gka, gqb, gkb, sinks, vcu * (NWAVES * 64) + tid, G * NWAVES * 64);
#else
#if defined(ATTN_V1)
        REP(2) attn_phase(PROJ, MIXB, gqa, gka, gqb, gkb, sinks, L + RING_OFF, vcu, G, wave, lane);
#else
        REP(2) attn_phase2(PROJ, MIXB, sinks, L + RING_OFF, vcu, G, wave, lane, rep_ == 0 ? 0 : PROBE_MODE);
#endif
#endif
        if (BOTH(2)) GRID_BAR(2);
    }
    if (IN(3)) {
        pg8::Gemm g{MIXB, Wout_t, M, D, D}; pg8::StaticOrder S; S.init(M, D, G, (int)blockIdx.x);
        pg8::EpiOut E{x, XN, ssp, D};
        REP(3) pg8::gemm_phase<pg8::EpiOut, pg8::StaticOrder, true>(L + RING_OFF, g, S, E);
        if (BOTH(3)) GRID_BAR(3);
    }
    if (IN(4)) {
        pg8::Gemm g{XN, Wup_t, M, FF, D}; pg8::StaticOrder S; S.init(M, FF, G, (int)blockIdx.x);
        pg8::EpiUp E{ssp, HID, FF, 1.0f / D, RMS_EPS};
        REP(4) pg8::gemm_phase<pg8::EpiUp, pg8::StaticOrder, true>(L + RING_OFF, g, S, E);
        if (BOTH(4)) GRID_BAR(4);
    }
    if (IN(5)) {
        pg8::Gemm g{HID, Wdn_t, M, D, FF}; pg8::StaticOrder S; S.init(M, D, G, (int)blockIdx.x);
        pg8::EpiDown E{XN, out, D};
        pg8::gemm_phase<pg8::EpiDown, pg8::StaticOrder, true>(L + RING_OFF, g, S, E);
    }
#undef IN
#undef BOTH
}

extern "C" void kernel_launch(void* const* d_in, const int* in_sizes, int n_in, void* d_out, int out_size, void* d_ws, size_t ws_size, hipStream_t stream) {
    static int grid = 0;
    if (grid == 0) {
        if (n_in != 13 || in_sizes[0] != M * D || out_size != M * D || ws_size < WS_END) { fprintf(stderr, "kernel_launch: shape/workspace mismatch (n_in %d in0 %d out %d ws %zu); nothing launched\n", n_in, n_in > 0 ? in_sizes[0] : -1, out_size, ws_size); grid = -1; return; }
        int dev = 0, cus = 0, per_cu = 0;
        if (hipGetDevice(&dev) != hipSuccess || hipDeviceGetAttribute(&cus, hipDeviceAttributeMultiprocessorCount, dev) != hipSuccess) { fprintf(stderr, "kernel_launch: device query failed\n"); grid = -1; return; }
        if (hipFuncSetAttribute((const void*)hymba_fwd, hipFuncAttributeMaxDynamicSharedMemorySize, LDS_BYTES) != hipSuccess) { fprintf(stderr, "kernel_launch: hipFuncSetAttribute failed\n"); grid = -1; return; }
        if (hipOccupancyMaxActiveBlocksPerMultiprocessor(&per_cu, (const void*)hymba_fwd, NWAVES * 64, LDS_BYTES) != hipSuccess || per_cu < 1)
            fprintf(stderr, "kernel_launch: note: occupancy query reports %d workgroups per CU\n", per_cu);
        (void)hipGetLastError();
        grid = cus;
    }
    if (grid < 0) return;
    if (hipMemsetAsync((char*)d_ws + WS_CTL, 0, CTL_ZERO_BYTES, stream) != hipSuccess) { fprintf(stderr, "kernel_launch: hipMemsetAsync failed\n"); return; }
    Args a{};
    for (int i = 0; i < 13; ++i) a.in[i] = (const float*)d_in[i];
    a.out = (float*)d_out; a.ws = (unsigned char*)d_ws;
    static_assert(N_LAUNCHES == 1 || N_LAUNCHES == PER_PHASE, "MK_N_LAUNCHES must be 1 or 6");
    for (int li = 0; li < N_LAUNCHES; ++li) {
        a.ph_lo = (N_LAUNCHES == PER_PHASE) ? li : 0; a.ph_hi = (N_LAUNCHES == PER_PHASE) ? li + 1 : PER_PHASE; a.li = li;
        hipLaunchKernelGGL(hymba_fwd, dim3(grid), dim3(NWAVES * 64), LDS_BYTES, stream, a);
        const hipError_t le = hipPeekAtLastError();
        if (le != hipSuccess) { fprintf(stderr, "kernel_launch: launch %d failed: %s\n", li, hipGetErrorName(le)); break; }
    }
}
```

```cpp
#include <hip/hip_runtime.h>
#include <cstdio>
#include <cstdint>

#ifndef MK_N_LAUNCHES
#define MK_N_LAUNCHES 1
#endif
#ifndef REPEAT_MASK
#define REPEAT_MASK 0
#endif
#ifndef STAGGER_TICKS
#define STAGGER_TICKS 0
#endif
#ifndef STAGGER_PHASES
#define STAGGER_PHASES 0
#endif
#ifndef PROBE_MODE
#define PROBE_MODE 0
#endif
#define REP(k) for (int rep_ = 0; rep_ < 1 + ((REPEAT_MASK >> (k)) & 1); ++rep_)

namespace pg8 {
#define PG8_LAS __attribute__((address_space(3)))
typedef unsigned short bf16_t;
typedef short bf16x8 __attribute__((ext_vector_type(8)));
typedef float f32x4 __attribute__((ext_vector_type(4)));
typedef unsigned u32x4 __attribute__((ext_vector_type(4)));
constexpr int BM = 256, BK = 64, HALF = 128, HTB = HALF * BK * 2  , STAGE_BYTES = 8 * HTB, NXCD = 8, WGM = 8;

__host__ __device__ __forceinline__ int lds_byte(int r, int c) { const int st = (r >> 4) * 2 + (c >> 5), rr = r & 15, cc = c & 31, ob = rr * 64 + cc * 2; return st * 1024 + (ob ^ (((ob >> 9) & 1) << 5)); }
__host__ __device__ __forceinline__ void stage_rc(int b, int& R, int& C) { const int st = b / 1024, sb = b % 1024, swz = sb ^ (((sb >> 9) & 1) << 5); R = (st >> 1) * 16 + swz / 64; C = (st & 1) * 32 + (swz % 64) / 2; }
__host__ __device__ __forceinline__ int perm32(int rho) { const int n = rho >> 4, i = rho & 15; return 8 * (i >> 2) + 4 * n + (i & 3); }

struct Unit { int pm, pn; };
struct Gemm { const bf16_t* A; const bf16_t* Bt; int M, N, K; };

struct StaticOrder {
    int nM, nN, nwg, G, c;
    __host__ __device__ void init(int M, int N, int G_, int c_) { nM = M / BM; nN = N / BM; nwg = nM * nN; G = G_; c = c_; }
    __host__ __device__ bool next(int i, Unit& u) const {
        const long L = (long)i * G + c; if (L >= nwg) return false;
        int wgid = (int)L; { const int q = nwg / NXCD, r = nwg % NXCD, xcd = wgid % NXCD, off = wgid / NXCD; wgid = (xcd < r ? xcd * (q + 1) : r * (q + 1) + (xcd - r) * q) + off; }
        const int nig = WGM * nN, gid = wgid / nig, fm = gid * WGM, gsz = (nM - fm) < WGM ? (nM - fm) : WGM;
        u.pm = fm + ((wgid % nig) % gsz); u.pn = (wgid % nig) / gsz; return true;
    }
};

__device__ __forceinline__ unsigned cvt_pk_bf16(float lo, float hi) { unsigned r; asm volatile("v_cvt_pk_bf16_f32 %0, %1, %2" : "=v"(r) : "v"(lo), "v"(hi)); return r; }

constexpr int EPI_PITCH = 144, EPI_WBYTES = 16 * EPI_PITCH;
__device__ __forceinline__ void epi_store_rows(PG8_LAS unsigned char* sb, int lane, int fr, u32x4 d0, u32x4 d1, int off0, int off1, char* g, size_t pitch) {
    *(PG8_LAS u32x4*)(sb + fr * EPI_PITCH + off0) = d0; *(PG8_LAS u32x4*)(sb + fr * EPI_PITCH + off1) = d1;
#pragma unroll
    for (int k = 0; k < 2; ++k) { const int row = 8 * k + (lane >> 3); const u32x4 v = *(const PG8_LAS u32x4*)(sb + row * EPI_PITCH + (lane & 7) * 16);
        *(u32x4*)(g + (size_t)row * pitch + (lane & 7) * 16) = v; }
}
constexpr float QK_EPS = 1e-6f;
constexpr float C2 = 0.125f * 1.4426950408889634f;

struct EpiQKV {
    bf16_t* O; int ldc; const float* gqa; const float* gka; const float* gqb; const float* gkb; const float* rope;
    __device__ __forceinline__ void operator()(const f32x4 (&acc)[2][2][4][2], const Unit& u, int wr, int wc, int fr, int fq, PG8_LAS unsigned char* sb, int lane) const {
        const int pn = u.pn; int mode = 0; const float* g = gqa;
        if (pn < 2) { mode = 1; g = gqa; } else if (pn == 2) { if (wc < 2) { mode = 2; g = gka; } } else if (pn < 5) { mode = 1; g = gqb; } else if (pn < 7) { mode = 2; g = gkb; }
        const int row0 = u.pm * BM + wr * 64 + fr, rowg = u.pm * BM + wr * 64, colw = pn * BM + wc * 64;
        if (mode == 0) {
#pragma unroll
            for (int ai = 0; ai < 2; ++ai)
#pragma unroll
                for (int m = 0; m < 4; ++m) { u32x4 w[2];
#pragma unroll
                    for (int bj = 0; bj < 2; ++bj) { const f32x4 v0 = acc[ai][bj][m][0], v1 = acc[ai][bj][m][1];
                        w[bj].x = cvt_pk_bf16(v0[0], v0[1]); w[bj].y = cvt_pk_bf16(v0[2], v0[3]); w[bj].z = cvt_pk_bf16(v1[0], v1[1]); w[bj].w = cvt_pk_bf16(v1[2], v1[3]); }
                    epi_store_rows(sb, lane, fr, w[0], w[1], fq * 16, 64 + fq * 16, (char*)(O + (size_t)(rowg + ai * HALF + m * 16) * ldc + colw), (size_t)ldc * 2); }
            return;
        }
        f32x4 gv[2][2];
#pragma unroll
        for (int bj = 0; bj < 2; ++bj)
#pragma unroll
            for (int n = 0; n < 2; ++n) gv[bj][n] = *(const f32x4*)(g + 32 * bj + 8 * fq + 4 * n);
        const float sc = (mode == 1) ? C2 : 1.0f;
        const float sgn = (fq == 0) ? -1.0f : 1.0f;
#pragma unroll
        for (int ai = 0; ai < 2; ++ai)
#pragma unroll
            for (int m = 0; m < 4; ++m) {
                const int row = row0 + ai * HALF + m * 16;
                float ss = 0.f;
#pragma unroll
                for (int bj = 0; bj < 2; ++bj)
#pragma unroll
                    for (int n = 0; n < 2; ++n) { const f32x4 x = acc[ai][bj][m][n]; ss += (x[0] * x[0] + x[1] * x[1]) + (x[2] * x[2] + x[3] * x[3]); }
                ss += __shfl_xor(ss, 16); ss += __shfl_xor(ss, 32);
                const float rs = __builtin_amdgcn_rsqf(ss * (1.0f / 64.0f) + QK_EPS);
                f32x4 y[2][2];
#pragma unroll
                for (int bj = 0; bj < 2; ++bj)
#pragma unroll
                    for (int n = 0; n < 2; ++n) y[bj][n] = acc[ai][bj][m][n] * rs * gv[bj][n];
                const f32x4 c0 = *(const f32x4*)(rope + (size_t)row * 16), c1 = *(const f32x4*)(rope + (size_t)row * 16 + 4);
                const f32x4 s0 = *(const f32x4*)(rope + (size_t)row * 16 + 8), s1 = *(const f32x4*)(rope + (size_t)row * 16 + 12);
                f32x4 p0, p1;
#pragma unroll
                for (int e = 0; e < 4; ++e) { p0[e] = __shfl_xor(y[0][0][e], 16); p1[e] = __shfl_xor(y[0][1][e], 16); }
                if (fq < 2) { y[0][0] = y[0][0] * c0 + p0 * s0 * sgn; y[0][1] = y[0][1] * c1 + p1 * s1 * sgn; }
                u32x4 w[2];
#pragma unroll
                for (int bj = 0; bj < 2; ++bj) { const f32x4 v0 = y[bj][0] * sc, v1 = y[bj][1] * sc;
                    w[bj].x = cvt_pk_bf16(v0[0], v0[1]); w[bj].y = cvt_pk_bf16(v0[2], v0[3]); w[bj].z = cvt_pk_bf16(v1[0], v1[1]); w[bj].w = cvt_pk_bf16(v1[2], v1[3]); }
                epi_store_rows(sb, lane, fr, w[0], w[1], fq * 16, 64 + fq * 16, (char*)(O + (size_t)(rowg + ai * HALF + m * 16) * ldc + colw), (size_t)ldc * 2);
            }
    }
};

struct EpiOut {
    const float* x; bf16_t* hb; float* ssp; int ldc;
    __device__ __forceinline__ void operator()(const f32x4 (&acc)[2][2][4][2], const Unit& u, int wr, int wc, int fr, int fq, PG8_LAS unsigned char* sb, int lane) const {
        const int row0 = u.pm * BM + wr * 64 + fr, col0 = u.pn * BM + wc * 64 + 8 * fq;
#pragma unroll
        for (int ai = 0; ai < 2; ++ai)
#pragma unroll
            for (int m = 0; m < 4; ++m) {
                const int row = row0 + ai * HALF + m * 16; const size_t off = (size_t)row * ldc + col0; float ss = 0.f; u32x4 w[2];
#pragma unroll
                for (int bj = 0; bj < 2; ++bj) {
                    const f32x4 x0 = *(const f32x4*)(x + off + bj * 32), x1 = *(const f32x4*)(x + off + bj * 32 + 4);
                    const f32x4 v0 = acc[ai][bj][m][0] + x0, v1 = acc[ai][bj][m][1] + x1;
                    w[bj].x = cvt_pk_bf16(v0[0], v0[1]); w[bj].y = cvt_pk_bf16(v0[2], v0[3]); w[bj].z = cvt_pk_bf16(v1[0], v1[1]); w[bj].w = cvt_pk_bf16(v1[2], v1[3]);
                    ss += (v0[0] * v0[0] + v0[1] * v0[1]) + (v0[2] * v0[2] + v0[3] * v0[3]) + (v1[0] * v1[0] + v1[1] * v1[1]) + (v1[2] * v1[2] + v1[3] * v1[3]);
                }
                epi_store_rows(sb, lane, fr, w[0], w[1], fq * 16, 64 + fq * 16, (char*)(hb + (size_t)(row - fr) * ldc + u.pn * BM + wc * 64), (size_t)ldc * 2);
                ss += __shfl_xor(ss, 16); ss += __shfl_xor(ss, 32);
                if (fq == 0) ssp[(size_t)row * 16 + u.pn * 4 + wc] = ss;
            }
    }
};

struct EpiUp {
    const float* ssp; bf16_t* hid; int ldc; float inv_n, eps;
    __device__ __forceinline__ void operator()(const f32x4 (&acc)[2][2][4][2], const Unit& u, int wr, int wc, int fr, int fq, PG8_LAS unsigned char* sb, int lane) const {
        const int row0 = u.pm * BM + wr * 64 + fr, col0 = u.pn * BM + wc * 64 + 8 * fq;
#pragma unroll
        for (int ai = 0; ai < 2; ++ai)
#pragma unroll
            for (int m = 0; m < 4; ++m) {
                const int row = row0 + ai * HALF + m * 16;
                const f32x4 a = *(const f32x4*)(ssp + (size_t)row * 16), b = *(const f32x4*)(ssp + (size_t)row * 16 + 4), c = *(const f32x4*)(ssp + (size_t)row * 16 + 8), d = *(const f32x4*)(ssp + (size_t)row * 16 + 12);
                const f32x4 t = (a + b) + (c + d); const float ss = (t[0] + t[1]) + (t[2] + t[3]);
                const float rs = __builtin_amdgcn_rsqf(ss * inv_n + eps);
                u32x4 w[2];
#pragma unroll
                for (int bj = 0; bj < 2; ++bj) { f32x4 v0 = acc[ai][bj][m][0] * rs, v1 = acc[ai][bj][m][1] * rs;
#pragma unroll
                    for (int e = 0; e < 4; ++e) { const float r0 = __builtin_fmaxf(v0[e], 0.f), r1 = __builtin_fmaxf(v1[e], 0.f); v0[e] = r0 * r0; v1[e] = r1 * r1; }
                    w[bj].x = cvt_pk_bf16(v0[0], v0[1]); w[bj].y = cvt_pk_bf16(v0[2], v0[3]); w[bj].z = cvt_pk_bf16(v1[0], v1[1]); w[bj].w = cvt_pk_bf16(v1[2], v1[3]); }
                epi_store_rows(sb, lane, fr, w[0], w[1], fq * 16, 64 + fq * 16, (char*)(hid + (size_t)(row - fr) * ldc + u.pn * BM + wc * 64), (size_t)ldc * 2);
            }
    }
};

struct EpiDown {
    const bf16_t* hb; float* out; int ldc;
    __device__ __forceinline__ void operator()(const f32x4 (&acc)[2][2][4][2], const Unit& u, int wr, int wc, int fr, int fq, PG8_LAS unsigned char* sb, int lane) const {
        const int row0 = u.pm * BM + wr * 64 + fr, col0 = u.pn * BM + wc * 64 + 8 * fq;
#pragma unroll
        for (int ai = 0; ai < 2; ++ai)
#pragma unroll
            for (int m = 0; m < 4; ++m) {
                const size_t off = (size_t)(row0 + ai * HALF + m * 16) * ldc + col0;
#pragma unroll
                for (int bj = 0; bj < 2; ++bj) {
                    const u32x4 hw = *(const u32x4*)(hb + off + bj * 32);
                    const f32x4 h0 = {__uint_as_float(hw.x << 16), __uint_as_float(hw.x & 0xffff0000u), __uint_as_float(hw.y << 16), __uint_as_float(hw.y & 0xffff0000u)};
                    const f32x4 h1 = {__uint_as_float(hw.z << 16), __uint_as_float(hw.z & 0xffff0000u), __uint_as_float(hw.w << 16), __uint_as_float(hw.w & 0xffff0000u)};
                    const f32x4 o0 = h0 + acc[ai][bj][m][0], o1 = h1 + acc[ai][bj][m][1];
                    epi_store_rows(sb, lane, fr, __builtin_bit_cast(u32x4, o0), __builtin_bit_cast(u32x4, o1), fq * 32, fq * 32 + 16, (char*)(out + (size_t)(row0 - fr + ai * HALF + m * 16) * ldc + u.pn * BM + wc * 64 + bj * 32), (size_t)ldc * 4);
                }
            }
    }
};

template <class Epi, class Sched, bool ALIGN_EPI>
__device__ __forceinline__ void gemm_phase(PG8_LAS unsigned char* lds, PG8_LAS unsigned char* epi_lds, const Gemm g, const Sched& S, const Epi& E) {
    const int tid = threadIdx.x, wid = __builtin_amdgcn_readfirstlane(tid >> 6), lane = tid & 63, wr = wid >> 2, wc = wid & 3, fr = lane & 15, fq = lane >> 4;
    const int K = g.K, nt = K / BK;
    unsigned voffA[2], voffB[2];
#pragma unroll
    for (int i = 0; i < 2; ++i) { int R, C; stage_rc(tid * 16 + i * 8192, R, C); const int Rb = (R >> 5) * 64 + perm32(R & 31);
        voffA[i] = (unsigned)(R * K + C) * 2u; voffB[i] = (unsigned)(Rb * K + C) * 2u; }
    const size_t kstep = (size_t)(BK * 2);
    const size_t hstepA = (size_t)HALF * K * 2;
    const size_t hstepB = (size_t)32 * K * 2;
    const size_t tstep = (size_t)BM * K * 2;
    const unsigned ldsw = (unsigned)wid * 1024u;
    const int aoff = lds_byte(wr * 64 + fr, fq * 8), boff = lds_byte(wc * 32 + fr, fq * 8);
#define PG8_SA(b, h) (((b) * 2 + (h)) * HTB)
#define PG8_SB(b, h) ((4 + (b) * 2 + (h)) * HTB)
#define PG8_STAGE(bufoff, gbase, voff) do { _Pragma("unroll") for (int _i = 0; _i < 2; ++_i) \
        __builtin_amdgcn_global_load_lds((const unsigned*)((const char*)(gbase) + (voff)[_i]), (PG8_LAS unsigned*)(lds + (bufoff) + ldsw + _i * 8192), 16, 0, 0); } while (0)
#define PG8_LDA(dst, b, h) do { _Pragma("unroll") for (int m = 0; m < 4; ++m) _Pragma("unroll") for (int k = 0; k < 2; ++k) dst[m][k] = *(const PG8_LAS bf16x8*)(lds + PG8_SA(b, h) + aoff + m * 2048 + k * 1024); } while (0)
#define PG8_LDB(dst, b, h) do { _Pragma("unroll") for (int n = 0; n < 2; ++n) _Pragma("unroll") for (int k = 0; k < 2; ++k) dst[n][k] = *(const PG8_LAS bf16x8*)(lds + PG8_SB(b, h) + boff + n * 2048 + k * 1024); } while (0)
#define PG8_MMA(ai, bj, At, Bt) do { __builtin_amdgcn_s_setprio(1); _Pragma("unroll") for (int m = 0; m < 4; ++m) _Pragma("unroll") for (int n = 0; n < 2; ++n) _Pragma("unroll") for (int k = 0; k < 2; ++k) \
        acc[ai][bj][m][n] = __builtin_amdgcn_mfma_f32_16x16x32_bf16(Bt[n][k], At[m][k], acc[ai][bj][m][n], 0, 0, 0); __builtin_amdgcn_s_setprio(0); } while (0)
#define PG8_WAIT_V(n) asm volatile("s_waitcnt vmcnt(" #n ")" ::: "memory")
#define PG8_WAIT_L(n) asm volatile("s_waitcnt lgkmcnt(" #n ")" ::: "memory")
#define PG8_BAR __builtin_amdgcn_s_barrier()
#define PG8_SCHED __builtin_amdgcn_sched_barrier(0)
    Unit cur, nxt; int ui = 0;
    if (!S.next(0, cur)) return;
    f32x4 acc[2][2][4][2];
#pragma unroll
    for (int a = 0; a < 2; ++a)
#pragma unroll
        for (int b = 0; b < 2; ++b)
#pragma unroll
            for (int m = 0; m < 4; ++m)
#pragma unroll
                for (int n = 0; n < 2; ++n) acc[a][b][m][n] = (f32x4){0.f, 0.f, 0.f, 0.f};
    bf16x8 At[4][2], B0[2][2], B1[2][2];
    const char* cA = (const char*)g.A + (size_t)cur.pm * tstep; const char* cB = (const char*)g.Bt + (size_t)cur.pn * tstep;
    PG8_STAGE(PG8_SB(0, 0), cB, voffB); PG8_STAGE(PG8_SB(0, 1), cB + hstepB, voffB); PG8_STAGE(PG8_SA(0, 0), cA, voffA); PG8_STAGE(PG8_SA(0, 1), cA + hstepA, voffA);
    if (wr == 1) PG8_BAR;
    PG8_WAIT_V(2); PG8_BAR;
    PG8_STAGE(PG8_SB(1, 0), cB + kstep, voffB); PG8_STAGE(PG8_SA(1, 0), cA + kstep, voffA); PG8_STAGE(PG8_SB(1, 1), cB + hstepB + kstep, voffB);
    PG8_WAIT_V(6); PG8_BAR;
    for (;;) {
        const bool has_next = S.next(ui + 1, nxt);
        const char* nA = has_next ? (const char*)g.A + (size_t)nxt.pm * tstep : cA; const char* nB = has_next ? (const char*)g.Bt + (size_t)nxt.pn * tstep : cB;
        for (int t = 0; t < nt; t += 2) {
            const bool last = (t == nt - 2);
            const char* a1 = cA + (size_t)(t + 1) * kstep;
            const char* a2 = last ? nA : cA + (size_t)(t + 2) * kstep; const char* b2 = last ? nB : cB + (size_t)(t + 2) * kstep;
            const char* a3 = a2 + kstep; const char* b3 = b2 + kstep;
            PG8_LDB(B0, 0, 0); PG8_LDB(B1, 0, 1); PG8_SCHED; PG8_LDA(At, 0, 0); PG8_STAGE(PG8_SA(1, 1), a1 + hstepA, voffA);
            PG8_WAIT_V(8); PG8_WAIT_L(0); PG8_BAR; PG8_MMA(0, 0, At, B0); PG8_MMA(0, 1, At, B1); PG8_BAR; PG8_SCHED;
            PG8_LDA(At, 0, 1); PG8_STAGE(PG8_SB(0, 0), b2, voffB); PG8_STAGE(PG8_SB(0, 1), b2 + hstepB, voffB); PG8_STAGE(PG8_SA(0, 0), a2, voffA);
            PG8_WAIT_V(8); PG8_WAIT_L(0); PG8_BAR; PG8_MMA(1, 0, At, B0); PG8_MMA(1, 1, At, B1); PG8_BAR; PG8_SCHED;
            PG8_LDB(B0, 1, 0); PG8_LDB(B1, 1, 1); PG8_SCHED; PG8_LDA(At, 1, 0); PG8_STAGE(PG8_SA(0, 1), a2 + hstepA, voffA);
            PG8_WAIT_V(8); PG8_WAIT_L(0); PG8_BAR; PG8_MMA(0, 0, At, B0); PG8_MMA(0, 1, At, B1); PG8_BAR; PG8_SCHED;
            PG8_LDA(At, 1, 1); PG8_STAGE(PG8_SB(1, 0), b3, voffB); PG8_STAGE(PG8_SB(1, 1), b3 + hstepB, voffB); PG8_STAGE(PG8_SA(1, 0), a3, voffA);
            PG8_WAIT_V(8); PG8_WAIT_L(0); PG8_BAR; PG8_MMA(1, 0, At, B0); PG8_MMA(1, 1, At, B1); PG8_BAR; PG8_SCHED;
        }
        if constexpr (ALIGN_EPI) { if (wr == 0) PG8_BAR; }
        E(acc, cur, wr, wc, fr, fq, epi_lds + wid * EPI_WBYTES, lane);
        if (!has_next) break;
#pragma unroll
        for (int a = 0; a < 2; ++a)
#pragma unroll
            for (int b = 0; b < 2; ++b)
#pragma unroll
                for (int m = 0; m < 4; ++m)
#pragma unroll
                    for (int n = 0; n < 2; ++n) acc[a][b][m][n] = (f32x4){0.f, 0.f, 0.f, 0.f};
        cur = nxt; cA = nA; cB = nB; ++ui;
        if constexpr (ALIGN_EPI) { if (wr == 1) PG8_BAR; }
    }
    PG8_WAIT_V(0);
    if constexpr (!ALIGN_EPI) { if (wr == 0) PG8_BAR; }
    PG8_BAR;
#undef PG8_SA
#undef PG8_SB
#undef PG8_STAGE
#undef PG8_LDA
#undef PG8_LDB
#undef PG8_MMA
#undef PG8_WAIT_V
#undef PG8_WAIT_L
#undef PG8_BAR
#undef PG8_SCHED
}
}

constexpr int NWAVES = 8;
constexpr int BATCH = 32, SEQ = 2048, D = 1024, FF = 4096, HD = 64;
constexpr int M = BATCH * SEQ;
constexpr int NPROJ = 2304;
constexpr int COL_QA = 0, COL_KA = 512, COL_VA = 640, COL_QB = 768, COL_KB = 1280, COL_VB = 1792;
constexpr float RMS_EPS = 1e-6f;
constexpr int N_LAUNCHES = MK_N_LAUNCHES, PER_PHASE = 6;
constexpr int N_BAR_REGIONS = (MK_N_LAUNCHES == PER_PHASE) ? 1 : MK_N_LAUNCHES;

constexpr size_t MiB = 1u << 20;
constexpr size_t WS_CTL = 0, CTL_ZERO_BYTES = 1 * MiB;
constexpr size_t WS_WIN = 2 * MiB, WS_WOUT = 8 * MiB, WS_WUP = 10 * MiB, WS_WDN = 18 * MiB;
constexpr size_t WS_ROPE = 26 * MiB;
constexpr size_t WS_SS = 30 * MiB;
constexpr size_t WS_XN = 64 * MiB;
constexpr size_t WS_PROJ = 192 * MiB;
constexpr size_t WS_MIX = 480 * MiB;
constexpr size_t WS_HID = 192 * MiB;
constexpr size_t WS_END = 704 * MiB;
static_assert(WS_WIN + (size_t)NPROJ * D * 2 <= WS_WOUT && WS_WDN + (size_t)D * FF * 2 <= WS_ROPE && WS_SS + (size_t)M * 64 <= WS_XN, "d_ws map");
static_assert(WS_XN + (size_t)M * D * 2 <= WS_PROJ && WS_PROJ + (size_t)M * NPROJ * 2 <= WS_MIX && WS_MIX + (size_t)M * D * 2 <= WS_END && WS_HID + (size_t)M * FF * 2 <= WS_END, "d_ws map");
constexpr int CW_TMO = 0, CW_CODE = 1;
constexpr int CW_BAR = 4096;

constexpr int RING_OFF = 0, RING_BYTES = 131072;
constexpr int EPI_OFF = RING_BYTES;
constexpr int LDSCTL_OFF = 150528, MISC_OFF = LDSCTL_OFF + 320;
constexpr int LDS_BYTES = 151552;
static_assert(EPI_OFF + 8 * pg8::EPI_WBYTES <= LDSCTL_OFF && MISC_OFF + 128 <= LDS_BYTES, "LDS map");

#define GAS __attribute__((address_space(1)))
#define LAS __attribute__((address_space(3)))
typedef unsigned short bf16;
typedef unsigned v4u __attribute__((ext_vector_type(4)));
typedef float f32x4 __attribute__((ext_vector_type(4)));
typedef GAS unsigned gu32;
#define RLX_AGENT __ATOMIC_RELAXED, __HIP_MEMORY_SCOPE_AGENT
#define LDS_WAIT() asm volatile("s_waitcnt lgkmcnt(0)" ::: "memory")
#define VM_WAIT() asm volatile("s_waitcnt vmcnt(0)" ::: "memory")
__device__ __forceinline__ unsigned f2bf(float f) { unsigned u = __builtin_bit_cast(unsigned, f); return (u + 0x7fffu + ((u >> 16) & 1u)) >> 16; }
__device__ __forceinline__ unsigned pk2(float lo, float hi) { return f2bf(lo) | (f2bf(hi) << 16); }
__device__ __forceinline__ float bf_lo(unsigned u) { return __uint_as_float(u << 16); }
__device__ __forceinline__ float bf_hi(unsigned u) { return __uint_as_float(u & 0xffff0000u); }

#define XB_TMO      128
#define XB_XCNT(j)  (256  + 64 * (j))
#define XB_XSUB(j)  (1280 + 64 * (j))
#define XB_XGEN(j)  (2304 + 64 * (j))
#define XB_TOP      3328
#define XB_TOPGEN   3392
#define XCD_BAR_WORDS 3456
#define XB_SPIN_CAP (1u << 18)

__device__ __forceinline__ unsigned xb_ld(unsigned* p)              { return __hip_atomic_load(p, __ATOMIC_RELAXED, __HIP_MEMORY_SCOPE_AGENT); }
__device__ __forceinline__ unsigned xb_add(unsigned* p, unsigned v) { return __hip_atomic_fetch_add(p, v, __ATOMIC_RELAXED, __HIP_MEMORY_SCOPE_AGENT); }
__device__ __forceinline__ unsigned xb_xcc_id() { return (unsigned)__builtin_amdgcn_s_getreg((3 << 11) | 20) & 0xFu; }
#define XB_SPIN(cond, bar) do { unsigned _sp = 0; while (cond) { __builtin_amdgcn_s_sleep(1); \
    if ((++_sp & 255u) == 0u) { if (xb_ld(&(bar)[XB_TMO])) break; if (_sp > XB_SPIN_CAP) { atomicAdd(&(bar)[XB_TMO], 1u); break; } } } } while (0)

struct XcdBarrier { unsigned* bar; unsigned x; volatile LAS unsigned* st; };

__device__ __forceinline__ XcdBarrier xcd_barrier_post(unsigned* bar, volatile LAS unsigned* st) {
    XcdBarrier b; b.bar = bar; b.x = xb_xcc_id(); b.st = st;
    if (threadIdx.x == 0) (void)xb_add(&bar[XB_XCNT(b.x)], 1u);
    return b;
}
__device__ __forceinline__ void xcd_barrier_complete(unsigned* bar, unsigned x, unsigned& nloc, unsigned& nx) {
    const unsigned G = gridDim.x * gridDim.y * gridDim.z;
    unsigned sum, cnt, mine, sp = 0u;
    for (;;) {
        sum = 0u; cnt = 0u; mine = 0u;
#pragma unroll
        for (unsigned j = 0; j < 16; ++j) { const unsigned c = xb_ld(&bar[XB_XCNT(j)]); sum += c; cnt += (c > 0u) ? 1u : 0u; mine = (j == x) ? c : mine; }
        if (sum == G) break;
        __builtin_amdgcn_s_sleep(1);
        if ((++sp & 255u) == 0u) { if (xb_ld(&bar[XB_TMO])) break; if (sp > XB_SPIN_CAP) { atomicAdd(&bar[XB_TMO], 1u); break; } }
    }
    nloc = mine > 0u ? mine : 1u; nx = cnt > 0u ? cnt : 1u;
}
__device__ __forceinline__ void xcd_barrier(const XcdBarrier& b) {
    asm volatile("s_waitcnt vmcnt(0)" ::: "memory");
    __syncthreads();
    if (threadIdx.x == 0) {
        unsigned* bar = b.bar;
        __builtin_amdgcn_s_waitcnt(0);
        unsigned nloc = b.st[0], nx = b.st[1];
        if (nloc == 0u) { xcd_barrier_complete(bar, b.x, nloc, nx); b.st[0] = nloc; b.st[1] = nx; }
        const unsigned old = xb_add(&bar[XB_XSUB(b.x)], 1u);
        const unsigned gen = old / nloc;
        if (old + 1u == (gen + 1u) * nloc) {
            __builtin_amdgcn_fence(__ATOMIC_RELEASE, "agent");
            asm volatile("s_waitcnt vmcnt(0)" ::: "memory");
            const unsigned og = xb_add(&bar[XB_TOP], 1u);
            const unsigned tg = og / nx;
            if (og + 1u == (tg + 1u) * nx) xb_add(&bar[XB_TOPGEN], 1u);
            else XB_SPIN(xb_ld(&bar[XB_TOPGEN]) == tg, bar);
            __builtin_amdgcn_fence(__ATOMIC_ACQUIRE, "agent");
            xb_add(&bar[XB_XGEN(b.x)], 1u);
            asm volatile("s_waitcnt vmcnt(0)" ::: "memory");
        } else {
            XB_SPIN(xb_ld(&bar[XB_XGEN(b.x)]) == gen, bar);
            __builtin_amdgcn_fence(__ATOMIC_ACQUIRE, "agent");
            asm volatile("s_waitcnt vmcnt(0)" ::: "memory");
        }
    }
    __syncthreads();
}

__device__ __forceinline__ float wave_sum(float v) {
#pragma unroll
    for (int o = 1; o < 64; o <<= 1) v += __shfl_xor(v, o);
    return v;
}
__device__ __forceinline__ float wave_max(float v) {
#pragma unroll
    for (int o = 1; o < 64; o <<= 1) v = __builtin_fmaxf(v, __shfl_xor(v, o));
    return v;
}
__device__ __forceinline__ void p0_transpose_item(const float* W, int K, int N, bf16* WT, const float* gk, LAS float* scr, int item, int lane) {
    const int nblk = N / 32, kb = item / nblk, nb = item % nblk, k0 = 64 * kb, n0 = 32 * nb;
    float wv[32];
#pragma unroll
    for (int i = 0; i < 32; ++i) wv[i] = W[(size_t)(k0 + 2 * i + (lane >> 5)) * N + n0 + (lane & 31)];
    if (gk) {
#pragma unroll
        for (int i = 0; i < 32; ++i) wv[i] *= gk[k0 + 2 * i + (lane >> 5)]; }
#pragma unroll
    for (int i = 0; i < 32; ++i) scr[(2 * i + (lane >> 5)) * 33 + (lane & 31)] = wv[i];
    LDS_WAIT(); asm volatile("" ::: "memory");
    const int c = lane & 7;
#pragma unroll
    for (int j = 0; j < 4; ++j) { const int n = (lane >> 3) + 8 * j; const LAS float* s = scr + (8 * c) * 33 + n;
        v4u o; o.x = pk2(s[0 * 33], s[1 * 33]); o.y = pk2(s[2 * 33], s[3 * 33]); o.z = pk2(s[4 * 33], s[5 * 33]); o.w = pk2(s[6 * 33], s[7 * 33]);
        *(GAS v4u*)(WT + (size_t)(n0 + n) * K + k0 + 8 * c) = o; }
    LDS_WAIT(); asm volatile("" ::: "memory");
}
template <int NR>
__device__ __forceinline__ void rms_rows_to_bf16(const float* xrow, const float* gain, bf16* orow, int lane) {
    f32x4 v[NR][4]; float s[NR];
#pragma unroll
    for (int r = 0; r < NR; ++r) { const GAS f32x4* xr = (const GAS f32x4*)(xrow + (size_t)r * D) + lane;
#pragma unroll
        for (int j = 0; j < 4; ++j) v[r][j] = __builtin_nontemporal_load(xr + 64 * j); }
    const GAS f32x4* gr = (const GAS f32x4*)gain + lane;
    f32x4 gg[4];
#pragma unroll
    for (int j = 0; j < 4; ++j) gg[j] = gr[64 * j];
#pragma unroll
    for (int r = 0; r < NR; ++r) { s[r] = 0.f;
#pragma unroll
        for (int j = 0; j < 4; ++j) s[r] += (v[r][j].x * v[r][j].x + v[r][j].y * v[r][j].y) + (v[r][j].z * v[r][j].z + v[r][j].w * v[r][j].w); }
#pragma unroll
    for (int o = 1; o < 64; o <<= 1) {
#pragma unroll
        for (int r = 0; r < NR; ++r) s[r] += __shfl_xor(s[r], o); }
#pragma unroll
    for (int r = 0; r < NR; ++r) { const float rstd = __builtin_amdgcn_rsqf(s[r] * (1.f / D) + RMS_EPS);
        GAS unsigned long long* o8 = (GAS unsigned long long*)(orow + (size_t)r * D) + lane;
#pragma unroll
        for (int j = 0; j < 4; ++j) { const f32x4 y = v[r][j] * rstd * gg[j];
            o8[64 * j] = (unsigned long long)pk2(y.x, y.y) | ((unsigned long long)pk2(y.z, y.w) << 32); } }
}

__device__ __forceinline__ void attn_naive(const bf16* PROJ, bf16* MIX, const float* gqa, const float* gka, const float* gqb, const float* gkb, const float* sinks, int gtid, int nthr) {
    float mqa = 0.f, mka = 0.f, mqb = 0.f, mkb = 0.f;
    for (int d = 0; d < HD; ++d) { mqa = __builtin_fmaxf(mqa, __builtin_fabsf(gqa[d])); mka = __builtin_fmaxf(mka, __builtin_fabsf(gka[d])); mqb = __builtin_fmaxf(mqb, __builtin_fabsf(gqb[d])); mkb = __builtin_fmaxf(mkb, __builtin_fabsf(gkb[d])); }
    const float shiftA = pg8::C2 * 64.f * mqa * mka, shiftB = pg8::C2 * 64.f * mqb * mkb;
    for (long item = gtid; item < (long)M * 16; item += nthr) {
        const int hh = (int)(item / M), m = (int)(item % M), t = m & (SEQ - 1), rowbase = m - t;
        const bool isA = hh < 8; const int h = hh & 7;
        const int qcol = isA ? COL_QA + h * 64 : COL_QB + h * 64, kcol = isA ? COL_KA + (h >> 2) * 64 : COL_KB + h * 64, vcol = isA ? COL_VA + (h >> 2) * 64 : COL_VB + h * 64;
        const float shift = isA ? shiftA : shiftB;
        float q[64], o[64]; float l = 0.f;
        { const v4u* qp = (const v4u*)(PROJ + (size_t)m * NPROJ + qcol);
#pragma unroll
          for (int c = 0; c < 8; ++c) { const v4u u = qp[c]; q[8 * c + 0] = bf_lo(u.x); q[8 * c + 1] = bf_hi(u.x); q[8 * c + 2] = bf_lo(u.y); q[8 * c + 3] = bf_hi(u.y); q[8 * c + 4] = bf_lo(u.z); q[8 * c + 5] = bf_hi(u.z); q[8 * c + 6] = bf_lo(u.w); q[8 * c + 7] = bf_hi(u.w); } }
#pragma unroll
        for (int d = 0; d < 64; ++d) o[d] = 0.f;
#define KEY(srow, wgt) do { const v4u* kp = (const v4u*)(PROJ + (size_t)(rowbase + (srow)) * NPROJ + kcol); float sc = 0.f; \
        _Pragma("unroll") for (int c = 0; c < 8; ++c) { const v4u u = kp[c]; sc += q[8 * c + 0] * bf_lo(u.x) + q[8 * c + 1] * bf_hi(u.x) + q[8 * c + 2] * bf_lo(u.y) + q[8 * c + 3] * bf_hi(u.y) + q[8 * c + 4] * bf_lo(u.z) + q[8 * c + 5] * bf_hi(u.z) + q[8 * c + 6] * bf_lo(u.w) + q[8 * c + 7] * bf_hi(u.w); } \
        const float p = (wgt) * __builtin_amdgcn_exp2f(sc - shift); l += p; const v4u* vp = (const v4u*)(PROJ + (size_t)(rowbase + (srow)) * NPROJ + vcol); \
        _Pragma("unroll") for (int c = 0; c < 8; ++c) { const v4u u = vp[c]; o[8 * c + 0] += p * bf_lo(u.x); o[8 * c + 1] += p * bf_hi(u.x); o[8 * c + 2] += p * bf_lo(u.y); o[8 * c + 3] += p * bf_hi(u.y); o[8 * c + 4] += p * bf_lo(u.z); o[8 * c + 5] += p * bf_hi(u.z); o[8 * c + 6] += p * bf_lo(u.w); o[8 * c + 7] += p * bf_hi(u.w); } } while (0)
        if (isA) {
            for (int dist = 0; dist <= 127 && dist <= t; ++dist) KEY(t - dist, 1.0f);
            l += __builtin_amdgcn_exp2f(sinks[h] * 1.4426950408889634f - shift);
        } else {
            for (int dist = 0; dist <= 128 && dist <= t; ++dist) { const float w = 1.0f + (((dist & 3) == 0) ? 1.0f : 0.0f) + (((dist & 15) == 0) ? 1.0f : 0.0f); KEY(t - dist, w); }
            for (int dist = 132; dist <= 512 && dist <= t; dist += 4) { const float w = 1.0f + (((dist & 15) == 0) ? 1.0f : 0.0f); KEY(t - dist, w); }
            for (int dist = 528; dist <= t; dist += 16) KEY(t - dist, 1.0f);
        }
#undef KEY
        const float rl = 1.0f / l;
        v4u* op = (v4u*)(MIX + (size_t)m * D + hh * 64);
#pragma unroll
        for (int c = 0; c < 8; ++c) { v4u u; u.x = pk2(o[8 * c + 0] * rl, o[8 * c + 1] * rl); u.y = pk2(o[8 * c + 2] * rl, o[8 * c + 3] * rl); u.z = pk2(o[8 * c + 4] * rl, o[8 * c + 5] * rl); u.w = pk2(o[8 * c + 6] * rl, o[8 * c + 7] * rl); op[c] = u; }
    }
}


typedef short a_bf16x8 __attribute__((ext_vector_type(8)));
typedef short a_s16x4 __attribute__((ext_vector_type(4)));
typedef float a_f32x16 __attribute__((ext_vector_type(16)));
typedef float a_f32x2 __attribute__((ext_vector_type(2)));
typedef __bf16 a_bf16x2 __attribute__((ext_vector_type(2)));
__device__ __forceinline__ unsigned a_cvtpk(float lo, float hi) { a_f32x2 v = {lo, hi}; a_bf16x2 b = __builtin_convertvector(v, a_bf16x2); return __builtin_bit_cast(unsigned, b); }
__device__ __forceinline__ a_s16x4 a_vtr(LAS const unsigned char* p) { return __builtin_bit_cast(a_s16x4, __builtin_amdgcn_ds_read_tr16_b64_v4i16((LAS a_s16x4*)p)); }
constexpr int ATT_WLDS = 16384;
constexpr int ATT_STG = 8192, ATT_STG_PITCH = 144;

struct AttnTask { int qrow0, qrs, qcol, kcol, vcol, n1, row1, D01, kt2lo, kt2hi, row2, D02, qstep2, maxd2, orow0, ors, ocol; float shift, sinkterm; };

__device__ __forceinline__ void attn_task(const bf16* __restrict__ PROJ, bf16* __restrict__ MIX, LAS unsigned char* wl, const int lane, const AttnTask& T) {
    const int i = lane & 31, hh = lane >> 5;
    a_bf16x8 qf[4];
    { const bf16* qp = PROJ + (size_t)(T.qrow0 + i * T.qrs) * NPROJ + T.qcol + 8 * hh;
#pragma unroll
      for (int s = 0; s < 4; ++s) qf[s] = *(const a_bf16x8*)(qp + 16 * s); }
    a_f32x16 o0 = {}, o1 = {}; float lsum = 0.f;
    const int Dl1 = T.D01 + i - 4 * hh, Dl2 = T.D02 + T.qstep2 * i - 4 * hh;
    float wg[4];
#pragma unroll
    for (int c = 0; c < 4; ++c) wg[c] = ((Dl1 & 3) == c) ? 1.0f : 0.0f;
    const int nt = T.n1 + (T.kt2hi - T.kt2lo);
    const int klane = i * NPROJ + 8 * hh, vlane = (lane >> 3) * NPROJ + (lane & 7) * 8;
    LAS unsigned char* vw = wl + ((lane & 7) >> 2) * 2048 + (lane >> 3) * 64 + (lane & 3) * 16;
    LAS const unsigned char* tra = wl + (4 * hh + ((lane & 15) >> 2)) * 64 + ((lane >> 4) & 1) * 32 + (lane & 3) * 8;
    a_f32x16 negs;
#pragma unroll
    for (int r = 0; r < 16; ++r) negs[r] = -T.shift;
    v4u kn[4]; v4u vn[4];
#define ATT_LOAD(j) do { const int seg1_ = (j) < T.n1; const int kt_ = seg1_ ? (j) : T.kt2lo + ((j) - T.n1); const int row_ = seg1_ ? T.row1 + 128 * kt_ : T.row2 + 32 * kt_; const int rs_ = seg1_ ? 4 : 1; \
        const bf16* kb_ = PROJ + (size_t)row_ * NPROJ + T.kcol + (size_t)(vlane - (lane & 7) * 8) * rs_ + (lane & 7) * 8; const bf16* vb_ = PROJ + (size_t)row_ * NPROJ + T.vcol + (size_t)(vlane - (lane & 7) * 8) * rs_ + (lane & 7) * 8; \
        _Pragma("unroll") for (int jj = 0; jj < 4; ++jj) kn[jj] = *(const v4u*)(kb_ + (size_t)(8 * jj * rs_) * NPROJ); \
        _Pragma("unroll") for (int jj = 0; jj < 4; ++jj) vn[jj] = *(const v4u*)(vb_ + (size_t)(8 * jj * rs_) * NPROJ); } while (0)
    ATT_LOAD(0);
    for (int j = 0; j < nt; ++j) {
        v4u kr[4]; v4u vr[4];
#pragma unroll
        for (int s = 0; s < 4; ++s) { kr[s] = kn[s]; vr[s] = vn[s]; }
        if (j + 1 < nt) ATT_LOAD(j + 1);
        const bool seg1 = j < T.n1; const int kt = seg1 ? j : T.kt2lo + (j - T.n1);
        const int Dt = (seg1 ? Dl1 : Dl2) - 32 * kt;
        const int D0 = (seg1 ? T.D01 : T.D02) - 32 * kt, qst = seg1 ? 1 : T.qstep2, maxd = seg1 ? 128 : T.maxd2;
        const int dpmin = D0 - 31, dpmax = D0 + 31 * qst;
        const int cls = (dpmin >= 0 && dpmax <= maxd) ? 1 : (dpmin > maxd ? 2 : 0);
#pragma unroll
        for (int jj = 0; jj < 4; ++jj) *(LAS v4u*)(vw + 512 * jj) = vr[jj];
#pragma unroll
        for (int jj = 0; jj < 4; ++jj) *(LAS v4u*)(wl + 4096 + (lane & 7) * 512 + (((8 * jj + (lane >> 3)) ^ (lane & 7)) * 16)) = kr[jj];
        a_bf16x8 kf[4];
#pragma unroll
        for (int s = 0; s < 4; ++s) kf[s] = *(LAS const a_bf16x8*)(wl + 4096 + (2 * s + hh) * 512 + ((i ^ (2 * s + hh)) * 16));
        a_f32x16 S = negs;
#pragma unroll
        for (int s = 0; s < 4; ++s) S = __builtin_amdgcn_mfma_f32_32x32x16_bf16(kf[s], qf[s], S, 0, 0, 0);
        float p[16];
        float wm[4];
#pragma unroll
        for (int c = 0; c < 4; ++c) wm[c] = seg1 ? wg[c] : 0.0f;
        if (cls == 1) {
#pragma unroll
            for (int r = 0; r < 16; ++r) p[r] = (1.0f + wm[r & 3]) * __builtin_amdgcn_exp2f(S[r]);
        } else if (cls == 2) {
#pragma unroll
            for (int r = 0; r < 16; ++r) p[r] = wm[r & 3] * __builtin_amdgcn_exp2f(S[r]);
        } else {
#pragma unroll
            for (int r = 0; r < 16; ++r) { const int dp = Dt - ((r & 3) + 8 * (r >> 2));
                const float w = (((unsigned)dp <= (unsigned)maxd) ? 1.0f : 0.0f) + ((dp >= 0) ? wm[r & 3] : 0.0f);
                p[r] = w * __builtin_amdgcn_exp2f(S[r]); }
        }
        float ls = 0.f;
#pragma unroll
        for (int r = 0; r < 16; ++r) ls += p[r];
        lsum += ls;
        a_bf16x8 pb0, pb1;
        { v4u w0, w1; w0.x = a_cvtpk(p[0], p[1]); w0.y = a_cvtpk(p[2], p[3]); w0.z = a_cvtpk(p[4], p[5]); w0.w = a_cvtpk(p[6], p[7]);
          w1.x = a_cvtpk(p[8], p[9]); w1.y = a_cvtpk(p[10], p[11]); w1.z = a_cvtpk(p[12], p[13]); w1.w = a_cvtpk(p[14], p[15]);
          pb0 = __builtin_bit_cast(a_bf16x8, w0); pb1 = __builtin_bit_cast(a_bf16x8, w1); }
        {
            a_s16x4 lo, hi;
#define ATT_VF (a_bf16x8){lo[0], lo[1], lo[2], lo[3], hi[0], hi[1], hi[2], hi[3]}
            lo = a_vtr(tra);               hi = a_vtr(tra + 512);               o0 = __builtin_amdgcn_mfma_f32_32x32x16_bf16(ATT_VF, pb0, o0, 0, 0, 0);
            lo = a_vtr(tra + 1024);        hi = a_vtr(tra + 1024 + 512);        o0 = __builtin_amdgcn_mfma_f32_32x32x16_bf16(ATT_VF, pb1, o0, 0, 0, 0);
            lo = a_vtr(tra + 2048);        hi = a_vtr(tra + 2048 + 512);        o1 = __builtin_amdgcn_mfma_f32_32x32x16_bf16(ATT_VF, pb0, o1, 0, 0, 0);
            lo = a_vtr(tra + 2048 + 1024); hi = a_vtr(tra + 2048 + 1024 + 512); o1 = __builtin_amdgcn_mfma_f32_32x32x16_bf16(ATT_VF, pb1, o1, 0, 0, 0);
#undef ATT_VF
        }
    }
#undef ATT_LOAD
    const float ltot = lsum + __shfl_xor(lsum, 32) + T.sinkterm;
    const float rl = 1.0f / ltot;
    LAS unsigned char* stg = wl + ATT_STG;
#pragma unroll
    for (int g = 0; g < 4; ++g) {
        typedef unsigned u32x2_t __attribute__((ext_vector_type(2)));
        u32x2_t a, b2;
        a.x = a_cvtpk(o0[4 * g] * rl, o0[4 * g + 1] * rl); a.y = a_cvtpk(o0[4 * g + 2] * rl, o0[4 * g + 3] * rl);
        b2.x = a_cvtpk(o1[4 * g] * rl, o1[4 * g + 1] * rl); b2.y = a_cvtpk(o1[4 * g + 2] * rl, o1[4 * g + 3] * rl);
        *(LAS u32x2_t*)(stg + i * ATT_STG_PITCH + (8 * g + 4 * hh) * 2) = a;
        *(LAS u32x2_t*)(stg + i * ATT_STG_PITCH + (32 + 8 * g + 4 * hh) * 2) = b2;
    }
#pragma unroll
    for (int jj = 0; jj < 4; ++jj) { const int row = jj * 8 + (lane >> 3), ch = lane & 7;
        const v4u v = *(LAS const v4u*)(stg + row * ATT_STG_PITCH + ch * 16);
        *(v4u*)(MIX + (size_t)(T.orow0 + row * T.ors) * D + T.ocol + ch * 8) = v; }
}

__device__ __forceinline__ void attn_phase(const bf16* PROJ, bf16* MIX, const float* gqa, const float* gka, const float* gqb, const float* gkb, const float* sinks, LAS unsigned char* lds, int vcu, int G, int wave, int lane) {
    const float mqa = wave_max(__builtin_fabsf(gqa[lane])), mka = wave_max(__builtin_fabsf(gka[lane])), mqb = wave_max(__builtin_fabsf(gqb[lane])), mkb = wave_max(__builtin_fabsf(gkb[lane]));
    const float shiftA = pg8::C2 * 64.f * mqa * mka, shiftB = pg8::C2 * 64.f * mqb * mkb;
    LAS unsigned char* wl = lds + wave * ATT_WLDS;
    for (int v = vcu; v < BATCH * 8; v += G) {
        const int b = v >> 3, h = v & 7, rowb = b * SEQ;
        for (int k = 0; k < 16; ++k) {
            AttnTask T;
            if (k < 8) {
                const int r = wave & 3, half = wave >> 2, pr = 2 * (k >> 1) + half, c = (k & 1) ? 15 - pr : pr;
                T.qrow0 = rowb + 128 * c + r; T.qrs = 4; T.qcol = COL_QB + h * 64; T.kcol = COL_KB + h * 64; T.vcol = COL_VB + h * 64;
                T.n1 = c + 1; T.row1 = rowb + r; T.D01 = 32 * c;
                T.kt2lo = (c == 0) ? 4 : 0; T.kt2hi = 8; T.row2 = rowb + 128 * c - 128; T.D02 = 128 + r; T.qstep2 = 4; T.maxd2 = 128;
                T.orow0 = T.qrow0; T.ors = 4; T.ocol = 512 + h * 64; T.shift = shiftB; T.sinkterm = 0.f;
            } else {
                const int c = wave + 8 * (k - 8);
                T.qrow0 = rowb + 32 * c; T.qrs = 1; T.qcol = COL_QA + h * 64; T.kcol = COL_KA + (h >> 2) * 64; T.vcol = COL_VA + (h >> 2) * 64;
                T.n1 = 0; T.row1 = rowb; T.D01 = 0;
                T.kt2lo = (c < 4) ? 4 - c : 0; T.kt2hi = 5; T.row2 = rowb + 32 * c - 128; T.D02 = 128; T.qstep2 = 1; T.maxd2 = 127;
                T.orow0 = T.qrow0; T.ors = 1; T.ocol = h * 64; T.shift = shiftA; T.sinkterm = __builtin_amdgcn_exp2f(sinks[h] * 1.4426950408889634f - shiftA);
            }
            attn_task(PROJ, MIX, wl, lane, T);
        }
    }
}


constexpr int A2_SLOT = 32768, A2_STG = 98304, A2_STG_W = 4608, A2_NROUNDS = 72 + 16;
struct RIter { int ph, p, k; };
__device__ __forceinline__ void ri_next(RIter& it) { it.k++; if (it.ph == 0) { if (it.k == 2 * it.p + 2) { it.k = 0; it.p++; if (it.p == 8) { it.p = 0; it.ph = 1; } } } else if (it.k == 16) { it.k = 0; it.ph++; } }
__device__ __forceinline__ int ri_blk(const RIter& it) { return it.k; }
struct WTask { int cw; bool isB, first, last, live; };
__device__ __forceinline__ WTask wt_of(const RIter& it, int wave) {
    WTask t; t.isB = it.ph == 0; const int blk = it.k;
    if (t.isB) { t.cw = 2 * it.p + (wave >> 2); t.first = blk == 0; t.last = blk == t.cw; t.live = blk <= t.cw; }
    else if (wave < 4) { t.cw = 8 * ((blk + 1) >> 1) + wave; t.first = (blk & 1) || blk == 0; t.last = !(blk & 1); t.live = t.cw < 64; }
    else { t.cw = 8 * (blk >> 1) + wave; t.first = !(blk & 1); t.last = (blk & 1); t.live = true; }
    if (it.ph >= 2) { t.live = false; t.first = false; t.last = false; }
    return t;
}

__device__ __forceinline__ void attn_phase2(const bf16* __restrict__ PROJ, bf16* __restrict__ MIX, const float* sinks,
                                            LAS unsigned char* lds, int vcu, int G, int wave, int lane, const int mode) {
    const int i = lane & 31, hh = lane >> 5, r = wave & 3, grp = wave >> 2;
    const float NINF = -__builtin_inff();
    unsigned offK[2], offV[2];
#pragma unroll
    for (int j = 0; j < 2; ++j) { const int n = 2 * wave + j, slot = 8 * n + (lane >> 3), cp = lane & 7;
        const int rk = slot ^ ((slot >> 4) & 3), ch = cp ^ ((slot >> 1) & 7); offK[j] = (unsigned)(rk * NPROJ + ch * 8);
        const int rv = slot ^ ((slot >> 2) & 3), dh = (cp >> 2) ^ ((slot >> 1) & 1); offV[j] = (unsigned)(rv * NPROJ + dh * 32 + (cp & 3) * 8); }
    int k1[4], ke[4], ko[4], v1[2], v2[4];
    { const int rho = 4 * i + r, slot = rho ^ ((rho >> 4) & 3), sw = (slot >> 1) & 7;
#pragma unroll
      for (int s = 0; s < 4; ++s) k1[s] = slot * 128 + (((2 * s + hh) ^ sw) * 16); }
    { const int xe = i ^ (i >> 4), xo = i ^ (2 | (i >> 4));
#pragma unroll
      for (int s = 0; s < 4; ++s) { ke[s] = xe * 128 + (((2 * s + hh) ^ ((xe >> 1) & 7)) * 16); ko[s] = xo * 128 + (((2 * s + hh) ^ ((xo >> 1) & 7)) * 16); } }
    { const int q4 = (lane & 15) >> 2, g = (lane >> 4) & 1, pp = lane & 3;
#pragma unroll
      for (int dh = 0; dh < 2; ++dh) { const int sl = 16 * hh + 4 * q4 + (r ^ q4); v1[dh] = 16384 + sl * 128 + ((dh ^ ((sl >> 1) & 1)) * 64) + g * 32 + pp * 8; }
#pragma unroll
      for (int x = 0; x < 4; ++x) { const int dh = x >> 1, e = x & 1, kk = 8 * e + 4 * hh + q4, sl = kk ^ ((kk >> 2) & 3); v2[x] = 16384 + sl * 128 + ((dh ^ ((sl >> 1) & 1)) * 64) + g * 32 + pp * 8; } }
    a_f32x16 c1F, c1R;
#pragma unroll
    for (int q = 0; q < 16; ++q) { const bool mt = ((q & 3) == (i & 3)); c1F[q] = mt ? 1.0f : 0.0f; c1R[q] = mt ? 0.0f : NINF; }
    LAS unsigned char* stg = lds + A2_STG + wave * A2_STG_W;
#define A2_WAIT_V(n) asm volatile("s_waitcnt vmcnt(" #n ")" ::: "memory")
#define A2_OFFQ(q) (((q) & 3) + 8 * ((q) >> 2))
#define A2_CHAIN(S, C, KA) do { a_bf16x8 kf0_ = *(LAS const a_bf16x8*)(lds + (KA)[0]), kf1_ = *(LAS const a_bf16x8*)(lds + (KA)[1]), kf2_ = *(LAS const a_bf16x8*)(lds + (KA)[2]), kf3_ = *(LAS const a_bf16x8*)(lds + (KA)[3]); \
        S = __builtin_amdgcn_mfma_f32_32x32x16_bf16(kf0_, qf[0], C, 0, 0, 0); S = __builtin_amdgcn_mfma_f32_32x32x16_bf16(kf1_, qf[1], S, 0, 0, 0); \
        S = __builtin_amdgcn_mfma_f32_32x32x16_bf16(kf2_, qf[2], S, 0, 0, 0); S = __builtin_amdgcn_mfma_f32_32x32x16_bf16(kf3_, qf[3], S, 0, 0, 0); } while (0)
#define A2_TAIL(S, VA) do { float p_[16]; _Pragma("unroll") for (int q = 0; q < 16; ++q) p_[q] = __builtin_amdgcn_exp2f(S[q]); \
        lsum += ((p_[0] + p_[1]) + (p_[2] + p_[3])) + ((p_[4] + p_[5]) + (p_[6] + p_[7])) + (((p_[8] + p_[9]) + (p_[10] + p_[11])) + ((p_[12] + p_[13]) + (p_[14] + p_[15]))); \
        a_bf16x8 pb0_, pb1_; { v4u w0_, w1_; w0_.x = a_cvtpk(p_[0], p_[1]); w0_.y = a_cvtpk(p_[2], p_[3]); w0_.z = a_cvtpk(p_[4], p_[5]); w0_.w = a_cvtpk(p_[6], p_[7]); \
          w1_.x = a_cvtpk(p_[8], p_[9]); w1_.y = a_cvtpk(p_[10], p_[11]); w1_.z = a_cvtpk(p_[12], p_[13]); w1_.w = a_cvtpk(p_[14], p_[15]); \
          pb0_ = __builtin_bit_cast(a_bf16x8, w0_); pb1_ = __builtin_bit_cast(a_bf16x8, w1_); } \
        a_s16x4 lo_, hi_; \
        lo_ = a_vtr(lds + VA(0, 0, 0)); hi_ = a_vtr(lds + VA(0, 0, 1)); o0 = __builtin_amdgcn_mfma_f32_32x32x16_bf16((a_bf16x8){lo_[0], lo_[1], lo_[2], lo_[3], hi_[0], hi_[1], hi_[2], hi_[3]}, pb0_, o0, 0, 0, 0); \
        lo_ = a_vtr(lds + VA(0, 1, 0)); hi_ = a_vtr(lds + VA(0, 1, 1)); o0 = __builtin_amdgcn_mfma_f32_32x32x16_bf16((a_bf16x8){lo_[0], lo_[1], lo_[2], lo_[3], hi_[0], hi_[1], hi_[2], hi_[3]}, pb1_, o0, 0, 0, 0); \
        lo_ = a_vtr(lds + VA(1, 0, 0)); hi_ = a_vtr(lds + VA(1, 0, 1)); o1 = __builtin_amdgcn_mfma_f32_32x32x16_bf16((a_bf16x8){lo_[0], lo_[1], lo_[2], lo_[3], hi_[0], hi_[1], hi_[2], hi_[3]}, pb0_, o1, 0, 0, 0); \
        lo_ = a_vtr(lds + VA(1, 1, 0)); hi_ = a_vtr(lds + VA(1, 1, 1)); o1 = __builtin_amdgcn_mfma_f32_32x32x16_bf16((a_bf16x8){lo_[0], lo_[1], lo_[2], lo_[3], hi_[0], hi_[1], hi_[2], hi_[3]}, pb1_, o1, 0, 0, 0); } while (0)
    for (int v = vcu; v < BATCH * 8; v += G) {
        const int b = v >> 3, h = v & 7, rowb = b * SEQ;
        const float sinkterm = __builtin_amdgcn_exp2f(sinks[h] * 1.4426950408889634f);
#define A2_ISSUE(it, sl) do { const int blk_ = ri_blk(it); const bf16* kb_ = PROJ + (size_t)(rowb + 128 * blk_) * NPROJ + ((it).ph == 0 ? COL_KB + h * 64 : COL_KA + (h >> 2) * 64); \
        const bf16* vb_ = PROJ + (size_t)(rowb + 128 * blk_) * NPROJ + ((it).ph == 0 ? COL_VB + h * 64 : COL_VA + (h >> 2) * 64); \
        _Pragma("unroll") for (int j_ = 0; j_ < 2; ++j_) { \
            __builtin_amdgcn_global_load_lds((const unsigned*)(kb_ + offK[j_]), (LAS unsigned*)(lds + (sl) * A2_SLOT + (2 * wave + j_) * 1024), 16, 0, 0); \
            __builtin_amdgcn_global_load_lds((const unsigned*)(vb_ + offV[j_]), (LAS unsigned*)(lds + (sl) * A2_SLOT + 16384 + (2 * wave + j_) * 1024), 16, 0, 0); } } while (0)
        RIter cons = {0, 0, 0}, iss = {0, 0, 0};
        if (mode != 2) A2_ISSUE(iss, 0); ri_next(iss); if (mode != 2) A2_ISSUE(iss, 1); ri_next(iss);
        int slot = 0, islot = 2;
        a_bf16x8 qf[4], qn[4]; a_f32x16 o0 = {}, o1 = {}; float lsum = 0.f;
        { const WTask w0 = wt_of(cons, wave); const int nrow0 = rowb + 128 * w0.cw + r;
          const bf16* qp = PROJ + (size_t)(nrow0 + i * 4) * NPROJ + COL_QB + h * 64 + 8 * hh;
#pragma unroll
          for (int s = 0; s < 4; ++s) { qn[s] = *(const a_bf16x8*)(qp + 16 * s); qf[s] = qn[s]; } }
        for (int round = 0; round < A2_NROUNDS; ++round) {
            if (round + 1 < A2_NROUNDS) A2_WAIT_V(4); else A2_WAIT_V(0);
            __builtin_amdgcn_s_barrier(); asm volatile("" ::: "memory");
            if (iss.ph < 2) { if (mode != 2) A2_ISSUE(iss, islot); ri_next(iss); }
            islot = (islot == 2) ? 0 : islot + 1;
            const WTask wt = wt_of(cons, wave);
            const bool isB = wt.isB, first = wt.first && wt.live, last = wt.last && wt.live;
            const int cw = wt.cw, blk = ri_blk(cons);
            const int qrow0 = isB ? rowb + 128 * cw + r : rowb + 32 * cw, qrs = isB ? 4 : 1;
            if (first && mode != 1) {
#pragma unroll
                for (int s = 0; s < 4; ++s) qf[s] = qn[s];
                o0 = (a_f32x16){}; o1 = (a_f32x16){}; lsum = 0.f;
            }
            RIter nxr = cons; ri_next(nxr); const WTask wn = wt_of(nxr, wave);
            const bool prefetch_q = wn.first && wn.live && mode != 1;
            if (prefetch_q) {
                const int nrow0 = wn.isB ? rowb + 128 * wn.cw + r : rowb + 32 * wn.cw, nrs = wn.isB ? 4 : 1;
                const bf16* qp = PROJ + (size_t)(nrow0 + i * nrs) * NPROJ + (wn.isB ? COL_QB : COL_QA) + h * 64 + 8 * hh;
#pragma unroll
                for (int s = 0; s < 4; ++s) qn[s] = *(const a_bf16x8*)(qp + 16 * s);
            }
            const int sbo = slot * A2_SLOT;
            if (mode != 1) {
            if (isB && blk <= cw) {
                const int d = cw - blk;
                int ka[4];
#pragma unroll
                for (int s = 0; s < 4; ++s) ka[s] = k1[s] + sbo;
                a_f32x16 S;
                if (d >= 5) { A2_CHAIN(S, c1R, ka); }
                else if (d >= 1 && d <= 3) { A2_CHAIN(S, c1F, ka); }
                else { const int Dt = 32 * d + i - 4 * hh; a_f32x16 C;
                    if (d == 0) {
#pragma unroll
                        for (int q = 0; q < 16; ++q) C[q] = (A2_OFFQ(q) <= Dt) ? c1F[q] : NINF;
                    } else {
#pragma unroll
                        for (int q = 0; q < 16; ++q) C[q] = (A2_OFFQ(q) >= Dt - 128) ? c1F[q] : c1R[q];
                    }
                    A2_CHAIN(S, C, ka); }
                const int vb0 = v1[0] + sbo, vb1 = v1[1] + sbo;
#define A2_VA1(dh, sp, e) (((dh) ? vb1 : vb0) + (sp) * 8192 + (e) * 4096)
                A2_TAIL(S, A2_VA1);
#undef A2_VA1
            }
            int t2lo, t2hi, lo0, maxd;
            if (isB) { t2lo = 0; t2hi = (blk == cw || blk == cw - 1) ? 4 : 0; maxd = 128; lo0 = r - ((blk == cw) ? 128 : 0) + 4 * i - 4 * hh; }
            else { const int t0 = 4 * blk; t2lo = (cw - 4 - t0) > 0 ? (cw - 4 - t0) : 0; t2hi = (cw - t0 + 1) < 4 ? (cw - t0 + 1) : 4; maxd = 127; lo0 = 32 * (cw - t0) + i - 4 * hh - 127; if (!wt.live) t2hi = t2lo; }
#define A2_MASKC(C, LO) do { _Pragma("unroll") for (int q = 0; q < 16; ++q) C[q] = ((unsigned)(A2_OFFQ(q) - (LO)) <= (unsigned)maxd) ? 0.0f : NINF; } while (0)
            int t2 = t2lo;
            for (; t2 + 1 < t2hi; t2 += 2) {
                const int tba = sbo + t2 * 4096, tbb = tba + 4096;
                int kaa[4], kab[4];
#pragma unroll
                for (int s = 0; s < 4; ++s) { kaa[s] = ((t2 & 1) ? ko[s] : ke[s]) + tba; kab[s] = ((t2 & 1) ? ke[s] : ko[s]) + tbb; }
                a_f32x16 Ca, Cb, Sa, Sb;
                A2_MASKC(Ca, lo0 - 32 * t2); A2_MASKC(Cb, lo0 - 32 * t2 - 32);
                { a_bf16x8 fa0 = *(LAS const a_bf16x8*)(lds + kaa[0]), fb0 = *(LAS const a_bf16x8*)(lds + kab[0]), fa1 = *(LAS const a_bf16x8*)(lds + kaa[1]), fb1 = *(LAS const a_bf16x8*)(lds + kab[1]);
                  a_bf16x8 fa2 = *(LAS const a_bf16x8*)(lds + kaa[2]), fb2 = *(LAS const a_bf16x8*)(lds + kab[2]), fa3 = *(LAS const a_bf16x8*)(lds + kaa[3]), fb3 = *(LAS const a_bf16x8*)(lds + kab[3]);
                  Sa = __builtin_amdgcn_mfma_f32_32x32x16_bf16(fa0, qf[0], Ca, 0, 0, 0); Sb = __builtin_amdgcn_mfma_f32_32x32x16_bf16(fb0, qf[0], Cb, 0, 0, 0);
                  Sa = __builtin_amdgcn_mfma_f32_32x32x16_bf16(fa1, qf[1], Sa, 0, 0, 0); Sb = __builtin_amdgcn_mfma_f32_32x32x16_bf16(fb1, qf[1], Sb, 0, 0, 0);
                  Sa = __builtin_amdgcn_mfma_f32_32x32x16_bf16(fa2, qf[2], Sa, 0, 0, 0); Sb = __builtin_amdgcn_mfma_f32_32x32x16_bf16(fb2, qf[2], Sb, 0, 0, 0);
                  Sa = __builtin_amdgcn_mfma_f32_32x32x16_bf16(fa3, qf[3], Sa, 0, 0, 0); Sb = __builtin_amdgcn_mfma_f32_32x32x16_bf16(fb3, qf[3], Sb, 0, 0, 0); }
                const int vx0 = v2[0] + tba, vx1 = v2[1] + tba, vx2 = v2[2] + tba, vx3 = v2[3] + tba;
#define A2_VA2(dh, sp, e) (((dh) ? ((e) ? vx3 : vx2) : ((e) ? vx1 : vx0)) + (sp) * 2048)
#define A2_VA2B(dh, sp, e) (((dh) ? ((e) ? vx3 : vx2) : ((e) ? vx1 : vx0)) + (sp) * 2048 + 4096)
                A2_TAIL(Sa, A2_VA2);
                A2_TAIL(Sb, A2_VA2B);
#undef A2_VA2B
#undef A2_VA2
            }
            if (t2 < t2hi) {
                const int tbo = sbo + t2 * 4096;
                int ka[4];
#pragma unroll
                for (int s = 0; s < 4; ++s) ka[s] = ((t2 & 1) ? ko[s] : ke[s]) + tbo;
                a_f32x16 C, S;
                A2_MASKC(C, lo0 - 32 * t2);
                A2_CHAIN(S, C, ka);
                const int vx0 = v2[0] + tbo, vx1 = v2[1] + tbo, vx2 = v2[2] + tbo, vx3 = v2[3] + tbo;
#define A2_VA2(dh, sp, e) (((dh) ? ((e) ? vx3 : vx2) : ((e) ? vx1 : vx0)) + (sp) * 2048)
                A2_TAIL(S, A2_VA2);
#undef A2_VA2
            }
#undef A2_MASKC
            }
            if (last && mode != 1) {
                const float ltot = lsum + __shfl_xor(lsum, 32) + (isB ? 0.f : sinkterm);
                const float rl = 1.0f / ltot;
#pragma unroll
                for (int g = 0; g < 4; ++g) {
                    typedef unsigned u32x2_t __attribute__((ext_vector_type(2)));
                    u32x2_t a, b2;
                    a.x = a_cvtpk(o0[4 * g] * rl, o0[4 * g + 1] * rl); a.y = a_cvtpk(o0[4 * g + 2] * rl, o0[4 * g + 3] * rl);
                    b2.x = a_cvtpk(o1[4 * g] * rl, o1[4 * g + 1] * rl); b2.y = a_cvtpk(o1[4 * g + 2] * rl, o1[4 * g + 3] * rl);
                    *(LAS u32x2_t*)(stg + i * ATT_STG_PITCH + (8 * g + 4 * hh) * 2) = a;
                    *(LAS u32x2_t*)(stg + i * ATT_STG_PITCH + (32 + 8 * g + 4 * hh) * 2) = b2;
                }
                const int ocol = isB ? 512 + h * 64 : h * 64;
#pragma unroll
                for (int jj = 0; jj < 4; ++jj) { const int row = jj * 8 + (lane >> 3), ch = lane & 7;
                    const v4u vv = *(LAS const v4u*)(stg + row * ATT_STG_PITCH + ch * 16);
                    if (mode == 0) *(v4u*)(MIX + (size_t)(qrow0 + row * qrs) * D + ocol + ch * 8) = vv; else asm volatile("" :: "v"(vv)); }
            }
            if (prefetch_q) {
#pragma unroll
                for (int s = 0; s < 4; ++s) asm volatile("" : "+v"(qn[s]));
            }
            slot = (slot == 2) ? 0 : slot + 1; ri_next(cons);
        }
        A2_WAIT_V(0); __builtin_amdgcn_s_barrier(); asm volatile("" ::: "memory");
#undef A2_ISSUE
    }
#undef A2_WAIT_V
#undef A2_OFFQ
#undef A2_CHAIN
#undef A2_TAIL
}

struct Args { const float* in[13]; float* out; unsigned char* ws; int ph_lo, ph_hi, li, pad; };
__global__ void __launch_bounds__(NWAVES * 64, 2) hymba_fwd(Args args) {
    extern __shared__ __attribute__((aligned(16))) unsigned char lds[];
    LAS unsigned char* L = (LAS unsigned char*)lds;
    volatile LAS unsigned* MISC = (volatile LAS unsigned*)(L + MISC_OFF);
    const int tid = threadIdx.x, lane = tid & 63, wave = __builtin_amdgcn_readfirstlane(tid >> 6);
    const int G = gridDim.x; const int bx = blockIdx.x; const int vcu = (G % 8 == 0) ? (bx % 8) * (G / 8) + bx / 8 : bx;
    unsigned char* ws = args.ws;
    gu32* ctl = (gu32*)(ws + WS_CTL);
    const float* x = args.in[0]; const int* positions = (const int*)args.in[1]; const float* g_attn = args.in[2]; const float* w_in = args.in[3];
    const float* gqa = args.in[4]; const float* gka = args.in[5]; const float* sinks = args.in[6]; const float* gqb = args.in[7]; const float* gkb = args.in[8];
    const float* w_out = args.in[9]; const float* g_mlp = args.in[10]; const float* w_up = args.in[11]; const float* w_dn = args.in[12];
    float* out = args.out;
    bf16* Win_t = (bf16*)(ws + WS_WIN); bf16* Wout_t = (bf16*)(ws + WS_WOUT); bf16* Wup_t = (bf16*)(ws + WS_WUP); bf16* Wdn_t = (bf16*)(ws + WS_WDN);
    float* rope = (float*)(ws + WS_ROPE); float* ssp = (float*)(ws + WS_SS);
    bf16* XN = (bf16*)(ws + WS_XN); bf16* PROJ = (bf16*)(ws + WS_PROJ); bf16* MIXB = (bf16*)(ws + WS_MIX); bf16* HID = (bf16*)(ws + WS_HID);
    for (int u = tid; u < (LDS_BYTES - LDSCTL_OFF) / 4; u += NWAVES * 64) ((LAS unsigned*)(L + LDSCTL_OFF))[u] = 0u;
    __syncthreads();
    const int bli = (N_LAUNCHES == PER_PHASE) ? 0 : args.li;
    XcdBarrier bar; bar.bar = (unsigned*)(ctl + CW_BAR) + bli * XCD_BAR_WORDS; bar.x = 0; bar.st = nullptr;
    if (N_LAUNCHES != PER_PHASE) bar = xcd_barrier_post((unsigned*)(ctl + CW_BAR) + bli * XCD_BAR_WORDS, MISC + 8);
#define GRID_BAR(seam) do { if (N_LAUNCHES == PER_PHASE) { if (tid == 0) __hip_atomic_store(ctl + CW_TMO, 0xBADBA0u | (unsigned)(seam), RLX_AGENT); } else { xcd_barrier(bar); } } while (0)
    const int lo = args.ph_lo, hi = args.ph_hi;
#define IN(k) (lo <= (k) && (k) < hi)
#define STAGGER(k) do { if (((STAGGER_PHASES >> (k)) & 1) && STAGGER_TICKS > 0 && ((blockIdx.x >> 3) & 1)) { const unsigned long long t0_ = __builtin_amdgcn_s_memrealtime(); while (__builtin_amdgcn_s_memrealtime() - t0_ < (unsigned long long)STAGGER_TICKS) __builtin_amdgcn_s_sleep(16); } } while (0)
#define BOTH(k) (IN(k) && IN((k) + 1))

    if (IN(0)) { REP(0) {
        LAS float* scr = (LAS float*)(L + RING_OFF + wave * 16384);
        const int gw = vcu * NWAVES + wave, NGW = G * NWAVES;
        constexpr int I_IN = (D / 64) * (NPROJ / 32), I_OUT = (D / 64) * (D / 32), I_UP = (D / 64) * (FF / 32), I_DN = (FF / 64) * (D / 32);
        constexpr int NITEMS = I_IN + I_OUT + I_UP + I_DN;
        for (int it = gw; it < NITEMS; it += NGW) {
            int r = it;
            if (r < I_IN) { p0_transpose_item(w_in, D, NPROJ, Win_t, nullptr, scr, r, lane); continue; } r -= I_IN;
            if (r < I_OUT) { p0_transpose_item(w_out, D, D, Wout_t, nullptr, scr, r, lane); continue; } r -= I_OUT;
            if (r < I_UP) { p0_transpose_item(w_up, D, FF, Wup_t, g_mlp, scr, r, lane); continue; } r -= I_UP;
            p0_transpose_item(w_dn, FF, D, Wdn_t, nullptr, scr, r, lane);
        }
        for (int m = gw * 4; m < M; m += NGW * 4) rms_rows_to_bf16<4>(x + (size_t)m * D, g_attn, XN + (size_t)m * D, lane);
        for (int it = gw * 64 + lane; it < M * 8; it += NGW * 64) {
            const int m = it >> 3, i = it & 7;
            const float inv_freq = (i == 0) ? 1.0f : (i == 1) ? 0.193922743f : (i == 2) ? 0.0376060307f : (i == 3) ? 0.00729266461f : (i == 4) ? 0.00141421356f : (i == 5) ? 0.000274248188f : (i == 6) ? 5.3182961e-05f : 1.03133862e-05f;
            const float ang = (float)positions[m] * inv_freq;
            double rev = (double)ang * 0.15915494309189535; rev -= __builtin_floor(rev);
            const float rf = (float)rev;
            rope[(size_t)m * 16 + i] = __builtin_amdgcn_cosf(rf); rope[(size_t)m * 16 + 8 + i] = __builtin_amdgcn_sinf(rf);
        }
        }
        if (BOTH(0)) GRID_BAR(0);
    }
    if (IN(1)) {
        pg8::Gemm g{XN, Win_t, M, NPROJ, D}; pg8::StaticOrder S; S.init(M, NPROJ, G, (int)blockIdx.x);
        pg8::EpiQKV E{PROJ, NPROJ, gqa, gka, gqb, gkb, rope};
        STAGGER(1);
        REP(1) pg8::gemm_phase<pg8::EpiQKV, pg8::StaticOrder, true>(L + RING_OFF, L + EPI_OFF, g, S, E);
        if (BOTH(1)) GRID_BAR(1);
    }
    if (IN(2)) {
#if defined(NAIVE_ATTN)
        attn_naive(PROJ, MIXB, gqa, gka, gqb, gkb, sinks, vcu * (NWAVES * 64) + tid, G * NWAVES * 64);
#else
#if defined(ATTN_V1)
        REP(2) attn_phase(PROJ, MIXB, gqa, gka, gqb, gkb, sinks, L + RING_OFF, vcu, G, wave, lane);
#else
        REP(2) attn_phase2(PROJ, MIXB, sinks, L + RING_OFF, vcu, G, wave, lane, rep_ == 0 ? 0 : PROBE_MODE);
#endif
#endif
        if (BOTH(2)) GRID_BAR(2);
    }
    if (IN(3)) {
        pg8::Gemm g{MIXB, Wout_t, M, D, D}; pg8::StaticOrder S; S.init(M, D, G, (int)blockIdx.x);
        pg8::EpiOut E{x, XN, ssp, D};
        STAGGER(3);
        REP(3) pg8::gemm_phase<pg8::EpiOut, pg8::StaticOrder, true>(L + RING_OFF, L + EPI_OFF, g, S, E);
        if (BOTH(3)) GRID_BAR(3);
    }
    if (IN(4)) {
        pg8::Gemm g{XN, Wup_t, M, FF, D}; pg8::StaticOrder S; S.init(M, FF, G, (int)blockIdx.x);
        pg8::EpiUp E{ssp, HID, FF, 1.0f / D, RMS_EPS};
        STAGGER(4);
        REP(4) pg8::gemm_phase<pg8::EpiUp, pg8::StaticOrder, true>(L + RING_OFF, L + EPI_OFF, g, S, E);
        if (BOTH(4)) GRID_BAR(4);
    }
    if (IN(5)) {
        pg8::Gemm g{HID, Wdn_t, M, D, FF}; pg8::StaticOrder S; S.init(M, D, G, (int)blockIdx.x);
        pg8::EpiDown E{XN, out, D};
        STAGGER(5);
        pg8::gemm_phase<pg8::EpiDown, pg8::StaticOrder, true>(L + RING_OFF, L + EPI_OFF, g, S, E);
    }
#undef IN
#undef BOTH
}

extern "C" void kernel_launch(void* const* d_in, const int* in_sizes, int n_in, void* d_out, int out_size, void* d_ws, size_t ws_size, hipStream_t stream) {
    static int grid = 0;
    if (grid == 0) {
        if (n_in != 13 || in_sizes[0] != M * D || out_size != M * D || ws_size < WS_END) { fprintf(stderr, "kernel_launch: shape/workspace mismatch (n_in %d in0 %d out %d ws %zu); nothing launched\n", n_in, n_in > 0 ? in_sizes[0] : -1, out_size, ws_size); grid = -1; return; }
        int dev = 0, cus = 0, per_cu = 0;
        if (hipGetDevice(&dev) != hipSuccess || hipDeviceGetAttribute(&cus, hipDeviceAttributeMultiprocessorCount, dev) != hipSuccess) { fprintf(stderr, "kernel_launch: device query failed\n"); grid = -1; return; }
        if (hipFuncSetAttribute((const void*)hymba_fwd, hipFuncAttributeMaxDynamicSharedMemorySize, LDS_BYTES) != hipSuccess) { fprintf(stderr, "kernel_launch: hipFuncSetAttribute failed\n"); grid = -1; return; }
        if (hipOccupancyMaxActiveBlocksPerMultiprocessor(&per_cu, (const void*)hymba_fwd, NWAVES * 64, LDS_BYTES) != hipSuccess || per_cu < 1)
            fprintf(stderr, "kernel_launch: note: occupancy query reports %d workgroups per CU\n", per_cu);
        (void)hipGetLastError();
        grid = cus;
    }
    if (grid < 0) return;
    if (hipMemsetAsync((char*)d_ws + WS_CTL, 0, CTL_ZERO_BYTES, stream) != hipSuccess) { fprintf(stderr, "kernel_launch: hipMemsetAsync failed\n"); return; }
    Args a{};
    for (int i = 0; i < 13; ++i) a.in[i] = (const float*)d_in[i];
    a.out = (float*)d_out; a.ws = (unsigned char*)d_ws;
    static_assert(N_LAUNCHES == 1 || N_LAUNCHES == PER_PHASE, "MK_N_LAUNCHES must be 1 or 6");
    for (int li = 0; li < N_LAUNCHES; ++li) {
        a.ph_lo = (N_LAUNCHES == PER_PHASE) ? li : 0; a.ph_hi = (N_LAUNCHES == PER_PHASE) ? li + 1 : PER_PHASE; a.li = li;
        hipLaunchKernelGGL(hymba_fwd, dim3(grid), dim3(NWAVES * 64), LDS_BYTES, stream, a);
        const hipError_t le = hipPeekAtLastError();
        if (le != hipSuccess) { fprintf(stderr, "kernel_launch: launch %d failed: %s\n", li, hipGetErrorName(le)); break; }
    }
}
```

```cpp
#include <hip/hip_runtime.h>
#include <cstdio>
#include <cstdint>

#ifndef MK_N_LAUNCHES
#define MK_N_LAUNCHES 1
#endif
#ifndef REPEAT_MASK
#define REPEAT_MASK 0
#endif
#ifndef STAGGER_TICKS
#define STAGGER_TICKS 0
#endif
#ifndef STAGGER_PHASES
#define STAGGER_PHASES 0
#endif
#ifndef PROBE_NULL_EPI
#define PROBE_NULL_EPI 0
#endif
#ifndef PROBE_MODE
#define PROBE_MODE 0
#endif
#define REP(k) for (int rep_ = 0; rep_ < 1 + ((REPEAT_MASK >> (k)) & 1); ++rep_)

namespace pg8 {
#define PG8_LAS __attribute__((address_space(3)))
typedef unsigned short bf16_t;
typedef short bf16x8 __attribute__((ext_vector_type(8)));
typedef float f32x4 __attribute__((ext_vector_type(4)));
typedef unsigned u32x4 __attribute__((ext_vector_type(4)));
constexpr int BM = 256, BK = 64, HALF = 128, HTB = HALF * BK * 2  , STAGE_BYTES = 8 * HTB, NXCD = 8, WGM = 8;

__host__ __device__ __forceinline__ int lds_byte(int r, int c) { const int st = (r >> 4) * 2 + (c >> 5), rr = r & 15, cc = c & 31, ob = rr * 64 + cc * 2; return st * 1024 + (ob ^ (((ob >> 9) & 1) << 5)); }
__host__ __device__ __forceinline__ void stage_rc(int b, int& R, int& C) { const int st = b / 1024, sb = b % 1024, swz = sb ^ (((sb >> 9) & 1) << 5); R = (st >> 1) * 16 + swz / 64; C = (st & 1) * 32 + (swz % 64) / 2; }
__host__ __device__ __forceinline__ int perm32(int rho) { const int n = rho >> 4, i = rho & 15; return 8 * (i >> 2) + 4 * n + (i & 3); }

struct Unit { int pm, pn; };
struct Gemm { const bf16_t* A; const bf16_t* Bt; int M, N, K; };

struct StaticOrder {
    int nM, nN, nwg, G, c;
    __host__ __device__ void init(int M, int N, int G_, int c_) { nM = M / BM; nN = N / BM; nwg = nM * nN; G = G_; c = c_; }
    __host__ __device__ bool next(int i, Unit& u) const {
        const long L = (long)i * G + c; if (L >= nwg) return false;
        int wgid = (int)L; { const int q = nwg / NXCD, r = nwg % NXCD, xcd = wgid % NXCD, off = wgid / NXCD; wgid = (xcd < r ? xcd * (q + 1) : r * (q + 1) + (xcd - r) * q) + off; }
        const int nig = WGM * nN, gid = wgid / nig, fm = gid * WGM, gsz = (nM - fm) < WGM ? (nM - fm) : WGM;
        u.pm = fm + ((wgid % nig) % gsz); u.pn = (wgid % nig) / gsz; return true;
    }
};

__device__ __forceinline__ unsigned cvt_pk_bf16(float lo, float hi) { unsigned r; asm volatile("v_cvt_pk_bf16_f32 %0, %1, %2" : "=v"(r) : "v"(lo), "v"(hi)); return r; }

constexpr int EPI_PITCH = 144, EPI_WBYTES = 16 * EPI_PITCH;
__device__ __forceinline__ void epi_store_rows(PG8_LAS unsigned char* sb, int lane, int fr, u32x4 d0, u32x4 d1, int off0, int off1, char* g, size_t pitch) {
    *(PG8_LAS u32x4*)(sb + fr * EPI_PITCH + off0) = d0; *(PG8_LAS u32x4*)(sb + fr * EPI_PITCH + off1) = d1;
#pragma unroll
    for (int k = 0; k < 2; ++k) { const int row = 8 * k + (lane >> 3); const u32x4 v = *(const PG8_LAS u32x4*)(sb + row * EPI_PITCH + (lane & 7) * 16);
        *(u32x4*)(g + (size_t)row * pitch + (lane & 7) * 16) = v; }
}
constexpr float QK_EPS = 1e-6f;
constexpr float C2 = 0.125f * 1.4426950408889634f;

struct EpiQKV {
    bf16_t* O; int ldc; const float* gqa; const float* gka; const float* gqb; const float* gkb; const float* rope;
    __device__ __forceinline__ void operator()(const f32x4 (&acc)[2][2][4][2], const Unit& u, int wr, int wc, int fr, int fq, PG8_LAS unsigned char* sb, int lane) const {
        const int pn = u.pn; int mode = 0; const float* g = gqa;
        if (pn < 2) { mode = 1; g = gqa; } else if (pn == 2) { if (wc < 2) { mode = 2; g = gka; } } else if (pn < 5) { mode = 1; g = gqb; } else if (pn < 7) { mode = 2; g = gkb; }
        const int row0 = u.pm * BM + wr * 64 + fr, rowg = u.pm * BM + wr * 64, colw = pn * BM + wc * 64;
        if (mode == 0) {
#pragma unroll
            for (int ai = 0; ai < 2; ++ai)
#pragma unroll
                for (int m = 0; m < 4; ++m) { u32x4 w[2];
#pragma unroll
                    for (int bj = 0; bj < 2; ++bj) { const f32x4 v0 = acc[ai][bj][m][0], v1 = acc[ai][bj][m][1];
                        w[bj].x = cvt_pk_bf16(v0[0], v0[1]); w[bj].y = cvt_pk_bf16(v0[2], v0[3]); w[bj].z = cvt_pk_bf16(v1[0], v1[1]); w[bj].w = cvt_pk_bf16(v1[2], v1[3]); }
                    epi_store_rows(sb, lane, fr, w[0], w[1], fq * 16, 64 + fq * 16, (char*)(O + (size_t)(rowg + ai * HALF + m * 16) * ldc + colw), (size_t)ldc * 2); }
            return;
        }
        f32x4 gv[2][2];
#pragma unroll
        for (int bj = 0; bj < 2; ++bj)
#pragma unroll
            for (int n = 0; n < 2; ++n) gv[bj][n] = *(const f32x4*)(g + 32 * bj + 8 * fq + 4 * n);
        const float sc = (mode == 1) ? C2 : 1.0f;
        const float sgn = (fq == 0) ? -1.0f : 1.0f;
        f32x4 rn[4];
#define EPIQ_LOAD(g) do { const float* rp_ = rope + (size_t)(row0 + ((g) >> 2) * HALF + ((g) & 3) * 16) * 16; _Pragma("unroll") for (int j = 0; j < 4; ++j) rn[j] = *(const f32x4*)(rp_ + 4 * j); } while (0)
        EPIQ_LOAD(0);
#pragma unroll
        for (int g8 = 0; g8 < 8; ++g8) { const int ai = g8 >> 2, m = g8 & 3; {
                const f32x4 c0 = rn[0], c1 = rn[1], s0 = rn[2], s1 = rn[3];
                if (g8 + 1 < 8) EPIQ_LOAD(g8 + 1);
                float ss = 0.f;
#pragma unroll
                for (int bj = 0; bj < 2; ++bj)
#pragma unroll
                    for (int n = 0; n < 2; ++n) { const f32x4 x = acc[ai][bj][m][n]; ss += (x[0] * x[0] + x[1] * x[1]) + (x[2] * x[2] + x[3] * x[3]); }
                ss += __shfl_xor(ss, 16); ss += __shfl_xor(ss, 32);
                const float rs = __builtin_amdgcn_rsqf(ss * (1.0f / 64.0f) + QK_EPS);
                f32x4 y[2][2];
#pragma unroll
                for (int bj = 0; bj < 2; ++bj)
#pragma unroll
                    for (int n = 0; n < 2; ++n) y[bj][n] = acc[ai][bj][m][n] * rs * gv[bj][n];
                f32x4 p0, p1;
#pragma unroll
                for (int e = 0; e < 4; ++e) { p0[e] = __shfl_xor(y[0][0][e], 16); p1[e] = __shfl_xor(y[0][1][e], 16); }
                if (fq < 2) { y[0][0] = y[0][0] * c0 + p0 * s0 * sgn; y[0][1] = y[0][1] * c1 + p1 * s1 * sgn; }
                u32x4 w[2];
#pragma unroll
                for (int bj = 0; bj < 2; ++bj) { const f32x4 v0 = y[bj][0] * sc, v1 = y[bj][1] * sc;
                    w[bj].x = cvt_pk_bf16(v0[0], v0[1]); w[bj].y = cvt_pk_bf16(v0[2], v0[3]); w[bj].z = cvt_pk_bf16(v1[0], v1[1]); w[bj].w = cvt_pk_bf16(v1[2], v1[3]); }
                epi_store_rows(sb, lane, fr, w[0], w[1], fq * 16, 64 + fq * 16, (char*)(O + (size_t)(rowg + ai * HALF + m * 16) * ldc + colw), (size_t)ldc * 2);
            } }
#undef EPIQ_LOAD
    }
};

struct EpiOut {
    const float* x; bf16_t* hb; float* ssp; int ldc;
    __device__ __forceinline__ void operator()(const f32x4 (&acc)[2][2][4][2], const Unit& u, int wr, int wc, int fr, int fq, PG8_LAS unsigned char* sb, int lane) const {
        const int row0 = u.pm * BM + wr * 64 + fr, col0 = u.pn * BM + wc * 64 + 8 * fq;
        f32x4 xn[4];
#define EPIO_LOAD(g) do { const size_t off_ = (size_t)(row0 + ((g) >> 2) * HALF + ((g) & 3) * 16) * ldc + col0; xn[0] = *(const f32x4*)(x + off_); xn[1] = *(const f32x4*)(x + off_ + 4); xn[2] = *(const f32x4*)(x + off_ + 32); xn[3] = *(const f32x4*)(x + off_ + 36); } while (0)
        EPIO_LOAD(0);
#pragma unroll
        for (int g = 0; g < 8; ++g) {
            const int ai = g >> 2, m = g & 3, row = row0 + ai * HALF + m * 16;
            const f32x4 xc[4] = {xn[0], xn[1], xn[2], xn[3]};
            if (g + 1 < 8) EPIO_LOAD(g + 1);
            float ss = 0.f; u32x4 w[2];
#pragma unroll
            for (int bj = 0; bj < 2; ++bj) {
                const f32x4 v0 = acc[ai][bj][m][0] + xc[2 * bj], v1 = acc[ai][bj][m][1] + xc[2 * bj + 1];
                w[bj].x = cvt_pk_bf16(v0[0], v0[1]); w[bj].y = cvt_pk_bf16(v0[2], v0[3]); w[bj].z = cvt_pk_bf16(v1[0], v1[1]); w[bj].w = cvt_pk_bf16(v1[2], v1[3]);
                ss += (v0[0] * v0[0] + v0[1] * v0[1]) + (v0[2] * v0[2] + v0[3] * v0[3]) + (v1[0] * v1[0] + v1[1] * v1[1]) + (v1[2] * v1[2] + v1[3] * v1[3]);
            }
            epi_store_rows(sb, lane, fr, w[0], w[1], fq * 16, 64 + fq * 16, (char*)(hb + (size_t)(row - fr) * ldc + u.pn * BM + wc * 64), (size_t)ldc * 2);
            ss += __shfl_xor(ss, 16); ss += __shfl_xor(ss, 32);
            if (fq == 0) ssp[(size_t)row * 16 + u.pn * 4 + wc] = ss;
        }
#undef EPIO_LOAD
    }
};

struct EpiUp {
    bf16_t* hid; int ldc;
    __device__ __forceinline__ void operator()(const f32x4 (&acc)[2][2][4][2], const Unit& u, int wr, int wc, int fr, int fq, PG8_LAS unsigned char* sb, int lane) const {
        const int rowg = u.pm * BM + wr * 64, colw = u.pn * BM + wc * 64;
#pragma unroll
        for (int ai = 0; ai < 2; ++ai)
#pragma unroll
            for (int m = 0; m < 4; ++m) {
                u32x4 w[2];
#pragma unroll
                for (int bj = 0; bj < 2; ++bj) { f32x4 v0 = acc[ai][bj][m][0], v1 = acc[ai][bj][m][1];
#pragma unroll
                    for (int e = 0; e < 4; ++e) { const float r0 = __builtin_fmaxf(v0[e], 0.f), r1 = __builtin_fmaxf(v1[e], 0.f); v0[e] = r0 * r0; v1[e] = r1 * r1; }
                    w[bj].x = cvt_pk_bf16(v0[0], v0[1]); w[bj].y = cvt_pk_bf16(v0[2], v0[3]); w[bj].z = cvt_pk_bf16(v1[0], v1[1]); w[bj].w = cvt_pk_bf16(v1[2], v1[3]); }
                epi_store_rows(sb, lane, fr, w[0], w[1], fq * 16, 64 + fq * 16, (char*)(hid + (size_t)(rowg + ai * HALF + m * 16) * ldc + colw), (size_t)ldc * 2);
            }
    }
};

struct EpiNull {
    __device__ __forceinline__ void operator()(const f32x4 (&acc)[2][2][4][2], const Unit& u, int wr, int wc, int fr, int fq, PG8_LAS unsigned char* sb, int lane) const {
#pragma unroll
        for (int ai = 0; ai < 2; ++ai)
#pragma unroll
            for (int bj = 0; bj < 2; ++bj)
#pragma unroll
                for (int m = 0; m < 4; ++m)
#pragma unroll
                    for (int n = 0; n < 2; ++n) asm volatile("" :: "v"(acc[ai][bj][m][n]));
    }
};
struct EpiDown {
    const bf16_t* hb; const float* ssp; float* out; int ldc; float inv_n, eps;
    __device__ __forceinline__ void operator()(const f32x4 (&acc)[2][2][4][2], const Unit& u, int wr, int wc, int fr, int fq, PG8_LAS unsigned char* sb, int lane) const {
        const int row0 = u.pm * BM + wr * 64 + fr, col0 = u.pn * BM + wc * 64 + 8 * fq;
        u32x4 hn[2]; f32x4 sn[4];
#define EPID_LOAD(g) do { const int row_ = row0 + ((g) >> 2) * HALF + ((g) & 3) * 16; hn[0] = *(const u32x4*)(hb + (size_t)row_ * ldc + col0); hn[1] = *(const u32x4*)(hb + (size_t)row_ * ldc + col0 + 32); \
        _Pragma("unroll") for (int j = 0; j < 4; ++j) sn[j] = *(const f32x4*)(ssp + (size_t)row_ * 16 + 4 * j); } while (0)
        EPID_LOAD(0);
#pragma unroll
        for (int g = 0; g < 8; ++g) {
            const int ai = g >> 2, m = g & 3;
            u32x4 hw[2] = {hn[0], hn[1]}; const f32x4 t = (sn[0] + sn[1]) + (sn[2] + sn[3]);
            if (g + 1 < 8) EPID_LOAD(g + 1);
            const float ss = (t[0] + t[1]) + (t[2] + t[3]);
            const float rs2 = __builtin_amdgcn_rcpf(ss * inv_n + eps);
#pragma unroll
            for (int bj = 0; bj < 2; ++bj) {
                const f32x4 h0 = {__uint_as_float(hw[bj].x << 16), __uint_as_float(hw[bj].x & 0xffff0000u), __uint_as_float(hw[bj].y << 16), __uint_as_float(hw[bj].y & 0xffff0000u)};
                const f32x4 h1 = {__uint_as_float(hw[bj].z << 16), __uint_as_float(hw[bj].z & 0xffff0000u), __uint_as_float(hw[bj].w << 16), __uint_as_float(hw[bj].w & 0xffff0000u)};
                const f32x4 o0 = h0 + acc[ai][bj][m][0] * rs2, o1 = h1 + acc[ai][bj][m][1] * rs2;
                epi_store_rows(sb, lane, fr, __builtin_bit_cast(u32x4, o0), __builtin_bit_cast(u32x4, o1), fq * 32, fq * 32 + 16, (char*)(out + (size_t)(row0 - fr + ai * HALF + m * 16) * ldc + u.pn * BM + wc * 64 + bj * 32), (size_t)ldc * 4);
            }
        }
#undef EPID_LOAD
    }
};

template <class Epi, class Sched, bool ALIGN_EPI>
__device__ __forceinline__ void gemm_phase(PG8_LAS unsigned char* lds, PG8_LAS unsigned char* epi_lds, const Gemm g, const Sched& S, const Epi& E) {
    const int tid = threadIdx.x, wid = __builtin_amdgcn_readfirstlane(tid >> 6), lane = tid & 63, wr = wid >> 2, wc = wid & 3, fr = lane & 15, fq = lane >> 4;
    const int K = g.K, nt = K / BK;
    unsigned voffA[2], voffB[2];
#pragma unroll
    for (int i = 0; i < 2; ++i) { int R, C; stage_rc(tid * 16 + i * 8192, R, C); const int Rb = (R >> 5) * 64 + perm32(R & 31);
        voffA[i] = (unsigned)(R * K + C) * 2u; voffB[i] = (unsigned)(Rb * K + C) * 2u; }
    const size_t kstep = (size_t)(BK * 2);
    const size_t hstepA = (size_t)HALF * K * 2;
    const size_t hstepB = (size_t)32 * K * 2;
    const size_t tstep = (size_t)BM * K * 2;
    const unsigned ldsw = (unsigned)wid * 1024u;
    const int aoff = lds_byte(wr * 64 + fr, fq * 8), boff = lds_byte(wc * 32 + fr, fq * 8);
#define PG8_SA(b, h) (((b) * 2 + (h)) * HTB)
#define PG8_SB(b, h) ((4 + (b) * 2 + (h)) * HTB)
#define PG8_STAGE(bufoff, gbase, voff) do { _Pragma("unroll") for (int _i = 0; _i < 2; ++_i) \
        __builtin_amdgcn_global_load_lds((const unsigned*)((const char*)(gbase) + (voff)[_i]), (PG8_LAS unsigned*)(lds + (bufoff) + ldsw + _i * 8192), 16, 0, 0); } while (0)
#define PG8_LDA(dst, b, h) do { _Pragma("unroll") for (int m = 0; m < 4; ++m) _Pragma("unroll") for (int k = 0; k < 2; ++k) dst[m][k] = *(const PG8_LAS bf16x8*)(lds + PG8_SA(b, h) + aoff + m * 2048 + k * 1024); } while (0)
#define PG8_LDB(dst, b, h) do { _Pragma("unroll") for (int n = 0; n < 2; ++n) _Pragma("unroll") for (int k = 0; k < 2; ++k) dst[n][k] = *(const PG8_LAS bf16x8*)(lds + PG8_SB(b, h) + boff + n * 2048 + k * 1024); } while (0)
#define PG8_MMA(ai, bj, At, Bt) do { __builtin_amdgcn_s_setprio(1); _Pragma("unroll") for (int m = 0; m < 4; ++m) _Pragma("unroll") for (int n = 0; n < 2; ++n) _Pragma("unroll") for (int k = 0; k < 2; ++k) \
        acc[ai][bj][m][n] = __builtin_amdgcn_mfma_f32_16x16x32_bf16(Bt[n][k], At[m][k], acc[ai][bj][m][n], 0, 0, 0); __builtin_amdgcn_s_setprio(0); } while (0)
#define PG8_WAIT_V(n) asm volatile("s_waitcnt vmcnt(" #n ")" ::: "memory")
#define PG8_WAIT_L(n) asm volatile("s_waitcnt lgkmcnt(" #n ")" ::: "memory")
#define PG8_BAR __builtin_amdgcn_s_barrier()
#define PG8_SCHED __builtin_amdgcn_sched_barrier(0)
    Unit cur, nxt; int ui = 0;
    if (!S.next(0, cur)) return;
    f32x4 acc[2][2][4][2];
#pragma unroll
    for (int a = 0; a < 2; ++a)
#pragma unroll
        for (int b = 0; b < 2; ++b)
#pragma unroll
            for (int m = 0; m < 4; ++m)
#pragma unroll
                for (int n = 0; n < 2; ++n) acc[a][b][m][n] = (f32x4){0.f, 0.f, 0.f, 0.f};
    bf16x8 At[4][2], B0[2][2], B1[2][2];
    const char* cA = (const char*)g.A + (size_t)cur.pm * tstep; const char* cB = (const char*)g.Bt + (size_t)cur.pn * tstep;
    PG8_STAGE(PG8_SB(0, 0), cB, voffB); PG8_STAGE(PG8_SB(0, 1), cB + hstepB, voffB); PG8_STAGE(PG8_SA(0, 0), cA, voffA); PG8_STAGE(PG8_SA(0, 1), cA + hstepA, voffA);
    if (wr == 1) PG8_BAR;
    PG8_WAIT_V(2); PG8_BAR;
    PG8_STAGE(PG8_SB(1, 0), cB + kstep, voffB); PG8_STAGE(PG8_SA(1, 0), cA + kstep, voffA); PG8_STAGE(PG8_SB(1, 1), cB + hstepB + kstep, voffB);
    PG8_WAIT_V(6); PG8_BAR;
    for (;;) {
        const bool has_next = S.next(ui + 1, nxt);
        const char* nA = has_next ? (const char*)g.A + (size_t)nxt.pm * tstep : cA; const char* nB = has_next ? (const char*)g.Bt + (size_t)nxt.pn * tstep : cB;
        for (int t = 0; t < nt; t += 2) {
            const bool last = (t == nt - 2);
            const char* a1 = cA + (size_t)(t + 1) * kstep;
            const char* a2 = last ? nA : cA + (size_t)(t + 2) * kstep; const char* b2 = last ? nB : cB + (size_t)(t + 2) * kstep;
            const char* a3 = a2 + kstep; const char* b3 = b2 + kstep;
            PG8_LDB(B0, 0, 0); PG8_LDB(B1, 0, 1); PG8_SCHED; PG8_LDA(At, 0, 0); PG8_STAGE(PG8_SA(1, 1), a1 + hstepA, voffA);
            PG8_WAIT_V(8); PG8_WAIT_L(0); PG8_BAR; PG8_MMA(0, 0, At, B0); PG8_MMA(0, 1, At, B1); PG8_BAR; PG8_SCHED;
            PG8_LDA(At, 0, 1); PG8_STAGE(PG8_SB(0, 0), b2, voffB); PG8_STAGE(PG8_SB(0, 1), b2 + hstepB, voffB); PG8_STAGE(PG8_SA(0, 0), a2, voffA);
            PG8_WAIT_V(8); PG8_WAIT_L(0); PG8_BAR; PG8_MMA(1, 0, At, B0); PG8_MMA(1, 1, At, B1); PG8_BAR; PG8_SCHED;
            PG8_LDB(B0, 1, 0); PG8_LDB(B1, 1, 1); PG8_SCHED; PG8_LDA(At, 1, 0); PG8_STAGE(PG8_SA(0, 1), a2 + hstepA, voffA);
            PG8_WAIT_V(8); PG8_WAIT_L(0); PG8_BAR; PG8_MMA(0, 0, At, B0); PG8_MMA(0, 1, At, B1); PG8_BAR; PG8_SCHED;
            PG8_LDA(At, 1, 1); PG8_STAGE(PG8_SB(1, 0), b3, voffB); PG8_STAGE(PG8_SB(1, 1), b3 + hstepB, voffB); PG8_STAGE(PG8_SA(1, 0), a3, voffA);
            PG8_WAIT_V(8); PG8_WAIT_L(0); PG8_BAR; PG8_MMA(1, 0, At, B0); PG8_MMA(1, 1, At, B1); PG8_BAR; PG8_SCHED;
        }
        if constexpr (ALIGN_EPI) { if (wr == 0) PG8_BAR; }
        E(acc, cur, wr, wc, fr, fq, epi_lds + wid * EPI_WBYTES, lane);
        if (!has_next) break;
#pragma unroll
        for (int a = 0; a < 2; ++a)
#pragma unroll
            for (int b = 0; b < 2; ++b)
#pragma unroll
                for (int m = 0; m < 4; ++m)
#pragma unroll
                    for (int n = 0; n < 2; ++n) acc[a][b][m][n] = (f32x4){0.f, 0.f, 0.f, 0.f};
        cur = nxt; cA = nA; cB = nB; ++ui;
        if constexpr (ALIGN_EPI) { if (wr == 1) PG8_BAR; }
    }
    PG8_WAIT_V(0);
    if constexpr (!ALIGN_EPI) { if (wr == 0) PG8_BAR; }
    PG8_BAR;
#undef PG8_SA
#undef PG8_SB
#undef PG8_STAGE
#undef PG8_LDA
#undef PG8_LDB
#undef PG8_MMA
#undef PG8_WAIT_V
#undef PG8_WAIT_L
#undef PG8_BAR
#undef PG8_SCHED
}
}

constexpr int NWAVES = 8;
constexpr int BATCH = 32, SEQ = 2048, D = 1024, FF = 4096, HD = 64;
constexpr int M = BATCH * SEQ;
constexpr int NPROJ = 2304;
constexpr int COL_QA = 0, COL_KA = 512, COL_VA = 640, COL_QB = 768, COL_KB = 1280, COL_VB = 1792;
constexpr float RMS_EPS = 1e-6f;
constexpr int N_LAUNCHES = MK_N_LAUNCHES, PER_PHASE = 6;
constexpr int N_BAR_REGIONS = (MK_N_LAUNCHES == PER_PHASE) ? 1 : MK_N_LAUNCHES;

constexpr size_t MiB = 1u << 20;
constexpr size_t WS_CTL = 0, CTL_ZERO_BYTES = 1 * MiB;
constexpr size_t WS_WIN = 2 * MiB, WS_WOUT = 8 * MiB, WS_WUP = 10 * MiB, WS_WDN = 18 * MiB;
constexpr size_t WS_ROPE = 26 * MiB;
constexpr size_t WS_SS = 30 * MiB;
constexpr size_t WS_XN = 64 * MiB;
constexpr size_t WS_PROJ = 192 * MiB;
constexpr size_t WS_MIX = 480 * MiB;
constexpr size_t WS_HID = 192 * MiB;
constexpr size_t WS_END = 704 * MiB;
static_assert(WS_WIN + (size_t)NPROJ * D * 2 <= WS_WOUT && WS_WDN + (size_t)D * FF * 2 <= WS_ROPE && WS_SS + (size_t)M * 64 <= WS_XN, "d_ws map");
static_assert(WS_XN + (size_t)M * D * 2 <= WS_PROJ && WS_PROJ + (size_t)M * NPROJ * 2 <= WS_MIX && WS_MIX + (size_t)M * D * 2 <= WS_END && WS_HID + (size_t)M * FF * 2 <= WS_END, "d_ws map");
constexpr int CW_TMO = 0, CW_CODE = 1;
constexpr int CW_BAR = 4096;

constexpr int RING_OFF = 0, RING_BYTES = 131072;
constexpr int EPI_OFF = RING_BYTES;
constexpr int LDSCTL_OFF = 150528, MISC_OFF = LDSCTL_OFF + 320;
constexpr int LDS_BYTES = 151552;
static_assert(EPI_OFF + 8 * pg8::EPI_WBYTES <= LDSCTL_OFF && MISC_OFF + 128 <= LDS_BYTES, "LDS map");

#define GAS __attribute__((address_space(1)))
#define LAS __attribute__((address_space(3)))
typedef unsigned short bf16;
typedef unsigned v4u __attribute__((ext_vector_type(4)));
typedef float f32x4 __attribute__((ext_vector_type(4)));
typedef GAS unsigned gu32;
#define RLX_AGENT __ATOMIC_RELAXED, __HIP_MEMORY_SCOPE_AGENT
#define LDS_WAIT() asm volatile("s_waitcnt lgkmcnt(0)" ::: "memory")
#define VM_WAIT() asm volatile("s_waitcnt vmcnt(0)" ::: "memory")
__device__ __forceinline__ unsigned f2bf(float f) { unsigned u = __builtin_bit_cast(unsigned, f); return (u + 0x7fffu + ((u >> 16) & 1u)) >> 16; }
__device__ __forceinline__ unsigned pk2(float lo, float hi) { return f2bf(lo) | (f2bf(hi) << 16); }
__device__ __forceinline__ float bf_lo(unsigned u) { return __uint_as_float(u << 16); }
__device__ __forceinline__ float bf_hi(unsigned u) { return __uint_as_float(u & 0xffff0000u); }

#define XB_TMO      128
#define XB_XCNT(j)  (256  + 64 * (j))
#define XB_XSUB(j)  (1280 + 64 * (j))
#define XB_XGEN(j)  (2304 + 64 * (j))
#define XB_TOP      3328
#define XB_TOPGEN   3392
#define XCD_BAR_WORDS 3456
#define XB_SPIN_CAP (1u << 18)

__device__ __forceinline__ unsigned xb_ld(unsigned* p)              { return __hip_atomic_load(p, __ATOMIC_RELAXED, __HIP_MEMORY_SCOPE_AGENT); }
__device__ __forceinline__ unsigned xb_add(unsigned* p, unsigned v) { return __hip_atomic_fetch_add(p, v, __ATOMIC_RELAXED, __HIP_MEMORY_SCOPE_AGENT); }
__device__ __forceinline__ unsigned xb_xcc_id() { return (unsigned)__builtin_amdgcn_s_getreg((3 << 11) | 20) & 0xFu; }
#define XB_SPIN(cond, bar) do { unsigned _sp = 0; while (cond) { __builtin_amdgcn_s_sleep(1); \
    if ((++_sp & 255u) == 0u) { if (xb_ld(&(bar)[XB_TMO])) break; if (_sp > XB_SPIN_CAP) { atomicAdd(&(bar)[XB_TMO], 1u); break; } } } } while (0)

struct XcdBarrier { unsigned* bar; unsigned x; volatile LAS unsigned* st; };

__device__ __forceinline__ XcdBarrier xcd_barrier_post(unsigned* bar, volatile LAS unsigned* st) {
    XcdBarrier b; b.bar = bar; b.x = xb_xcc_id(); b.st = st;
    if (threadIdx.x == 0) (void)xb_add(&bar[XB_XCNT(b.x)], 1u);
    return b;
}
__device__ __forceinline__ void xcd_barrier_complete(unsigned* bar, unsigned x, unsigned& nloc, unsigned& nx) {
    const unsigned G = gridDim.x * gridDim.y * gridDim.z;
    unsigned sum, cnt, mine, sp = 0u;
    for (;;) {
        sum = 0u; cnt = 0u; mine = 0u;
#pragma unroll
        for (unsigned j = 0; j < 16; ++j) { const unsigned c = xb_ld(&bar[XB_XCNT(j)]); sum += c; cnt += (c > 0u) ? 1u : 0u; mine = (j == x) ? c : mine; }
        if (sum == G) break;
        __builtin_amdgcn_s_sleep(1);
        if ((++sp & 255u) == 0u) { if (xb_ld(&bar[XB_TMO])) break; if (sp > XB_SPIN_CAP) { atomicAdd(&bar[XB_TMO], 1u); break; } }
    }
    nloc = mine > 0u ? mine : 1u; nx = cnt > 0u ? cnt : 1u;
}
__device__ __forceinline__ void xcd_barrier(const XcdBarrier& b) {
    asm volatile("s_waitcnt vmcnt(0)" ::: "memory");
    __syncthreads();
    if (threadIdx.x == 0) {
        unsigned* bar = b.bar;
        __builtin_amdgcn_s_waitcnt(0);
        unsigned nloc = b.st[0], nx = b.st[1];
        if (nloc == 0u) { xcd_barrier_complete(bar, b.x, nloc, nx); b.st[0] = nloc; b.st[1] = nx; }
        const unsigned old = xb_add(&bar[XB_XSUB(b.x)], 1u);
        const unsigned gen = old / nloc;
        if (old + 1u == (gen + 1u) * nloc) {
            __builtin_amdgcn_fence(__ATOMIC_RELEASE, "agent");
            asm volatile("s_waitcnt vmcnt(0)" ::: "memory");
            const unsigned og = xb_add(&bar[XB_TOP], 1u);
            const unsigned tg = og / nx;
            if (og + 1u == (tg + 1u) * nx) xb_add(&bar[XB_TOPGEN], 1u);
            else XB_SPIN(xb_ld(&bar[XB_TOPGEN]) == tg, bar);
            __builtin_amdgcn_fence(__ATOMIC_ACQUIRE, "agent");
            xb_add(&bar[XB_XGEN(b.x)], 1u);
            asm volatile("s_waitcnt vmcnt(0)" ::: "memory");
        } else {
            XB_SPIN(xb_ld(&bar[XB_XGEN(b.x)]) == gen, bar);
            __builtin_amdgcn_fence(__ATOMIC_ACQUIRE, "agent");
            asm volatile("s_waitcnt vmcnt(0)" ::: "memory");
        }
    }
    __syncthreads();
}

__device__ __forceinline__ float wave_sum(float v) {
#pragma unroll
    for (int o = 1; o < 64; o <<= 1) v += __shfl_xor(v, o);
    return v;
}
__device__ __forceinline__ float wave_max(float v) {
#pragma unroll
    for (int o = 1; o < 64; o <<= 1) v = __builtin_fmaxf(v, __shfl_xor(v, o));
    return v;
}
__device__ __forceinline__ void p0_transpose_item(const float* W, int K, int N, bf16* WT, const float* gk, LAS float* scr, int item, int lane) {
    const int nblk = N / 32, kb = item / nblk, nb = item % nblk, k0 = 64 * kb, n0 = 32 * nb;
    float wv[32];
#pragma unroll
    for (int i = 0; i < 32; ++i) wv[i] = W[(size_t)(k0 + 2 * i + (lane >> 5)) * N + n0 + (lane & 31)];
    if (gk) {
#pragma unroll
        for (int i = 0; i < 32; ++i) wv[i] *= gk[k0 + 2 * i + (lane >> 5)]; }
#pragma unroll
    for (int i = 0; i < 32; ++i) scr[(2 * i + (lane >> 5)) * 33 + (lane & 31)] = wv[i];
    LDS_WAIT(); asm volatile("" ::: "memory");
    const int c = lane & 7;
#pragma unroll
    for (int j = 0; j < 4; ++j) { const int n = (lane >> 3) + 8 * j; const LAS float* s = scr + (8 * c) * 33 + n;
        v4u o; o.x = pk2(s[0 * 33], s[1 * 33]); o.y = pk2(s[2 * 33], s[3 * 33]); o.z = pk2(s[4 * 33], s[5 * 33]); o.w = pk2(s[6 * 33], s[7 * 33]);
        *(GAS v4u*)(WT + (size_t)(n0 + n) * K + k0 + 8 * c) = o; }
    LDS_WAIT(); asm volatile("" ::: "memory");
}
template <int NR>
__device__ __forceinline__ void rms_rows_to_bf16(const float* xrow, const float* gain, bf16* orow, int lane) {
    f32x4 v[NR][4]; float s[NR];
#pragma unroll
    for (int r = 0; r < NR; ++r) { const GAS f32x4* xr = (const GAS f32x4*)(xrow + (size_t)r * D) + lane;
#pragma unroll
        for (int j = 0; j < 4; ++j) v[r][j] = __builtin_nontemporal_load(xr + 64 * j); }
    const GAS f32x4* gr = (const GAS f32x4*)gain + lane;
    f32x4 gg[4];
#pragma unroll
    for (int j = 0; j < 4; ++j) gg[j] = gr[64 * j];
#pragma unroll
    for (int r = 0; r < NR; ++r) { s[r] = 0.f;
#pragma unroll
        for (int j = 0; j < 4; ++j) s[r] += (v[r][j].x * v[r][j].x + v[r][j].y * v[r][j].y) + (v[r][j].z * v[r][j].z + v[r][j].w * v[r][j].w); }
#pragma unroll
    for (int o = 1; o < 64; o <<= 1) {
#pragma unroll
        for (int r = 0; r < NR; ++r) s[r] += __shfl_xor(s[r], o); }
#pragma unroll
    for (int r = 0; r < NR; ++r) { const float rstd = __builtin_amdgcn_rsqf(s[r] * (1.f / D) + RMS_EPS);
        GAS unsigned long long* o8 = (GAS unsigned long long*)(orow + (size_t)r * D) + lane;
#pragma unroll
        for (int j = 0; j < 4; ++j) { const f32x4 y = v[r][j] * rstd * gg[j];
            o8[64 * j] = (unsigned long long)pk2(y.x, y.y) | ((unsigned long long)pk2(y.z, y.w) << 32); } }
}

__device__ __forceinline__ void attn_naive(const bf16* PROJ, bf16* MIX, const float* gqa, const float* gka, const float* gqb, const float* gkb, const float* sinks, int gtid, int nthr) {
    float mqa = 0.f, mka = 0.f, mqb = 0.f, mkb = 0.f;
    for (int d = 0; d < HD; ++d) { mqa = __builtin_fmaxf(mqa, __builtin_fabsf(gqa[d])); mka = __builtin_fmaxf(mka, __builtin_fabsf(gka[d])); mqb = __builtin_fmaxf(mqb, __builtin_fabsf(gqb[d])); mkb = __builtin_fmaxf(mkb, __builtin_fabsf(gkb[d])); }
    const float shiftA = pg8::C2 * 64.f * mqa * mka, shiftB = pg8::C2 * 64.f * mqb * mkb;
    for (long item = gtid; item < (long)M * 16; item += nthr) {
        const int hh = (int)(item / M), m = (int)(item % M), t = m & (SEQ - 1), rowbase = m - t;
        const bool isA = hh < 8; const int h = hh & 7;
        const int qcol = isA ? COL_QA + h * 64 : COL_QB + h * 64, kcol = isA ? COL_KA + (h >> 2) * 64 : COL_KB + h * 64, vcol = isA ? COL_VA + (h >> 2) * 64 : COL_VB + h * 64;
        const float shift = isA ? shiftA : shiftB;
        float q[64], o[64]; float l = 0.f;
        { const v4u* qp = (const v4u*)(PROJ + (size_t)m * NPROJ + qcol);
#pragma unroll
          for (int c = 0; c < 8; ++c) { const v4u u = qp[c]; q[8 * c + 0] = bf_lo(u.x); q[8 * c + 1] = bf_hi(u.x); q[8 * c + 2] = bf_lo(u.y); q[8 * c + 3] = bf_hi(u.y); q[8 * c + 4] = bf_lo(u.z); q[8 * c + 5] = bf_hi(u.z); q[8 * c + 6] = bf_lo(u.w); q[8 * c + 7] = bf_hi(u.w); } }
#pragma unroll
        for (int d = 0; d < 64; ++d) o[d] = 0.f;
#define KEY(srow, wgt) do { const v4u* kp = (const v4u*)(PROJ + (size_t)(rowbase + (srow)) * NPROJ + kcol); float sc = 0.f; \
        _Pragma("unroll") for (int c = 0; c < 8; ++c) { const v4u u = kp[c]; sc += q[8 * c + 0] * bf_lo(u.x) + q[8 * c + 1] * bf_hi(u.x) + q[8 * c + 2] * bf_lo(u.y) + q[8 * c + 3] * bf_hi(u.y) + q[8 * c + 4] * bf_lo(u.z) + q[8 * c + 5] * bf_hi(u.z) + q[8 * c + 6] * bf_lo(u.w) + q[8 * c + 7] * bf_hi(u.w); } \
        const float p = (wgt) * __builtin_amdgcn_exp2f(sc - shift); l += p; const v4u* vp = (const v4u*)(PROJ + (size_t)(rowbase + (srow)) * NPROJ + vcol); \
        _Pragma("unroll") for (int c = 0; c < 8; ++c) { const v4u u = vp[c]; o[8 * c + 0] += p * bf_lo(u.x); o[8 * c + 1] += p * bf_hi(u.x); o[8 * c + 2] += p * bf_lo(u.y); o[8 * c + 3] += p * bf_hi(u.y); o[8 * c + 4] += p * bf_lo(u.z); o[8 * c + 5] += p * bf_hi(u.z); o[8 * c + 6] += p * bf_lo(u.w); o[8 * c + 7] += p * bf_hi(u.w); } } while (0)
        if (isA) {
            for (int dist = 0; dist <= 127 && dist <= t; ++dist) KEY(t - dist, 1.0f);
            l += __builtin_amdgcn_exp2f(sinks[h] * 1.4426950408889634f - shift);
        } else {
            for (int dist = 0; dist <= 128 && dist <= t; ++dist) { const float w = 1.0f + (((dist & 3) == 0) ? 1.0f : 0.0f) + (((dist & 15) == 0) ? 1.0f : 0.0f); KEY(t - dist, w); }
            for (int dist = 132; dist <= 512 && dist <= t; dist += 4) { const float w = 1.0f + (((dist & 15) == 0) ? 1.0f : 0.0f); KEY(t - dist, w); }
            for (int dist = 528; dist <= t; dist += 16) KEY(t - dist, 1.0f);
        }
#undef KEY
        const float rl = 1.0f / l;
        v4u* op = (v4u*)(MIX + (size_t)m * D + hh * 64);
#pragma unroll
        for (int c = 0; c < 8; ++c) { v4u u; u.x = pk2(o[8 * c + 0] * rl, o[8 * c + 1] * rl); u.y = pk2(o[8 * c + 2] * rl, o[8 * c + 3] * rl); u.z = pk2(o[8 * c + 4] * rl, o[8 * c + 5] * rl); u.w = pk2(o[8 * c + 6] * rl, o[8 * c + 7] * rl); op[c] = u; }
    }
}


typedef short a_bf16x8 __attribute__((ext_vector_type(8)));
typedef short a_s16x4 __attribute__((ext_vector_type(4)));
typedef float a_f32x16 __attribute__((ext_vector_type(16)));
typedef float a_f32x2 __attribute__((ext_vector_type(2)));
typedef __bf16 a_bf16x2 __attribute__((ext_vector_type(2)));
__device__ __forceinline__ unsigned a_cvtpk(float lo, float hi) { a_f32x2 v = {lo, hi}; a_bf16x2 b = __builtin_convertvector(v, a_bf16x2); return __builtin_bit_cast(unsigned, b); }
__device__ __forceinline__ a_s16x4 a_vtr(LAS const unsigned char* p) { return __builtin_bit_cast(a_s16x4, __builtin_amdgcn_ds_read_tr16_b64_v4i16((LAS a_s16x4*)p)); }
constexpr int ATT_WLDS = 16384;
constexpr int ATT_STG = 8192, ATT_STG_PITCH = 144;

struct AttnTask { int qrow0, qrs, qcol, kcol, vcol, n1, row1, D01, kt2lo, kt2hi, row2, D02, qstep2, maxd2, orow0, ors, ocol; float shift, sinkterm; };

__device__ __forceinline__ void attn_task(const bf16* __restrict__ PROJ, bf16* __restrict__ MIX, LAS unsigned char* wl, const int lane, const AttnTask& T) {
    const int i = lane & 31, hh = lane >> 5;
    a_bf16x8 qf[4];
    { const bf16* qp = PROJ + (size_t)(T.qrow0 + i * T.qrs) * NPROJ + T.qcol + 8 * hh;
#pragma unroll
      for (int s = 0; s < 4; ++s) qf[s] = *(const a_bf16x8*)(qp + 16 * s); }
    a_f32x16 o0 = {}, o1 = {}; float lsum = 0.f;
    const int Dl1 = T.D01 + i - 4 * hh, Dl2 = T.D02 + T.qstep2 * i - 4 * hh;
    float wg[4];
#pragma unroll
    for (int c = 0; c < 4; ++c) wg[c] = ((Dl1 & 3) == c) ? 1.0f : 0.0f;
    const int nt = T.n1 + (T.kt2hi - T.kt2lo);
    const int klane = i * NPROJ + 8 * hh, vlane = (lane >> 3) * NPROJ + (lane & 7) * 8;
    LAS unsigned char* vw = wl + ((lane & 7) >> 2) * 2048 + (lane >> 3) * 64 + (lane & 3) * 16;
    LAS const unsigned char* tra = wl + (4 * hh + ((lane & 15) >> 2)) * 64 + ((lane >> 4) & 1) * 32 + (lane & 3) * 8;
    a_f32x16 negs;
#pragma unroll
    for (int r = 0; r < 16; ++r) negs[r] = -T.shift;
    v4u kn[4]; v4u vn[4];
#define ATT_LOAD(j) do { const int seg1_ = (j) < T.n1; const int kt_ = seg1_ ? (j) : T.kt2lo + ((j) - T.n1); const int row_ = seg1_ ? T.row1 + 128 * kt_ : T.row2 + 32 * kt_; const int rs_ = seg1_ ? 4 : 1; \
        const bf16* kb_ = PROJ + (size_t)row_ * NPROJ + T.kcol + (size_t)(vlane - (lane & 7) * 8) * rs_ + (lane & 7) * 8; const bf16* vb_ = PROJ + (size_t)row_ * NPROJ + T.vcol + (size_t)(vlane - (lane & 7) * 8) * rs_ + (lane & 7) * 8; \
        _Pragma("unroll") for (int jj = 0; jj < 4; ++jj) kn[jj] = *(const v4u*)(kb_ + (size_t)(8 * jj * rs_) * NPROJ); \
        _Pragma("unroll") for (int jj = 0; jj < 4; ++jj) vn[jj] = *(const v4u*)(vb_ + (size_t)(8 * jj * rs_) * NPROJ); } while (0)
    ATT_LOAD(0);
    for (int j = 0; j < nt; ++j) {
        v4u kr[4]; v4u vr[4];
#pragma unroll
        for (int s = 0; s < 4; ++s) { kr[s] = kn[s]; vr[s] = vn[s]; }
        if (j + 1 < nt) ATT_LOAD(j + 1);
        const bool seg1 = j < T.n1; const int kt = seg1 ? j : T.kt2lo + (j - T.n1);
        const int Dt = (seg1 ? Dl1 : Dl2) - 32 * kt;
        const int D0 = (seg1 ? T.D01 : T.D02) - 32 * kt, qst = seg1 ? 1 : T.qstep2, maxd = seg1 ? 128 : T.maxd2;
        const int dpmin = D0 - 31, dpmax = D0 + 31 * qst;
        const int cls = (dpmin >= 0 && dpmax <= maxd) ? 1 : (dpmin > maxd ? 2 : 0);
#pragma unroll
        for (int jj = 0; jj < 4; ++jj) *(LAS v4u*)(vw + 512 * jj) = vr[jj];
#pragma unroll
        for (int jj = 0; jj < 4; ++jj) *(LAS v4u*)(wl + 4096 + (lane & 7) * 512 + (((8 * jj + (lane >> 3)) ^ (lane & 7)) * 16)) = kr[jj];
        a_bf16x8 kf[4];
#pragma unroll
        for (int s = 0; s < 4; ++s) kf[s] = *(LAS const a_bf16x8*)(wl + 4096 + (2 * s + hh) * 512 + ((i ^ (2 * s + hh)) * 16));
        a_f32x16 S = negs;
#pragma unroll
        for (int s = 0; s < 4; ++s) S = __builtin_amdgcn_mfma_f32_32x32x16_bf16(kf[s], qf[s], S, 0, 0, 0);
        float p[16];
        float wm[4];
#pragma unroll
        for (int c = 0; c < 4; ++c) wm[c] = seg1 ? wg[c] : 0.0f;
        if (cls == 1) {
#pragma unroll
            for (int r = 0; r < 16; ++r) p[r] = (1.0f + wm[r & 3]) * __builtin_amdgcn_exp2f(S[r]);
        } else if (cls == 2) {
#pragma unroll
            for (int r = 0; r < 16; ++r) p[r] = wm[r & 3] * __builtin_amdgcn_exp2f(S[r]);
        } else {
#pragma unroll
            for (int r = 0; r < 16; ++r) { const int dp = Dt - ((r & 3) + 8 * (r >> 2));
                const float w = (((unsigned)dp <= (unsigned)maxd) ? 1.0f : 0.0f) + ((dp >= 0) ? wm[r & 3] : 0.0f);
                p[r] = w * __builtin_amdgcn_exp2f(S[r]); }
        }
        float ls = 0.f;
#pragma unroll
        for (int r = 0; r < 16; ++r) ls += p[r];
        lsum += ls;
        a_bf16x8 pb0, pb1;
        { v4u w0, w1; w0.x = a_cvtpk(p[0], p[1]); w0.y = a_cvtpk(p[2], p[3]); w0.z = a_cvtpk(p[4], p[5]); w0.w = a_cvtpk(p[6], p[7]);
          w1.x = a_cvtpk(p[8], p[9]); w1.y = a_cvtpk(p[10], p[11]); w1.z = a_cvtpk(p[12], p[13]); w1.w = a_cvtpk(p[14], p[15]);
          pb0 = __builtin_bit_cast(a_bf16x8, w0); pb1 = __builtin_bit_cast(a_bf16x8, w1); }
        {
            a_s16x4 lo, hi;
#define ATT_VF (a_bf16x8){lo[0], lo[1], lo[2], lo[3], hi[0], hi[1], hi[2], hi[3]}
            lo = a_vtr(tra);               hi = a_vtr(tra + 512);               o0 = __builtin_amdgcn_mfma_f32_32x32x16_bf16(ATT_VF, pb0, o0, 0, 0, 0);
            lo = a_vtr(tra + 1024);        hi = a_vtr(tra + 1024 + 512);        o0 = __builtin_amdgcn_mfma_f32_32x32x16_bf16(ATT_VF, pb1, o0, 0, 0, 0);
            lo = a_vtr(tra + 2048);        hi = a_vtr(tra + 2048 + 512);        o1 = __builtin_amdgcn_mfma_f32_32x32x16_bf16(ATT_VF, pb0, o1, 0, 0, 0);
            lo = a_vtr(tra + 2048 + 1024); hi = a_vtr(tra + 2048 + 1024 + 512); o1 = __builtin_amdgcn_mfma_f32_32x32x16_bf16(ATT_VF, pb1, o1, 0, 0, 0);
#undef ATT_VF
        }
    }
#undef ATT_LOAD
    const float ltot = lsum + __shfl_xor(lsum, 32) + T.sinkterm;
    const float rl = 1.0f / ltot;
    LAS unsigned char* stg = wl + ATT_STG;
#pragma unroll
    for (int g = 0; g < 4; ++g) {
        typedef unsigned u32x2_t __attribute__((ext_vector_type(2)));
        u32x2_t a, b2;
        a.x = a_cvtpk(o0[4 * g] * rl, o0[4 * g + 1] * rl); a.y = a_cvtpk(o0[4 * g + 2] * rl, o0[4 * g + 3] * rl);
        b2.x = a_cvtpk(o1[4 * g] * rl, o1[4 * g + 1] * rl); b2.y = a_cvtpk(o1[4 * g + 2] * rl, o1[4 * g + 3] * rl);
        *(LAS u32x2_t*)(stg + i * ATT_STG_PITCH + (8 * g + 4 * hh) * 2) = a;
        *(LAS u32x2_t*)(stg + i * ATT_STG_PITCH + (32 + 8 * g + 4 * hh) * 2) = b2;
    }
#pragma unroll
    for (int jj = 0; jj < 4; ++jj) { const int row = jj * 8 + (lane >> 3), ch = lane & 7;
        const v4u v = *(LAS const v4u*)(stg + row * ATT_STG_PITCH + ch * 16);
        *(v4u*)(MIX + (size_t)(T.orow0 + row * T.ors) * D + T.ocol + ch * 8) = v; }
}

__device__ __forceinline__ void attn_phase(const bf16* PROJ, bf16* MIX, const float* gqa, const float* gka, const float* gqb, const float* gkb, const float* sinks, LAS unsigned char* lds, int vcu, int G, int wave, int lane) {
    const float mqa = wave_max(__builtin_fabsf(gqa[lane])), mka = wave_max(__builtin_fabsf(gka[lane])), mqb = wave_max(__builtin_fabsf(gqb[lane])), mkb = wave_max(__builtin_fabsf(gkb[lane]));
    const float shiftA = pg8::C2 * 64.f * mqa * mka, shiftB = pg8::C2 * 64.f * mqb * mkb;
    LAS unsigned char* wl = lds + wave * ATT_WLDS;
    for (int v = vcu; v < BATCH * 8; v += G) {
        const int b = v >> 3, h = v & 7, rowb = b * SEQ;
        for (int k = 0; k < 16; ++k) {
            AttnTask T;
            if (k < 8) {
                const int r = wave & 3, half = wave >> 2, pr = 2 * (k >> 1) + half, c = (k & 1) ? 15 - pr : pr;
                T.qrow0 = rowb + 128 * c + r; T.qrs = 4; T.qcol = COL_QB + h * 64; T.kcol = COL_KB + h * 64; T.vcol = COL_VB + h * 64;
                T.n1 = c + 1; T.row1 = rowb + r; T.D01 = 32 * c;
                T.kt2lo = (c == 0) ? 4 : 0; T.kt2hi = 8; T.row2 = rowb + 128 * c - 128; T.D02 = 128 + r; T.qstep2 = 4; T.maxd2 = 128;
                T.orow0 = T.qrow0; T.ors = 4; T.ocol = 512 + h * 64; T.shift = shiftB; T.sinkterm = 0.f;
            } else {
                const int c = wave + 8 * (k - 8);
                T.qrow0 = rowb + 32 * c; T.qrs = 1; T.qcol = COL_QA + h * 64; T.kcol = COL_KA + (h >> 2) * 64; T.vcol = COL_VA + (h >> 2) * 64;
                T.n1 = 0; T.row1 = rowb; T.D01 = 0;
                T.kt2lo = (c < 4) ? 4 - c : 0; T.kt2hi = 5; T.row2 = rowb + 32 * c - 128; T.D02 = 128; T.qstep2 = 1; T.maxd2 = 127;
                T.orow0 = T.qrow0; T.ors = 1; T.ocol = h * 64; T.shift = shiftA; T.sinkterm = __builtin_amdgcn_exp2f(sinks[h] * 1.4426950408889634f - shiftA);
            }
            attn_task(PROJ, MIX, wl, lane, T);
        }
    }
}


constexpr int A2_SLOT = 32768, A2_STG = 98304, A2_STG_W = 4608, A2_NROUNDS = 72 + 16;
struct RIter { int ph, p, k; };
__device__ __forceinline__ void ri_next(RIter& it) { it.k++; if (it.ph == 0) { if (it.k == 2 * it.p + 2) { it.k = 0; it.p++; if (it.p == 8) { it.p = 0; it.ph = 1; } } } else if (it.k == 16) { it.k = 0; it.ph++; } }
__device__ __forceinline__ int ri_blk(const RIter& it) { return it.k; }
struct WTask { int cw; bool isB, first, last, live; };
__device__ __forceinline__ WTask wt_of(const RIter& it, int wave) {
    WTask t; t.isB = it.ph == 0; const int blk = it.k;
    if (t.isB) { t.cw = 2 * it.p + (wave >> 2); t.first = blk == 0; t.last = blk == t.cw; t.live = blk <= t.cw; }
    else if (wave < 4) { t.cw = 8 * ((blk + 1) >> 1) + wave; t.first = (blk & 1) || blk == 0; t.last = !(blk & 1); t.live = t.cw < 64; }
    else { t.cw = 8 * (blk >> 1) + wave; t.first = !(blk & 1); t.last = (blk & 1); t.live = true; }
    if (it.ph >= 2) { t.live = false; t.first = false; t.last = false; }
    return t;
}

__device__ __forceinline__ void attn_phase2(const bf16* __restrict__ PROJ, bf16* __restrict__ MIX, const float* sinks,
                                            LAS unsigned char* lds, int vcu, int G, int wave, int lane, const int mode) {
    const int i = lane & 31, hh = lane >> 5, r = wave & 3, grp = wave >> 2;
    const float NINF = -__builtin_inff();
    unsigned offK[2], offV[2];
#pragma unroll
    for (int j = 0; j < 2; ++j) { const int n = 2 * wave + j, slot = 8 * n + (lane >> 3), cp = lane & 7;
        const int rk = slot ^ ((slot >> 4) & 3), ch = cp ^ ((slot >> 1) & 7); offK[j] = (unsigned)(rk * NPROJ + ch * 8);
        const int rv = slot ^ ((slot >> 2) & 3), dh = (cp >> 2) ^ ((slot >> 1) & 1); offV[j] = (unsigned)(rv * NPROJ + dh * 32 + (cp & 3) * 8); }
    int k1[4], ke[4], ko[4], v1[2], v2[4];
    { const int rho = 4 * i + r, slot = rho ^ ((rho >> 4) & 3), sw = (slot >> 1) & 7;
#pragma unroll
      for (int s = 0; s < 4; ++s) k1[s] = slot * 128 + (((2 * s + hh) ^ sw) * 16); }
    { const int xe = i ^ (i >> 4), xo = i ^ (2 | (i >> 4));
#pragma unroll
      for (int s = 0; s < 4; ++s) { ke[s] = xe * 128 + (((2 * s + hh) ^ ((xe >> 1) & 7)) * 16); ko[s] = xo * 128 + (((2 * s + hh) ^ ((xo >> 1) & 7)) * 16); } }
    { const int q4 = (lane & 15) >> 2, g = (lane >> 4) & 1, pp = lane & 3;
#pragma unroll
      for (int dh = 0; dh < 2; ++dh) { const int sl = 16 * hh + 4 * q4 + (r ^ q4); v1[dh] = 16384 + sl * 128 + ((dh ^ ((sl >> 1) & 1)) * 64) + g * 32 + pp * 8; }
#pragma unroll
      for (int x = 0; x < 4; ++x) { const int dh = x >> 1, e = x & 1, kk = 8 * e + 4 * hh + q4, sl = kk ^ ((kk >> 2) & 3); v2[x] = 16384 + sl * 128 + ((dh ^ ((sl >> 1) & 1)) * 64) + g * 32 + pp * 8; } }
    a_f32x16 c1F, c1R;
#pragma unroll
    for (int q = 0; q < 16; ++q) { const bool mt = ((q & 3) == (i & 3)); c1F[q] = mt ? 1.0f : 0.0f; c1R[q] = mt ? 0.0f : NINF; }
    LAS unsigned char* stg = lds + A2_STG + wave * A2_STG_W;
#define A2_WAIT_V(n) asm volatile("s_waitcnt vmcnt(" #n ")" ::: "memory")
#define A2_OFFQ(q) (((q) & 3) + 8 * ((q) >> 2))
#define A2_CHAIN(S, C, KA) do { a_bf16x8 kf0_ = *(LAS const a_bf16x8*)(lds + (KA)[0]), kf1_ = *(LAS const a_bf16x8*)(lds + (KA)[1]), kf2_ = *(LAS const a_bf16x8*)(lds + (KA)[2]), kf3_ = *(LAS const a_bf16x8*)(lds + (KA)[3]); \
        S = __builtin_amdgcn_mfma_f32_32x32x16_bf16(kf0_, qf[0], C, 0, 0, 0); S = __builtin_amdgcn_mfma_f32_32x32x16_bf16(kf1_, qf[1], S, 0, 0, 0); \
        S = __builtin_amdgcn_mfma_f32_32x32x16_bf16(kf2_, qf[2], S, 0, 0, 0); S = __builtin_amdgcn_mfma_f32_32x32x16_bf16(kf3_, qf[3], S, 0, 0, 0); } while (0)
#define A2_TAIL(S, VA) do { float p_[16]; _Pragma("unroll") for (int q = 0; q < 16; ++q) p_[q] = __builtin_amdgcn_exp2f(S[q]); \
        lsum += ((p_[0] + p_[1]) + (p_[2] + p_[3])) + ((p_[4] + p_[5]) + (p_[6] + p_[7])) + (((p_[8] + p_[9]) + (p_[10] + p_[11])) + ((p_[12] + p_[13]) + (p_[14] + p_[15]))); \
        a_bf16x8 pb0_, pb1_; { v4u w0_, w1_; w0_.x = a_cvtpk(p_[0], p_[1]); w0_.y = a_cvtpk(p_[2], p_[3]); w0_.z = a_cvtpk(p_[4], p_[5]); w0_.w = a_cvtpk(p_[6], p_[7]); \
          w1_.x = a_cvtpk(p_[8], p_[9]); w1_.y = a_cvtpk(p_[10], p_[11]); w1_.z = a_cvtpk(p_[12], p_[13]); w1_.w = a_cvtpk(p_[14], p_[15]); \
          pb0_ = __builtin_bit_cast(a_bf16x8, w0_); pb1_ = __builtin_bit_cast(a_bf16x8, w1_); } \
        a_s16x4 lo_, hi_; \
        lo_ = a_vtr(lds + VA(0, 0, 0)); hi_ = a_vtr(lds + VA(0, 0, 1)); o0 = __builtin_amdgcn_mfma_f32_32x32x16_bf16((a_bf16x8){lo_[0], lo_[1], lo_[2], lo_[3], hi_[0], hi_[1], hi_[2], hi_[3]}, pb0_, o0, 0, 0, 0); \
        lo_ = a_vtr(lds + VA(0, 1, 0)); hi_ = a_vtr(lds + VA(0, 1, 1)); o0 = __builtin_amdgcn_mfma_f32_32x32x16_bf16((a_bf16x8){lo_[0], lo_[1], lo_[2], lo_[3], hi_[0], hi_[1], hi_[2], hi_[3]}, pb1_, o0, 0, 0, 0); \
        lo_ = a_vtr(lds + VA(1, 0, 0)); hi_ = a_vtr(lds + VA(1, 0, 1)); o1 = __builtin_amdgcn_mfma_f32_32x32x16_bf16((a_bf16x8){lo_[0], lo_[1], lo_[2], lo_[3], hi_[0], hi_[1], hi_[2], hi_[3]}, pb0_, o1, 0, 0, 0); \
        lo_ = a_vtr(lds + VA(1, 1, 0)); hi_ = a_vtr(lds + VA(1, 1, 1)); o1 = __builtin_amdgcn_mfma_f32_32x32x16_bf16((a_bf16x8){lo_[0], lo_[1], lo_[2], lo_[3], hi_[0], hi_[1], hi_[2], hi_[3]}, pb1_, o1, 0, 0, 0); } while (0)
    for (int v = vcu; v < BATCH * 8; v += G) {
        const int b = v >> 3, h = v & 7, rowb = b * SEQ;
        const float sinkterm = __builtin_amdgcn_exp2f(sinks[h] * 1.4426950408889634f);
#define A2_ISSUE(it, sl) do { const int blk_ = ri_blk(it); const bf16* kb_ = PROJ + (size_t)(rowb + 128 * blk_) * NPROJ + ((it).ph == 0 ? COL_KB + h * 64 : COL_KA + (h >> 2) * 64); \
        const bf16* vb_ = PROJ + (size_t)(rowb + 128 * blk_) * NPROJ + ((it).ph == 0 ? COL_VB + h * 64 : COL_VA + (h >> 2) * 64); \
        _Pragma("unroll") for (int j_ = 0; j_ < 2; ++j_) { \
            __builtin_amdgcn_global_load_lds((const unsigned*)(kb_ + offK[j_]), (LAS unsigned*)(lds + (sl) * A2_SLOT + (2 * wave + j_) * 1024), 16, 0, 0); \
            __builtin_amdgcn_global_load_lds((const unsigned*)(vb_ + offV[j_]), (LAS unsigned*)(lds + (sl) * A2_SLOT + 16384 + (2 * wave + j_) * 1024), 16, 0, 0); } } while (0)
        RIter cons = {0, 0, 0}, iss = {0, 0, 0};
        if (mode != 2) A2_ISSUE(iss, 0); ri_next(iss); if (mode != 2) A2_ISSUE(iss, 1); ri_next(iss);
        int slot = 0, islot = 2;
        a_bf16x8 qf[4], qn[4]; a_f32x16 o0 = {}, o1 = {}; float lsum = 0.f;
        { const WTask w0 = wt_of(cons, wave); const int nrow0 = rowb + 128 * w0.cw + r;
          const bf16* qp = PROJ + (size_t)(nrow0 + i * 4) * NPROJ + COL_QB + h * 64 + 8 * hh;
#pragma unroll
          for (int s = 0; s < 4; ++s) { qn[s] = *(const a_bf16x8*)(qp + 16 * s); qf[s] = qn[s]; } }
        for (int round = 0; round < A2_NROUNDS; ++round) {
            if (round + 1 < A2_NROUNDS) A2_WAIT_V(4); else A2_WAIT_V(0);
            __builtin_amdgcn_s_barrier(); asm volatile("" ::: "memory");
            if (iss.ph < 2) { if (mode != 2) A2_ISSUE(iss, islot); ri_next(iss); }
            islot = (islot == 2) ? 0 : islot + 1;
            const WTask wt = wt_of(cons, wave);
            const bool isB = wt.isB, first = wt.first && wt.live, last = wt.last && wt.live;
            const int cw = wt.cw, blk = ri_blk(cons);
            const int qrow0 = isB ? rowb + 128 * cw + r : rowb + 32 * cw, qrs = isB ? 4 : 1;
            if (first && mode != 1) {
#pragma unroll
                for (int s = 0; s < 4; ++s) qf[s] = qn[s];
                o0 = (a_f32x16){}; o1 = (a_f32x16){}; lsum = 0.f;
            }
            RIter nxr = cons; ri_next(nxr); const WTask wn = wt_of(nxr, wave);
            const bool prefetch_q = wn.first && wn.live && mode != 1;
            if (prefetch_q) {
                const int nrow0 = wn.isB ? rowb + 128 * wn.cw + r : rowb + 32 * wn.cw, nrs = wn.isB ? 4 : 1;
                const bf16* qp = PROJ + (size_t)(nrow0 + i * nrs) * NPROJ + (wn.isB ? COL_QB : COL_QA) + h * 64 + 8 * hh;
#pragma unroll
                for (int s = 0; s < 4; ++s) qn[s] = *(const a_bf16x8*)(qp + 16 * s);
            }
            const int sbo = slot * A2_SLOT;
            if (mode != 1) {
            if (isB && blk <= cw) {
                const int d = cw - blk;
                int ka[4];
#pragma unroll
                for (int s = 0; s < 4; ++s) ka[s] = k1[s] + sbo;
                a_f32x16 S;
                if (d >= 5) { A2_CHAIN(S, c1R, ka); }
                else if (d >= 1 && d <= 3) { A2_CHAIN(S, c1F, ka); }
                else { const int Dt = 32 * d + i - 4 * hh; a_f32x16 C;
                    if (d == 0) {
#pragma unroll
                        for (int q = 0; q < 16; ++q) C[q] = (A2_OFFQ(q) <= Dt) ? c1F[q] : NINF;
                    } else {
#pragma unroll
                        for (int q = 0; q < 16; ++q) C[q] = (A2_OFFQ(q) >= Dt - 128) ? c1F[q] : c1R[q];
                    }
                    A2_CHAIN(S, C, ka); }
                const int vb0 = v1[0] + sbo, vb1 = v1[1] + sbo;
#define A2_VA1(dh, sp, e) (((dh) ? vb1 : vb0) + (sp) * 8192 + (e) * 4096)
                A2_TAIL(S, A2_VA1);
#undef A2_VA1
            }
            int t2lo, t2hi, lo0, maxd;
            if (isB) { t2lo = 0; t2hi = (blk == cw || blk == cw - 1) ? 4 : 0; maxd = 128; lo0 = r - ((blk == cw) ? 128 : 0) + 4 * i - 4 * hh; }
            else { const int t0 = 4 * blk; t2lo = (cw - 4 - t0) > 0 ? (cw - 4 - t0) : 0; t2hi = (cw - t0 + 1) < 4 ? (cw - t0 + 1) : 4; maxd = 127; lo0 = 32 * (cw - t0) + i - 4 * hh - 127; if (!wt.live) t2hi = t2lo; }
#define A2_MASKC(C, LO) do { _Pragma("unroll") for (int q = 0; q < 16; ++q) C[q] = ((unsigned)(A2_OFFQ(q) - (LO)) <= (unsigned)maxd) ? 0.0f : NINF; } while (0)
            int t2 = t2lo;
            for (; t2 + 1 < t2hi; t2 += 2) {
                const int tba = sbo + t2 * 4096, tbb = tba + 4096;
                int kaa[4], kab[4];
#pragma unroll
                for (int s = 0; s < 4; ++s) { kaa[s] = ((t2 & 1) ? ko[s] : ke[s]) + tba; kab[s] = ((t2 & 1) ? ke[s] : ko[s]) + tbb; }
                a_f32x16 Ca, Cb, Sa, Sb;
                A2_MASKC(Ca, lo0 - 32 * t2); A2_MASKC(Cb, lo0 - 32 * t2 - 32);
                { a_bf16x8 fa0 = *(LAS const a_bf16x8*)(lds + kaa[0]), fb0 = *(LAS const a_bf16x8*)(lds + kab[0]), fa1 = *(LAS const a_bf16x8*)(lds + kaa[1]), fb1 = *(LAS const a_bf16x8*)(lds + kab[1]);
                  a_bf16x8 fa2 = *(LAS const a_bf16x8*)(lds + kaa[2]), fb2 = *(LAS const a_bf16x8*)(lds + kab[2]), fa3 = *(LAS const a_bf16x8*)(lds + kaa[3]), fb3 = *(LAS const a_bf16x8*)(lds + kab[3]);
                  Sa = __builtin_amdgcn_mfma_f32_32x32x16_bf16(fa0, qf[0], Ca, 0, 0, 0); Sb = __builtin_amdgcn_mfma_f32_32x32x16_bf16(fb0, qf[0], Cb, 0, 0, 0);
                  Sa = __builtin_amdgcn_mfma_f32_32x32x16_bf16(fa1, qf[1], Sa, 0, 0, 0); Sb = __builtin_amdgcn_mfma_f32_32x32x16_bf16(fb1, qf[1], Sb, 0, 0, 0);
                  Sa = __builtin_amdgcn_mfma_f32_32x32x16_bf16(fa2, qf[2], Sa, 0, 0, 0); Sb = __builtin_amdgcn_mfma_f32_32x32x16_bf16(fb2, qf[2], Sb, 0, 0, 0);
                  Sa = __builtin_amdgcn_mfma_f32_32x32x16_bf16(fa3, qf[3], Sa, 0, 0, 0); Sb = __builtin_amdgcn_mfma_f32_32x32x16_bf16(fb3, qf[3], Sb, 0, 0, 0); }
                const int vx0 = v2[0] + tba, vx1 = v2[1] + tba, vx2 = v2[2] + tba, vx3 = v2[3] + tba;
#define A2_VA2(dh, sp, e) (((dh) ? ((e) ? vx3 : vx2) : ((e) ? vx1 : vx0)) + (sp) * 2048)
#define A2_VA2B(dh, sp, e) (((dh) ? ((e) ? vx3 : vx2) : ((e) ? vx1 : vx0)) + (sp) * 2048 + 4096)
                A2_TAIL(Sa, A2_VA2);
                A2_TAIL(Sb, A2_VA2B);
#undef A2_VA2B
#undef A2_VA2
            }
            if (t2 < t2hi) {
                const int tbo = sbo + t2 * 4096;
                int ka[4];
#pragma unroll
                for (int s = 0; s < 4; ++s) ka[s] = ((t2 & 1) ? ko[s] : ke[s]) + tbo;
                a_f32x16 C, S;
                A2_MASKC(C, lo0 - 32 * t2);
                A2_CHAIN(S, C, ka);
                const int vx0 = v2[0] + tbo, vx1 = v2[1] + tbo, vx2 = v2[2] + tbo, vx3 = v2[3] + tbo;
#define A2_VA2(dh, sp, e) (((dh) ? ((e) ? vx3 : vx2) : ((e) ? vx1 : vx0)) + (sp) * 2048)
                A2_TAIL(S, A2_VA2);
#undef A2_VA2
            }
#undef A2_MASKC
            }
            if (last && mode != 1) {
                const float ltot = lsum + __shfl_xor(lsum, 32) + (isB ? 0.f : sinkterm);
                const float rl = 1.0f / ltot;
#pragma unroll
                for (int g = 0; g < 4; ++g) {
                    typedef unsigned u32x2_t __attribute__((ext_vector_type(2)));
                    u32x2_t a, b2;
                    a.x = a_cvtpk(o0[4 * g] * rl, o0[4 * g + 1] * rl); a.y = a_cvtpk(o0[4 * g + 2] * rl, o0[4 * g + 3] * rl);
                    b2.x = a_cvtpk(o1[4 * g] * rl, o1[4 * g + 1] * rl); b2.y = a_cvtpk(o1[4 * g + 2] * rl, o1[4 * g + 3] * rl);
                    *(LAS u32x2_t*)(stg + i * ATT_STG_PITCH + (8 * g + 4 * hh) * 2) = a;
                    *(LAS u32x2_t*)(stg + i * ATT_STG_PITCH + (32 + 8 * g + 4 * hh) * 2) = b2;
                }
                const int ocol = isB ? 512 + h * 64 : h * 64;
#pragma unroll
                for (int jj = 0; jj < 4; ++jj) { const int row = jj * 8 + (lane >> 3), ch = lane & 7;
                    const v4u vv = *(LAS const v4u*)(stg + row * ATT_STG_PITCH + ch * 16);
                    if (mode == 0) *(v4u*)(MIX + (size_t)(qrow0 + row * qrs) * D + ocol + ch * 8) = vv; else asm volatile("" :: "v"(vv)); }
            }
            if (prefetch_q) {
#pragma unroll
                for (int s = 0; s < 4; ++s) asm volatile("" : "+v"(qn[s]));
            }
            slot = (slot == 2) ? 0 : slot + 1; ri_next(cons);
        }
        A2_WAIT_V(0); __builtin_amdgcn_s_barrier(); asm volatile("" ::: "memory");
#undef A2_ISSUE
    }
#undef A2_WAIT_V
#undef A2_OFFQ
#undef A2_CHAIN
#undef A2_TAIL
}

struct Args { const float* in[13]; float* out; unsigned char* ws; int ph_lo, ph_hi, li, pad; };
__global__ void __launch_bounds__(NWAVES * 64, 2) hymba_fwd(Args args) {
    extern __shared__ __attribute__((aligned(16))) unsigned char lds[];
    LAS unsigned char* L = (LAS unsigned char*)lds;
    volatile LAS unsigned* MISC = (volatile LAS unsigned*)(L + MISC_OFF);
    const int tid = threadIdx.x, lane = tid & 63, wave = __builtin_amdgcn_readfirstlane(tid >> 6);
    const int G = gridDim.x; const int bx = blockIdx.x; const int vcu = (G % 8 == 0) ? (bx % 8) * (G / 8) + bx / 8 : bx;
    unsigned char* ws = args.ws;
    gu32* ctl = (gu32*)(ws + WS_CTL);
    const float* x = args.in[0]; const int* positions = (const int*)args.in[1]; const float* g_attn = args.in[2]; const float* w_in = args.in[3];
    const float* gqa = args.in[4]; const float* gka = args.in[5]; const float* sinks = args.in[6]; const float* gqb = args.in[7]; const float* gkb = args.in[8];
    const float* w_out = args.in[9]; const float* g_mlp = args.in[10]; const float* w_up = args.in[11]; const float* w_dn = args.in[12];
    float* out = args.out;
    bf16* Win_t = (bf16*)(ws + WS_WIN); bf16* Wout_t = (bf16*)(ws + WS_WOUT); bf16* Wup_t = (bf16*)(ws + WS_WUP); bf16* Wdn_t = (bf16*)(ws + WS_WDN);
    float* rope = (float*)(ws + WS_ROPE); float* ssp = (float*)(ws + WS_SS);
    bf16* XN = (bf16*)(ws + WS_XN); bf16* PROJ = (bf16*)(ws + WS_PROJ); bf16* MIXB = (bf16*)(ws + WS_MIX); bf16* HID = (bf16*)(ws + WS_HID);
    for (int u = tid; u < (LDS_BYTES - LDSCTL_OFF) / 4; u += NWAVES * 64) ((LAS unsigned*)(L + LDSCTL_OFF))[u] = 0u;
    __syncthreads();
    const int bli = (N_LAUNCHES == PER_PHASE) ? 0 : args.li;
    XcdBarrier bar; bar.bar = (unsigned*)(ctl + CW_BAR) + bli * XCD_BAR_WORDS; bar.x = 0; bar.st = nullptr;
    if (N_LAUNCHES != PER_PHASE) bar = xcd_barrier_post((unsigned*)(ctl + CW_BAR) + bli * XCD_BAR_WORDS, MISC + 8);
#define GRID_BAR(seam) do { if (N_LAUNCHES == PER_PHASE) { if (tid == 0) __hip_atomic_store(ctl + CW_TMO, 0xBADBA0u | (unsigned)(seam), RLX_AGENT); } else { xcd_barrier(bar); } } while (0)
    const int lo = args.ph_lo, hi = args.ph_hi;
#define IN(k) (lo <= (k) && (k) < hi)
#define STAGGER(k) do { if (((STAGGER_PHASES >> (k)) & 1) && STAGGER_TICKS > 0 && ((blockIdx.x >> 3) & 1)) { const unsigned long long t0_ = __builtin_amdgcn_s_memrealtime(); while (__builtin_amdgcn_s_memrealtime() - t0_ < (unsigned long long)STAGGER_TICKS) __builtin_amdgcn_s_sleep(16); } } while (0)
#define BOTH(k) (IN(k) && IN((k) + 1))

    if (IN(0)) { REP(0) {
        LAS float* scr = (LAS float*)(L + RING_OFF + wave * 16384);
        const int gw = vcu * NWAVES + wave, NGW = G * NWAVES;
        constexpr int I_IN = (D / 64) * (NPROJ / 32), I_OUT = (D / 64) * (D / 32), I_UP = (D / 64) * (FF / 32), I_DN = (FF / 64) * (D / 32);
        constexpr int NITEMS = I_IN + I_OUT + I_UP + I_DN;
        for (int it = gw; it < NITEMS; it += NGW) {
            int r = it;
            if (r < I_IN) { p0_transpose_item(w_in, D, NPROJ, Win_t, nullptr, scr, r, lane); continue; } r -= I_IN;
            if (r < I_OUT) { p0_transpose_item(w_out, D, D, Wout_t, nullptr, scr, r, lane); continue; } r -= I_OUT;
            if (r < I_UP) { p0_transpose_item(w_up, D, FF, Wup_t, g_mlp, scr, r, lane); continue; } r -= I_UP;
            p0_transpose_item(w_dn, FF, D, Wdn_t, nullptr, scr, r, lane);
        }
        for (int m = gw * 4; m < M; m += NGW * 4) rms_rows_to_bf16<4>(x + (size_t)m * D, g_attn, XN + (size_t)m * D, lane);
        for (int it = gw * 64 + lane; it < M * 8; it += NGW * 64) {
            const int m = it >> 3, i = it & 7;
            const float inv_freq = (i == 0) ? 1.0f : (i == 1) ? 0.193922743f : (i == 2) ? 0.0376060307f : (i == 3) ? 0.00729266461f : (i == 4) ? 0.00141421356f : (i == 5) ? 0.000274248188f : (i == 6) ? 5.3182961e-05f : 1.03133862e-05f;
            const float ang = (float)positions[m] * inv_freq;
            double rev = (double)ang * 0.15915494309189535; rev -= __builtin_floor(rev);
            const float rf = (float)rev;
            rope[(size_t)m * 16 + i] = __builtin_amdgcn_cosf(rf); rope[(size_t)m * 16 + 8 + i] = __builtin_amdgcn_sinf(rf);
        }
        }
        if (BOTH(0)) GRID_BAR(0);
    }
    if (IN(1)) {
        pg8::Gemm g{XN, Win_t, M, NPROJ, D}; pg8::StaticOrder S; S.init(M, NPROJ, G, (int)blockIdx.x);
        pg8::EpiQKV E{PROJ, NPROJ, gqa, gka, gqb, gkb, rope};
        STAGGER(1);
        REP(1) pg8::gemm_phase<pg8::EpiQKV, pg8::StaticOrder, true>(L + RING_OFF, L + EPI_OFF, g, S, E);
        if (BOTH(1)) GRID_BAR(1);
    }
    if (IN(2)) {
#if defined(NAIVE_ATTN)
        attn_naive(PROJ, MIXB, gqa, gka, gqb, gkb, sinks, vcu * (NWAVES * 64) + tid, G * NWAVES * 64);
#else
#if defined(ATTN_V1)
        REP(2) attn_phase(PROJ, MIXB, gqa, gka, gqb, gkb, sinks, L + RING_OFF, vcu, G, wave, lane);
#else
        REP(2) attn_phase2(PROJ, MIXB, sinks, L + RING_OFF, vcu, G, wave, lane, rep_ == 0 ? 0 : PROBE_MODE);
#endif
#endif
        if (BOTH(2)) GRID_BAR(2);
    }
    if (IN(3)) {
        pg8::Gemm g{MIXB, Wout_t, M, D, D}; pg8::StaticOrder S; S.init(M, D, G, (int)blockIdx.x);
        pg8::EpiOut E{x, XN, ssp, D};
        STAGGER(3);
        REP(3) pg8::gemm_phase<pg8::EpiOut, pg8::StaticOrder, true>(L + RING_OFF, L + EPI_OFF, g, S, E);
        if (BOTH(3)) GRID_BAR(3);
    }
    if (IN(4)) {
        pg8::Gemm g{XN, Wup_t, M, FF, D}; pg8::StaticOrder S; S.init(M, FF, G, (int)blockIdx.x);
        pg8::EpiUp E{HID, FF};
        STAGGER(4);
        pg8::gemm_phase<pg8::EpiUp, pg8::StaticOrder, true>(L + RING_OFF, L + EPI_OFF, g, S, E);
#if PROBE_NULL_EPI
        { pg8::EpiNull EN; pg8::gemm_phase<pg8::EpiNull, pg8::StaticOrder, true>(L + RING_OFF, L + EPI_OFF, g, S, EN); }
#elif (REPEAT_MASK & 16)
        pg8::gemm_phase<pg8::EpiUp, pg8::StaticOrder, true>(L + RING_OFF, L + EPI_OFF, g, S, E);
#endif
        if (BOTH(4)) GRID_BAR(4);
    }
    if (IN(5)) {
        pg8::Gemm g{HID, Wdn_t, M, D, FF}; pg8::StaticOrder S; S.init(M, D, G, (int)blockIdx.x);
        pg8::EpiDown E{XN, ssp, out, D, 1.0f / D, RMS_EPS};
        STAGGER(5);
        pg8::gemm_phase<pg8::EpiDown, pg8::StaticOrder, true>(L + RING_OFF, L + EPI_OFF, g, S, E);
    }
#undef IN
#undef BOTH
}

extern "C" void kernel_launch(void* const* d_in, const int* in_sizes, int n_in, void* d_out, int out_size, void* d_ws, size_t ws_size, hipStream_t stream) {
    static int grid = 0;
    if (grid == 0) {
        if (n_in != 13 || in_sizes[0] != M * D || out_size != M * D || ws_size < WS_END) { fprintf(stderr, "kernel_launch: shape/workspace mismatch (n_in %d in0 %d out %d ws %zu); nothing launched\n", n_in, n_in > 0 ? in_sizes[0] : -1, out_size, ws_size); grid = -1; return; }
        int dev = 0, cus = 0, per_cu = 0;
        if (hipGetDevice(&dev) != hipSuccess || hipDeviceGetAttribute(&cus, hipDeviceAttributeMultiprocessorCount, dev) != hipSuccess) { fprintf(stderr, "kernel_launch: device query failed\n"); grid = -1; return; }
        if (hipFuncSetAttribute((const void*)hymba_fwd, hipFuncAttributeMaxDynamicSharedMemorySize, LDS_BYTES) != hipSuccess) { fprintf(stderr, "kernel_launch: hipFuncSetAttribute failed\n"); grid = -1; return; }
        if (hipOccupancyMaxActiveBlocksPerMultiprocessor(&per_cu, (const void*)hymba_fwd, NWAVES * 64, LDS_BYTES) != hipSuccess || per_cu < 1)
            fprintf(stderr, "kernel_launch: note: occupancy query reports %d workgroups per CU\n", per_cu);
        (void)hipGetLastError();
        grid = cus;
    }
    if (grid < 0) return;
    if (hipMemsetAsync((char*)d_ws + WS_CTL, 0, CTL_ZERO_BYTES, stream) != hipSuccess) { fprintf(stderr, "kernel_launch: hipMemsetAsync failed\n"); return; }
    Args a{};
    for (int i = 0; i < 13; ++i) a.in[i] = (const float*)d_in[i];
    a.out = (float*)d_out; a.ws = (unsigned char*)d_ws;
    static_assert(N_LAUNCHES == 1 || N_LAUNCHES == PER_PHASE, "MK_N_LAUNCHES must be 1 or 6");
    for (int li = 0; li < N_LAUNCHES; ++li) {
        a.ph_lo = (N_LAUNCHES == PER_PHASE) ? li : 0; a.ph_hi = (N_LAUNCHES == PER_PHASE) ? li + 1 : PER_PHASE; a.li = li;
        hipLaunchKernelGGL(hymba_fwd, dim3(grid), dim3(NWAVES * 64), LDS_BYTES, stream, a);
        const hipError_t le = hipPeekAtLastError();
        if (le != hipSuccess) { fprintf(stderr, "kernel_launch: launch %d failed: %s\n", li, hipGetErrorName(le)); break; }
    }
}
```
